# Optimizing an MI355X kernel written in HIP

```python
import jax, jax.numpy as jnp
from jax import lax
import numpy as np

D_MODEL = 1024
BATCH = 4
SEQ = 8192
DEPTH = 2

N_A_LAYERS = DEPTH // 2
N_B_LAYERS = DEPTH - N_A_LAYERS
N_DENSE_LAYERS = (DEPTH + 1) // 2
N_MOE_LAYERS = DEPTH // 2

LRU_WIDTH = D_MODEL
LRU_BLOCKS = 4
LRU_BLOCK_W = LRU_WIDTH // LRU_BLOCKS
CONV_WIDTH = 4
LRU_C = 8.0

HEAD_DIM = 64
N_Q_HEADS = D_MODEL // HEAD_DIM
N_KV_HEADS = 2
GROUP = N_Q_HEADS // N_KV_HEADS
WINDOW = 128
BLOCK = 128
ROPE_THETA = 500000.0
ROT_DIM = HEAD_DIM // 4

D_FF = 3 * D_MODEL
N_EXPERTS = 8
TOP_K = 2
D_FF_EXPERT = D_MODEL

PLE_DIM = 256
EPS = 1e-6

kernel_name = 'yoco_rglru_swa_sink_moe_trunk'


def rmsnorm(x, g):
    xf = x.astype(jnp.float32)
    y = xf * lax.rsqrt(jnp.mean(xf * xf, axis=-1, keepdims=True) + EPS) * g.astype(jnp.float32)
    return y.astype(x.dtype)


def rope_tables(positions):
    freqs = ROPE_THETA ** (-jnp.arange(0, ROT_DIM, 2, dtype=jnp.float32) / ROT_DIM)
    ang = positions.astype(jnp.float32)[..., None] * freqs
    return jnp.cos(ang)[:, :, None, :], jnp.sin(ang)[:, :, None, :]


def partial_rope(t, cos, sin):
    half = ROT_DIM // 2
    t1 = t[..., :half].astype(jnp.float32)
    t2 = t[..., half:ROT_DIM].astype(jnp.float32)
    rot = jnp.concatenate([t1 * cos - t2 * sin, t2 * cos + t1 * sin], axis=-1).astype(t.dtype)
    return jnp.concatenate([rot, t[..., ROT_DIM:]], axis=-1)


def _lru_combine(c1, c2):
    a1, b1 = c1
    a2, b2 = c2
    return a1 * a2, a2 * b1 + b2


def rglru_block(xn, w_in, conv_w, conv_b, w_ga, b_ga, w_gx, b_gx, lam, w_out):
    B, S, _ = xn.shape
    h = xn @ w_in
    gate_branch, xb = jnp.split(h, 2, axis=-1)
    gate = jax.nn.gelu(gate_branch)
    xpad = jnp.pad(xb, ((0, 0), (CONV_WIDTH - 1, 0), (0, 0)))
    xc = conv_b
    for k in range(CONV_WIDTH):
        xc = xc + conv_w[k] * xpad[:, CONV_WIDTH - 1 - k: CONV_WIDTH - 1 - k + S]
    xh = xc.reshape(B, S, LRU_BLOCKS, LRU_BLOCK_W)
    r = jax.nn.sigmoid(jnp.einsum('bshi,hij->bshj', xh, w_ga).reshape(B, S, LRU_WIDTH) + b_ga)
    i = jax.nn.sigmoid(jnp.einsum('bshi,hij->bshj', xh, w_gx).reshape(B, S, LRU_WIDTH) + b_gx)
    log_a = -LRU_C * r.astype(jnp.float32) * jax.nn.softplus(-lam.astype(jnp.float32))
    a = jnp.exp(log_a)
    mult = jnp.sqrt(-jnp.expm1(2.0 * log_a))
    mult = mult.at[:, 0].set(1.0)
    b_in = mult * (i * xc).astype(jnp.float32)
    _, hs = lax.associative_scan(_lru_combine, (a, b_in), axis=1)
    return (hs.astype(xn.dtype) * gate) @ w_out


def _blockify_with_prev(t):
    B, S, Hk, Dh = t.shape
    tb = t.reshape(B, S // BLOCK, BLOCK, Hk, Dh)
    prev = jnp.pad(tb, ((0, 0), (1, 0), (0, 0), (0, 0), (0, 0)))[:, :-1]
    return jnp.concatenate([prev, tb], axis=2)


def sliding_window_attention_sinks(q, k, v, sinks):
    B, S, _, _ = q.shape
    NB = S // BLOCK
    qb = q.reshape(B, NB, BLOCK, N_KV_HEADS, GROUP, HEAD_DIM)
    kk = _blockify_with_prev(k)
    vv = _blockify_with_prev(v)
    scores = jnp.einsum('bnqhgd,bnjhd->bnhgqj', qb, kk).astype(jnp.float32) * (HEAD_DIM ** -0.5)
    qi = jnp.arange(BLOCK)[:, None]
    kj = jnp.arange(2 * BLOCK)[None, :]
    diff = qi + BLOCK - kj
    band = (diff >= 0) & (diff < WINDOW)
    valid = (jnp.arange(NB)[:, None, None] > 0) | (kj >= BLOCK)[None]
    mask = (band[None] & valid)[None, :, None, None]
    scores = jnp.where(mask, scores, jnp.float32(-1e30))
    sink = jnp.broadcast_to(sinks.astype(jnp.float32).reshape(1, 1, N_KV_HEADS, GROUP, 1, 1),
                            scores.shape[:-1] + (1,))
    probs = jax.nn.softmax(jnp.concatenate([scores, sink], axis=-1), axis=-1)[..., :-1]
    out = jnp.einsum('bnhgqj,bnjhd->bnqhgd', probs.astype(v.dtype), vv)
    return out.reshape(B, S, N_Q_HEADS * HEAD_DIM)


def swiglu(xn, w_in, w_out):
    g, u = jnp.split(xn @ w_in, 2, axis=-1)
    return (jax.nn.silu(g) * u) @ w_out


def moe_swiglu(xn, w_router, b_router, w_in, w_out):
    logits = (xn @ w_router).astype(jnp.float32) + b_router.astype(jnp.float32)
    top_vals, top_idx = lax.top_k(logits, TOP_K)
    top_w = jax.nn.softmax(top_vals, axis=-1)
    gates = jnp.einsum('bske,bsk->bse', jax.nn.one_hot(top_idx, N_EXPERTS, dtype=jnp.float32), top_w)
    y = jnp.zeros_like(xn)
    for e in range(N_EXPERTS):
        y = y + gates[..., e:e + 1].astype(xn.dtype) * swiglu(xn, w_in[e], w_out[e])
    return y


def setup_inputs(seed: int = 0) -> dict:
    key = jax.random.key(seed)
    ks = iter(jax.random.split(key, 48))
    f32 = jnp.float32

    def nrm(shape, fan_in):
        return jax.random.normal(next(ks), shape, f32) * (fan_in ** -0.5)

    def gain(shape):
        return 1.0 + 0.02 * jax.random.normal(next(ks), shape, f32)

    def bias(shape):
        return 0.01 * jax.random.normal(next(ks), shape, f32)

    x = jax.random.normal(next(ks), (BATCH, SEQ, D_MODEL), f32)
    p = jax.random.normal(next(ks), (DEPTH, BATCH, SEQ, PLE_DIM), f32)
    offsets = jax.random.randint(next(ks), (BATCH, 1), 0, 4096, dtype=jnp.int32)
    positions = offsets + jnp.arange(SEQ, dtype=jnp.int32)[None, :]

    a0 = jax.random.uniform(next(ks), (N_A_LAYERS, LRU_WIDTH), f32, 0.9, 0.999) ** (1.0 / LRU_C)
    lru_lambda = jnp.log(a0) - jnp.log1p(-a0)

    return {
        'x': x,
        'p': p,
        'positions': positions,
        'g_mix': gain((DEPTH, D_MODEL)),
        'g_ffn': gain((DEPTH, D_MODEL)),
        'g_ple': gain((DEPTH, D_MODEL)),
        'w_ple_gate': nrm((DEPTH, D_MODEL, D_MODEL), D_MODEL),
        'w_ple_proj': nrm((DEPTH, PLE_DIM, D_MODEL), PLE_DIM),
        'w_lru_in': nrm((N_A_LAYERS, D_MODEL, 2 * LRU_WIDTH), D_MODEL),
        'lru_conv_w': nrm((N_A_LAYERS, CONV_WIDTH, LRU_WIDTH), CONV_WIDTH),
        'lru_conv_b': bias((N_A_LAYERS, LRU_WIDTH)),
        'w_lru_ga': nrm((N_A_LAYERS, LRU_BLOCKS, LRU_BLOCK_W, LRU_BLOCK_W), LRU_BLOCK_W),
        'b_lru_ga': bias((N_A_LAYERS, LRU_WIDTH)),
        'w_lru_gx': nrm((N_A_LAYERS, LRU_BLOCKS, LRU_BLOCK_W, LRU_BLOCK_W), LRU_BLOCK_W),
        'b_lru_gx': bias((N_A_LAYERS, LRU_WIDTH)),
        'lru_lambda': lru_lambda,
        'w_lru_out': nrm((N_A_LAYERS, LRU_WIDTH, D_MODEL), LRU_WIDTH),
        'g_kv': gain((D_MODEL,)),
        'w_kv': nrm((D_MODEL, 2 * N_KV_HEADS * HEAD_DIM), D_MODEL),
        'w_q': nrm((N_B_LAYERS, D_MODEL, N_Q_HEADS * HEAD_DIM), D_MODEL),
        'attn_sinks': jax.random.normal(next(ks), (N_B_LAYERS, N_Q_HEADS), f32),
        'w_o': nrm((N_B_LAYERS, N_Q_HEADS * HEAD_DIM, D_MODEL), N_Q_HEADS * HEAD_DIM),
        'w_ff_in': nrm((N_DENSE_LAYERS, D_MODEL, 2 * D_FF), D_MODEL),
        'w_ff_out': nrm((N_DENSE_LAYERS, D_FF, D_MODEL), D_FF),
        'w_router': nrm((N_MOE_LAYERS, D_MODEL, N_EXPERTS), D_MODEL),
        'b_router': bias((N_MOE_LAYERS, N_EXPERTS)),
        'w_exp_in': nrm((N_MOE_LAYERS, N_EXPERTS, D_MODEL, 2 * D_FF_EXPERT), D_MODEL),
        'w_exp_out': nrm((N_MOE_LAYERS, N_EXPERTS, D_FF_EXPERT, D_MODEL), D_FF_EXPERT),
        'g_final': gain((D_MODEL,)),
    }


def reference(x, p, positions, g_mix, g_ffn, g_ple, w_ple_gate, w_ple_proj,
              w_lru_in, lru_conv_w, lru_conv_b, w_lru_ga, b_lru_ga, w_lru_gx, b_lru_gx,
              lru_lambda, w_lru_out, g_kv, w_kv, w_q, attn_sinks, w_o,
              w_ff_in, w_ff_out, w_router, b_router, w_exp_in, w_exp_out, g_final):
    B, S, _ = x.shape
    cos, sin = rope_tables(positions)
    k_shared = None
    v_shared = None
    for i in range(DEPTH):
        xn = rmsnorm(x, g_mix[i])
        if i < N_A_LAYERS:
            a = i
            x = x + rglru_block(xn, w_lru_in[a], lru_conv_w[a], lru_conv_b[a], w_lru_ga[a], b_lru_ga[a],
                                w_lru_gx[a], b_lru_gx[a], lru_lambda[a], w_lru_out[a])
        else:
            b = i - N_A_LAYERS
            q = partial_rope((xn @ w_q[b]).reshape(B, S, N_Q_HEADS, HEAD_DIM), cos, sin)
            attn = sliding_window_attention_sinks(q, k_shared, v_shared, attn_sinks[b])
            x = x + attn @ w_o[b]
        xn = rmsnorm(x, g_ffn[i])
        if i % 2 == 0:
            x = x + swiglu(xn, w_ff_in[i // 2], w_ff_out[i // 2])
        else:
            m = i // 2
            x = x + moe_swiglu(xn, w_router[m], b_router[m], w_exp_in[m], w_exp_out[m])
        ple_gate = jax.nn.sigmoid(rmsnorm(x, g_ple[i]) @ w_ple_gate[i])
        x = x + ple_gate * (p[i] @ w_ple_proj[i])
        if i == N_A_LAYERS - 1:
            kv = rmsnorm(x, g_kv) @ w_kv
            k_flat, v_flat = jnp.split(kv, 2, axis=-1)
            k_shared = partial_rope(k_flat.reshape(B, S, N_KV_HEADS, HEAD_DIM), cos, sin)
            v_shared = v_flat.reshape(B, S, N_KV_HEADS, HEAD_DIM)
    return rmsnorm(x, g_final)
```

```cpp
#include <hip/hip_runtime.h>
#include <hip/hip_cooperative_groups.h>
#include <cstdio>
#include <cstdint>
namespace cg = cooperative_groups;

#define LAS __attribute__((address_space(3)))
typedef unsigned short bf16_t;
typedef short bf16x8 __attribute__((ext_vector_type(8)));
typedef short s16x4 __attribute__((ext_vector_type(4)));
typedef float f32x4 __attribute__((ext_vector_type(4)));
typedef float f32x2 __attribute__((ext_vector_type(2)));
typedef float f32x16 __attribute__((ext_vector_type(16)));
typedef unsigned u32x4 __attribute__((ext_vector_type(4)));
typedef unsigned u32x2 __attribute__((ext_vector_type(2)));
typedef __bf16 bf16x2_t __attribute__((ext_vector_type(2)));

constexpr int D = 1024, BATCH = 4, SEQ = 8192, T = BATCH * SEQ, DFF = 3072, NE = 8, PLE = 256;
constexpr float EPS = 1e-6f;
constexpr float LOG2E = 1.4426950408889634f;
constexpr int XG_ROWS = 2 * T + 16 * 256;

__device__ __forceinline__ unsigned pk2(float lo, float hi) { f32x2 v = {lo, hi}; bf16x2_t b = __builtin_convertvector(v, bf16x2_t); return __builtin_bit_cast(unsigned, b); }
__device__ __forceinline__ float bflo(unsigned u) { return __uint_as_float(u << 16); }
__device__ __forceinline__ float bfhi(unsigned u) { return __uint_as_float(u & 0xffff0000u); }
__device__ __forceinline__ float amul(float a, float b) { float r; asm("v_mul_f32_e32 %0, %1, %2" : "=v"(r) : "v"(a), "v"(b)); return r; }
__device__ __forceinline__ float aadd(float a, float b) { float r; asm("v_add_f32_e32 %0, %1, %2" : "=v"(r) : "v"(a), "v"(b)); return r; }
__device__ __forceinline__ float asub(float a, float b) { float r; asm("v_sub_f32_e32 %0, %1, %2" : "=v"(r) : "v"(a), "v"(b)); return r; }
__device__ __forceinline__ float afma(float a, float b, float c) { float r; asm("v_fma_f32 %0, %1, %2, %3" : "=v"(r) : "v"(a), "v"(b), "v"(c)); return r; }
__device__ __forceinline__ void swiglu2(float g0, float u0, float g1, float u1, float n, float c, float& o0, float& o1) {
    float t0, t1, p0, p1;
    asm("v_mul_f32_e32 %0, %4, %8\n\tv_mul_f32_e32 %1, %6, %8\n\tv_exp_f32_e32 %0, %0\n\tv_exp_f32_e32 %1, %1\n\tv_mul_f32_e32 %2, %4, %5\n\t"
        "v_fma_f32 %0, %0, %9, %9\n\tv_fma_f32 %1, %1, %9, %9\n\tv_rcp_f32_e32 %0, %0\n\tv_rcp_f32_e32 %1, %1\n\tv_mul_f32_e32 %3, %6, %7\n\t"
        "v_mul_f32_e32 %0, %2, %0\n\tv_mul_f32_e32 %1, %3, %1"
        : "=&v"(t0), "=&v"(t1), "=&v"(p0), "=&v"(p1) : "v"(g0), "v"(u0), "v"(g1), "v"(u1), "v"(n), "v"(c));
    o0 = t0; o1 = t1;
}
__device__ __forceinline__ void plesig2(float a0, float a1, float n, float p0, float p1, float x0, float x1, float& o0, float& o1) {
    float t0, t1;
    asm("v_mul_f32_e32 %0, %2, %4\n\tv_mul_f32_e32 %1, %3, %4\n\tv_exp_f32_e32 %0, %0\n\tv_exp_f32_e32 %1, %1\n\ts_nop 0\n\tv_add_f32_e32 %0, 1.0, %0\n\tv_add_f32_e32 %1, 1.0, %1\n\t"
        "v_rcp_f32_e32 %0, %0\n\tv_rcp_f32_e32 %1, %1\n\ts_nop 0\n\tv_fma_f32 %0, %0, %5, %7\n\tv_fma_f32 %1, %1, %6, %8"
        : "=&v"(t0), "=&v"(t1) : "v"(a0), "v"(a1), "v"(n), "v"(p0), "v"(p1), "v"(x0), "v"(x1));
    o0 = t0; o1 = t1;
}
__device__ __forceinline__ void gelu2(float v0, float v1, float k1, float k2, float& o0, float& o1) {
    float t0, t1;
    asm("v_mul_f32_e32 %0, %2, %2\n\tv_mul_f32_e32 %1, %3, %3\n\tv_fma_f32 %0, %0, %5, %4\n\tv_fma_f32 %1, %1, %5, %4\n\tv_mul_f32_e32 %0, %0, %2\n\tv_mul_f32_e32 %1, %1, %3\n\t"
        "v_exp_f32_e32 %0, %0\n\tv_exp_f32_e32 %1, %1\n\ts_nop 0\n\tv_add_f32_e32 %0, 1.0, %0\n\tv_add_f32_e32 %1, 1.0, %1\n\tv_rcp_f32_e32 %0, %0\n\tv_rcp_f32_e32 %1, %1\n\ts_nop 0\n\t"
        "v_mul_f32_e32 %0, %2, %0\n\tv_mul_f32_e32 %1, %3, %1"
        : "=&v"(t0), "=&v"(t1) : "v"(v0), "v"(v1), "v"(k1), "v"(k2));
    o0 = t0; o1 = t1;
}
__device__ __forceinline__ float fsig(float x) { return __builtin_amdgcn_rcpf(1.0f + __builtin_amdgcn_exp2f(-LOG2E * x)); }
__device__ __forceinline__ float wave_sum(float v) {
#pragma unroll
    for (int o = 1; o < 64; o <<= 1) v += __shfl_xor(v, o);
    return v;
}
__device__ __forceinline__ u32x4 pack8(f32x4 a, f32x4 b) { u32x4 w; w.x = pk2(a[0], a[1]); w.y = pk2(a[2], a[3]); w.z = pk2(b[0], b[1]); w.w = pk2(b[2], b[3]); return w; }
__device__ __forceinline__ void unpack8(u32x4 w, f32x4& a, f32x4& b) { a[0] = bflo(w.x); a[1] = bfhi(w.x); a[2] = bflo(w.y); a[3] = bfhi(w.y); b[0] = bflo(w.z); b[1] = bfhi(w.z); b[2] = bflo(w.w); b[3] = bfhi(w.w); }

#ifndef WT_STORES
#define WT_STORES 0
#endif
__device__ __forceinline__ void st16(void* p, u32x4 v) {
#if WT_STORES
    asm volatile("global_store_dwordx4 %0, %1, off sc1\n\ts_nop 1" :: "v"(p), "v"(v) : "memory");
#else
    *(u32x4*)p = v;
#endif
}
__device__ __forceinline__ void st16f(void* p, f32x4 v) { st16(p, __builtin_bit_cast(u32x4, v)); }

typedef _Float16 f16x2_t __attribute__((ext_vector_type(2)));
__device__ __forceinline__ unsigned pack_h2(float a, float b) { f16x2_t v = {(_Float16)a, (_Float16)b}; return __builtin_bit_cast(unsigned, v); }
__device__ __forceinline__ void unpack_h2(unsigned w, float& a, float& b) { const f16x2_t v = __builtin_bit_cast(f16x2_t, w); a = (float)v.x; b = (float)v.y; }
#define SPLICE 0
#define ONE_LAUNCH 1
typedef __attribute__((address_space(1))) unsigned gu32;
#define RLX_AGENT __ATOMIC_RELAXED, __HIP_MEMORY_SCOPE_AGENT
#define XB_TMO      128
#define XB_XCNT(j)  (256  + 64 * (j))
#define XB_XSUB(j)  (1280 + 64 * (j))
#define XB_XGEN(j)  (2304 + 64 * (j))
#define XB_TOP      3328
#define XB_TOPGEN   3392
#define XCD_BAR_WORDS 3456
#define XB_SPIN_CAP (1u << 18)

__device__ __forceinline__ unsigned xb_ld(unsigned* p)              { return __hip_atomic_load(p, __ATOMIC_RELAXED, __HIP_MEMORY_SCOPE_AGENT); }
__device__ __forceinline__ unsigned xb_add(unsigned* p, unsigned v) { return __hip_atomic_fetch_add(p, v, __ATOMIC_RELAXED, __HIP_MEMORY_SCOPE_AGENT); }
__device__ __forceinline__ unsigned xb_xcc_id() { return (unsigned)__builtin_amdgcn_s_getreg((3 << 11) | 20) & 0xFu; }
#define XB_SPIN(cond, bar) do { unsigned _sp = 0; while (cond) { __builtin_amdgcn_s_sleep(1); \
    if ((++_sp & 255u) == 0u) { if (xb_ld(&(bar)[XB_TMO])) break; if (_sp > XB_SPIN_CAP) { atomicAdd(&(bar)[XB_TMO], 1u); break; } } } } while (0)

struct XcdBarrier {
    unsigned* bar; unsigned x;
    volatile LAS unsigned* st;
};

__device__ __forceinline__ XcdBarrier xcd_barrier_post(unsigned* bar, volatile LAS unsigned* st) {
    XcdBarrier b; b.bar = bar; b.x = xb_xcc_id(); b.st = st;
    if (threadIdx.x == 0) (void)xb_add(&bar[XB_XCNT(b.x)], 1u);
    return b;
}
__device__ __forceinline__ void xcd_barrier_complete(unsigned* bar, unsigned x, unsigned& nloc, unsigned& nx) {
    const unsigned G = gridDim.x * gridDim.y * gridDim.z;
    unsigned sum, cnt, mine, sp = 0u;
    for (;;) {
        sum = 0u; cnt = 0u; mine = 0u;
#pragma unroll
        for (unsigned j = 0; j < 16; ++j) { const unsigned c = xb_ld(&bar[XB_XCNT(j)]); sum += c; cnt += (c > 0u) ? 1u : 0u; mine = (j == x) ? c : mine; }
        if (sum == G) break;
        __builtin_amdgcn_s_sleep(1);
        if ((++sp & 255u) == 0u) { if (xb_ld(&bar[XB_TMO])) break; if (sp > XB_SPIN_CAP) { atomicAdd(&bar[XB_TMO], 1u); break; } }
    }
    nloc = mine > 0u ? mine : 1u; nx = cnt > 0u ? cnt : 1u;
}

__device__ __forceinline__ void xcd_barrier(const XcdBarrier& b) {
    asm volatile("s_waitcnt vmcnt(0)" ::: "memory");
    __syncthreads();
    if (threadIdx.x == 0) {
        unsigned* bar = b.bar;
        __builtin_amdgcn_s_waitcnt(0);
        unsigned nloc = b.st[0], nx = b.st[1];
        if (nloc == 0u) { xcd_barrier_complete(bar, b.x, nloc, nx); b.st[0] = nloc; b.st[1] = nx; }
        const unsigned old = xb_add(&bar[XB_XSUB(b.x)], 1u);
        const unsigned gen = old / nloc;
        if (old + 1u == (gen + 1u) * nloc) {
            __builtin_amdgcn_fence(__ATOMIC_RELEASE, "agent");
            asm volatile("s_waitcnt vmcnt(0)" ::: "memory");
            const unsigned og = xb_add(&bar[XB_TOP], 1u);
            const unsigned tg = og / nx;
            __builtin_amdgcn_fence(__ATOMIC_ACQUIRE, "agent");
            if (og + 1u == (tg + 1u) * nx) xb_add(&bar[XB_TOPGEN], 1u);
            else XB_SPIN(xb_ld(&bar[XB_TOPGEN]) == tg, bar);
            xb_add(&bar[XB_XGEN(b.x)], 1u);
            asm volatile("s_waitcnt vmcnt(0)" ::: "memory");
        } else {
            __builtin_amdgcn_fence(__ATOMIC_ACQUIRE, "agent");
            XB_SPIN(xb_ld(&bar[XB_XGEN(b.x)]) == gen, bar);
            asm volatile("s_waitcnt vmcnt(0)" ::: "memory");
        }
    }
    __syncthreads();
}

namespace pg8 {
constexpr int BM = 256, BK = 64, HALF = 128, HTB = HALF * BK * 2, STAGE_BYTES = 8 * HTB, NXCD = 8, WGM = 8;
__host__ __device__ __forceinline__ int lds_byte(int r, int c) { const int st = (r >> 4) * 2 + (c >> 5), rr = r & 15, cc = c & 31, ob = rr * 64 + cc * 2; return st * 1024 + (ob ^ (((ob >> 9) & 1) << 5)); }
__host__ __device__ __forceinline__ void stage_rc(int b, int& R, int& C) { const int st = b / 1024, sb = b % 1024, swz = sb ^ (((sb >> 9) & 1) << 5); R = (st >> 1) * 16 + swz / 64; C = (st & 1) * 32 + (swz % 64) / 2; }
__host__ __device__ __forceinline__ int perm32(int rho) { const int n = rho >> 4, i = rho & 15; return 8 * (i >> 2) + 4 * n + (i & 3); }

struct Unit { unsigned aoff, boff; int pm, pn, rb, half; };
struct Gemm { const char* A; const char* Bt; unsigned lda2, ldb2, hstepA; int K; int aperm; };

struct OrderBase {
    int nM, nN, nwg, G, c;
    __device__ __forceinline__ void init(int nM_, int nN_, int G_, int c_) { nM = nM_; nN = nN_; nwg = nM * nN; G = G_; c = c_; }
    __device__ __forceinline__ bool tile(int i, int& pm, int& pn) const {
        const long L = (long)i * G + c; if (L >= nwg) return false;
        int wgid = (int)L; { const int q = nwg / NXCD, r = nwg % NXCD, xcd = wgid % NXCD, off = wgid / NXCD; wgid = (xcd < r ? xcd * (q + 1) : r * (q + 1) + (xcd - r) * q) + off; }
        const int nig = WGM * nN, gid = wgid / nig, fm = gid * WGM, gsz = (nM - fm) < WGM ? (nM - fm) : WGM;
        pm = fm + ((wgid % nig) % gsz); pn = (wgid % nig) / gsz; return true;
    }
};
struct OrderHalf : OrderBase {
    __device__ __forceinline__ bool tileh(int i, int& pm, int& pn, int& half) const {
        const int nfull = (nwg / G) * G, rem = nwg - nfull; const bool split = rem > 0 && 2 * rem <= G;
        const long L = (long)i * G + c; int t;
        if (L < nfull || !split) { if (L >= nwg) return false; t = (int)L; half = 0; }
        else { const int x = (int)(L - nfull); if (x >= 2 * rem) return false; t = nfull + (x >> 1); half = 1 + (x & 1); }
        int wgid = t; { const int q = nwg / NXCD, r = nwg % NXCD, xcd = wgid % NXCD, off = wgid / NXCD; wgid = (xcd < r ? xcd * (q + 1) : r * (q + 1) + (xcd - r) * q) + off; }
        const int nig = WGM * nN, gid = wgid / nig, fm = gid * WGM, gsz = (nM - fm) < WGM ? (nM - fm) : WGM;
        pm = fm + ((wgid % nig) % gsz); pn = (wgid % nig) / gsz; return true;
    }
};
__device__ __forceinline__ int last_round_busy(int nwg, int G, bool halves) { const int rem = nwg % G; if (rem == 0) return 0; return (halves && 2 * rem <= G) ? 2 * rem : rem; }
struct OrdStd : OrderBase {
    unsigned atile, btile;
    __device__ __forceinline__ bool next(int i, Unit& u) const { if (!tile(i, u.pm, u.pn)) return false; u.aoff = (unsigned)u.pm * atile; u.boff = (unsigned)u.pn * btile; u.rb = u.pm * 256; u.half = 0; return true; }
};
struct OrdStdH : OrderHalf {
    unsigned atile, btile;
    __device__ __forceinline__ bool next(int i, Unit& u) const { if (!tileh(i, u.pm, u.pn, u.half)) return false; u.rb = u.pm * 256 + (u.half == 2 ? 128 : 0); u.aoff = (unsigned)u.pm * atile + (u.half == 2 ? atile / 2 : 0u); u.boff = (unsigned)u.pn * btile; return true; }
};

template <class Epi, class Sched, bool GATHER = false, bool HALFOK = false>
__device__ __forceinline__ void gemm_phase(LAS unsigned char* lds, const Gemm g, const Sched& S, const Epi& E) {
    const int tid = threadIdx.x, wid = __builtin_amdgcn_readfirstlane(tid >> 6), lane = tid & 63, wr = wid >> 2, wc = wid & 3, fr = lane & 15, fq = lane >> 4;
    int nt = g.K / BK; asm volatile("" : "+s"(nt));
    unsigned voffA[2], voffB[2]; int Rrow[2];
#pragma unroll
    for (int i = 0; i < 2; ++i) { int R, C; stage_rc(tid * 16 + i * 8192, R, C); const int Rb = Epi::PERM ? ((R & ~31) + perm32(R & 31)) : R;
        const int Ra = g.aperm ? (8 * ((R & 15) + 16 * (R >> 6)) + ((R >> 4) & 3)) : R;
        voffA[i] = GATHER ? (unsigned)C * 2u : (unsigned)Ra * g.lda2 + (unsigned)C * 2u; voffB[i] = (unsigned)Rb * g.ldb2 + (unsigned)C * 2u; Rrow[i] = R; }
    const size_t kstep = (size_t)(BK * 2);
    const size_t hstepA = g.hstepA, hstepB = (size_t)HALF * g.ldb2;
    const unsigned ldsw = (unsigned)wid * 1024u;
    const int aoff = lds_byte(wr * 64 + fr, fq * 8), boff = lds_byte(wc * 32 + fr, fq * 8);
#define PG8_SA(b, h) (((b) * 2 + (h)) * HTB)
#define PG8_SB(b, h) ((4 + (b) * 2 + (h)) * HTB)
#define PG8_STAGE(bufoff, gbase, voff) do { _Pragma("unroll") for (int _i = 0; _i < 2; ++_i) \
        __builtin_amdgcn_global_load_lds((const unsigned*)((const char*)(gbase) + (voff)[_i]), (LAS unsigned*)(lds + (bufoff) + ldsw + _i * 8192), 16, 0, 0); } while (0)
#define PG8_STAGE_A(bufoff, h, kptr, koff, usenext) do { if constexpr (GATHER) { unsigned vo_[2]; _Pragma("unroll") for (int _i = 0; _i < 2; ++_i) vo_[_i] = (usenext) ? gaN[h][_i] : gaC[h][_i]; \
        PG8_STAGE(bufoff, g.A + (koff), vo_); } else { PG8_STAGE(bufoff, (kptr) + (h) * hstepA, voffA); } } while (0)
#define PG8_LDA(dst, b, h) do { _Pragma("unroll") for (int m = 0; m < 4; ++m) _Pragma("unroll") for (int k = 0; k < 2; ++k) dst[m][k] = *(const LAS bf16x8*)(lds + PG8_SA(b, h) + aoff + m * 2048 + k * 1024); } while (0)
#define PG8_LDB(dst, b, h) do { _Pragma("unroll") for (int n = 0; n < 2; ++n) _Pragma("unroll") for (int k = 0; k < 2; ++k) dst[n][k] = *(const LAS bf16x8*)(lds + PG8_SB(b, h) + boff + n * 2048 + k * 1024); } while (0)
#define PG8_MMA(ai, bj, At, Bt) do { __builtin_amdgcn_s_setprio(1); _Pragma("unroll") for (int m = 0; m < 4; ++m) _Pragma("unroll") for (int n = 0; n < 2; ++n) _Pragma("unroll") for (int k = 0; k < 2; ++k) \
        acc[ai][bj][m][n] = __builtin_amdgcn_mfma_f32_16x16x32_bf16(Bt[n][k], At[m][k], acc[ai][bj][m][n], 0, 0, 0); __builtin_amdgcn_s_setprio(0); } while (0)
#define PG8_WAIT_V(n) asm volatile("s_waitcnt vmcnt(" #n ")" ::: "memory")
#define PG8_WAIT_L(n) asm volatile("s_waitcnt lgkmcnt(" #n ")" ::: "memory")
#define PG8_BAR __builtin_amdgcn_s_barrier()
#define PG8_SCHED __builtin_amdgcn_sched_barrier(0)
    Unit cur, nxt; int ui = 0;
    if (!S.next(0, cur)) return;
    f32x4 acc[2][2][4][2];
#pragma unroll
    for (int a = 0; a < 2; ++a)
#pragma unroll
        for (int b = 0; b < 2; ++b)
#pragma unroll
            for (int m = 0; m < 4; ++m)
#pragma unroll
                for (int n = 0; n < 2; ++n) acc[a][b][m][n] = (f32x4){0.f, 0.f, 0.f, 0.f};
    bf16x8 At[4][2], B0[2][2], B1[2][2];
    LAS unsigned* pbuf = (LAS unsigned*)(lds + 147456 + wid * 2048);
    typename Epi::Pre pre; E.prefetch(cur, wr, wc, fr, fq, pre, pbuf);
    const char* cA = g.A + cur.aoff; const char* cB = g.Bt + cur.boff;
    unsigned gaC[2][2], gaN[2][2];
    if constexpr (GATHER) {
#pragma unroll
        for (int h = 0; h < 2; ++h)
#pragma unroll
            for (int i = 0; i < 2; ++i) { const int tk = (HALFOK && cur.half && h == 1) ? 0 : S.toklist[cur.rb + h * 128 + Rrow[i]]; gaC[h][i] = (unsigned)(tk < 0 ? 0 : tk) * g.lda2 + voffA[i]; gaN[h][i] = gaC[h][i]; } }
    PG8_STAGE(PG8_SB(0, 0), cB, voffB); PG8_STAGE(PG8_SB(0, 1), cB + hstepB, voffB); PG8_STAGE_A(PG8_SA(0, 0), 0, cA, 0, false); PG8_STAGE_A(PG8_SA(0, 1), 1, cA, 0, false);
    if (wr == 1) PG8_BAR;
    PG8_WAIT_V(2); PG8_BAR;
    PG8_STAGE(PG8_SB(1, 0), cB + kstep, voffB); PG8_STAGE_A(PG8_SA(1, 0), 0, cA + kstep, kstep, false); PG8_STAGE(PG8_SB(1, 1), cB + hstepB + kstep, voffB);
    PG8_WAIT_V(6); PG8_BAR;
    for (;;) {
        const bool fullu = cur.half == 0;
        const bool has_next = S.next(ui + 1, nxt);
        const char* nA = has_next ? g.A + nxt.aoff : cA; const char* nB = has_next ? g.Bt + nxt.boff : cB;
        if constexpr (GATHER) { if (has_next) {
#pragma unroll
            for (int h = 0; h < 2; ++h)
#pragma unroll
                for (int i = 0; i < 2; ++i) { const int tk = (HALFOK && nxt.half && h == 1) ? 0 : S.toklist[nxt.rb + h * 128 + Rrow[i]]; gaN[h][i] = (unsigned)(tk < 0 ? 0 : tk) * g.lda2 + voffA[i]; } } }
#pragma unroll 1
        for (int t = 0; t < nt; t += 2) {
            const bool last = (t == nt - 2);
            const char* a1 = cA + (size_t)(t + 1) * kstep;
            const char* a2 = last ? nA : cA + (size_t)(t + 2) * kstep; const char* b2 = last ? nB : cB + (size_t)(t + 2) * kstep;
            const char* a3 = a2 + kstep; const char* b3 = b2 + kstep;
            const size_t k1 = (size_t)(t + 1) * kstep, k2 = last ? 0 : (size_t)(t + 2) * kstep, k3 = k2 + kstep;
            PG8_LDB(B0, 0, 0); PG8_LDB(B1, 0, 1); PG8_SCHED; PG8_LDA(At, 0, 0); PG8_STAGE_A(PG8_SA(1, 1), 1, a1, k1, false);
            PG8_WAIT_V(8); PG8_WAIT_L(0); PG8_BAR; PG8_MMA(0, 0, At, B0); PG8_MMA(0, 1, At, B1); PG8_BAR; PG8_SCHED;
            PG8_LDA(At, 0, 1); PG8_STAGE(PG8_SB(0, 0), b2, voffB); PG8_STAGE(PG8_SB(0, 1), b2 + hstepB, voffB); PG8_STAGE_A(PG8_SA(0, 0), 0, a2, k2, last);
            PG8_WAIT_V(8); PG8_WAIT_L(0); PG8_BAR; if (!HALFOK || fullu) { PG8_MMA(1, 0, At, B0); PG8_MMA(1, 1, At, B1); } PG8_BAR; PG8_SCHED;
            PG8_LDB(B0, 1, 0); PG8_LDB(B1, 1, 1); PG8_SCHED; PG8_LDA(At, 1, 0); PG8_STAGE_A(PG8_SA(0, 1), 1, a2, k2, last);
            PG8_WAIT_V(8); PG8_WAIT_L(0); PG8_BAR; PG8_MMA(0, 0, At, B0); PG8_MMA(0, 1, At, B1); PG8_BAR; PG8_SCHED;
            PG8_LDA(At, 1, 1); PG8_STAGE(PG8_SB(1, 0), b3, voffB); PG8_STAGE(PG8_SB(1, 1), b3 + hstepB, voffB); PG8_STAGE_A(PG8_SA(1, 0), 0, a3, k3, last);
            PG8_WAIT_V(8); PG8_WAIT_L(0); PG8_BAR; if (!HALFOK || fullu) { PG8_MMA(1, 0, At, B0); PG8_MMA(1, 1, At, B1); } PG8_BAR; PG8_SCHED;
        }
        if (wr == 0) PG8_BAR;
        if constexpr (Epi::EARLYPF) {
            typename Epi::Regs rg; E.consume(cur, wr, wc, fr, fq, pbuf, rg);
            asm volatile("s_waitcnt lgkmcnt(0)" ::: "memory");
            if (has_next) E.prefetch(nxt, wr, wc, fr, fq, pre, pbuf);
            E.body(acc, cur, wr, wc, fr, fq, rg);
        } else E(acc, cur, wr, wc, fr, fq, pre, pbuf);
        if (!has_next) break;
#pragma unroll
        for (int a = 0; a < 2; ++a)
#pragma unroll
            for (int b = 0; b < 2; ++b)
#pragma unroll
                for (int m = 0; m < 4; ++m)
#pragma unroll
                    for (int n = 0; n < 2; ++n) acc[a][b][m][n] = (f32x4){0.f, 0.f, 0.f, 0.f};
        cur = nxt; cA = nA; cB = nB; ++ui;
        if constexpr (!Epi::EARLYPF) {
            asm volatile("s_waitcnt lgkmcnt(0)" ::: "memory");
            E.prefetch(cur, wr, wc, fr, fq, pre, pbuf); }
        if constexpr (GATHER) {
#pragma unroll
            for (int h = 0; h < 2; ++h)
#pragma unroll
                for (int i = 0; i < 2; ++i) gaC[h][i] = gaN[h][i]; }
        if (wr == 1) PG8_BAR;
    }
    PG8_WAIT_V(0);
    PG8_BAR;
#undef PG8_SA
#undef PG8_SB
#undef PG8_STAGE
#undef PG8_STAGE_A
#undef PG8_LDA
#undef PG8_LDB
#undef PG8_MMA
#undef PG8_WAIT_V
#undef PG8_WAIT_L
#undef PG8_BAR
#undef PG8_SCHED
}
}
using pg8::Unit; using pg8::Gemm; using pg8::OrdStd; using pg8::gemm_phase;
typedef f32x4 Acc[2][2][4][2];
struct NoPre {};
__device__ __forceinline__ void dma4(const void* gsrc, LAS unsigned* pbuf, int k) { __builtin_amdgcn_global_load_lds((const unsigned*)gsrc, pbuf + k * 64, 4, 0, 0); }
__device__ __forceinline__ LAS unsigned* pbuf2_of(LAS unsigned* pbuf) { const int wid = threadIdx.x >> 6; return pbuf - (147456 / 4 + wid * 512) + ((131072 + 1024) / 4 + wid * 128); }
#define EPI_NOPRE typedef NoPre Pre; __device__ __forceinline__ void prefetch(const Unit&, int, int, int, int, Pre&, LAS unsigned*) const {}
#define EPI_ROW(u, ai, wr, m, fr) ((u).rb + (ai) * 128 + (wr) * 64 + (m) * 16 + (fr))
#define EPI_NA(u) ((u).half ? 1 : 2)

#define SS1_IDX(row, pn) ((size_t)(pn) * T + (size_t)(row))
struct Pre8 { float v[2][4]; };
__device__ __forceinline__ void ss_prefetch(const float* SS, const Unit& u, int wr, int fr, int fq, Pre8& p) {
#pragma unroll
    for (int ai = 0; ai < 2; ++ai)
#pragma unroll
        for (int m = 0; m < 4; ++m) p.v[ai][m] = SS[SS1_IDX(EPI_ROW(u, ai, wr, m, fr), fq)];
}
__device__ __forceinline__ void ss16_prefetch(const float* SS, const Unit& u, int wr, int fr, int fq, Pre8& p) {
#pragma unroll
    for (int ai = 0; ai < 2; ++ai)
#pragma unroll
        for (int m = 0; m < 4; ++m) { const f32x4 v = *(const f32x4*)(SS + (size_t)EPI_ROW(u, ai, wr, m, fr) * 16 + fq * 4); p.v[ai][m] = (v[0] + v[1]) + (v[2] + v[3]); }
}
__device__ __forceinline__ void ss_finish(const Pre8& p, float (&rs)[2][4]) {
#pragma unroll
    for (int ai = 0; ai < 2; ++ai)
#pragma unroll
        for (int m = 0; m < 4; ++m) { float s = p.v[ai][m]; s += __shfl_xor(s, 16); s += __shfl_xor(s, 32); rs[ai][m] = 1.0f / sqrtf(s * (1.0f / D) + EPS); }
}
__device__ __forceinline__ void ss_stage(LAS float* sst, int ai, int wr, int m, int fr, int wc, int fq, float ss) { if (fq == 0) sst[(ai * 128 + wr * 64 + m * 16 + fr) * 4 + wc] = ss; }
__device__ __forceinline__ void ss_flush(LAS float* sst, float* SS, const Unit& u, const int* toklist) {
    asm volatile("s_waitcnt lgkmcnt(0)" ::: "memory"); __syncthreads();
    const int t = threadIdx.x;
    if (t < (u.half ? 128 : 256)) { const f32x4 v = *(const LAS f32x4*)(sst + t * 4); int row = u.rb + t; if (toklist) row = toklist[row];
        if (row >= 0) SS[SS1_IDX(row, u.pn)] = (v[0] + v[1]) + (v[2] + v[3]); }
}
__device__ __forceinline__ float sumsq8(f32x4 a, f32x4 b) { float s0 = amul(a[0], a[0]), s1 = amul(b[0], b[0]);
#pragma unroll
    for (int i = 1; i < 4; ++i) { s0 = afma(a[i], a[i], s0); s1 = afma(b[i], b[i], s1); }
    return aadd(s0, s1); }
__device__ __forceinline__ f32x4 aadd4(f32x4 a, f32x4 b) { f32x4 r; r[0] = aadd(a[0], b[0]); r[1] = aadd(a[1], b[1]); r[2] = aadd(a[2], b[2]); r[3] = aadd(a[3], b[3]); return r; }
__device__ __forceinline__ f32x4 amul4(f32x4 a, float b) { f32x4 r; r[0] = amul(a[0], b); r[1] = amul(a[1], b); r[2] = amul(a[2], b); r[3] = amul(a[3], b); return r; }
__device__ __forceinline__ void put_ss(float* SS, int row, int slot, float ss, int fq) {
    ss += __shfl_xor(ss, 16); ss += __shfl_xor(ss, 32);
    if (fq == 0) SS[(size_t)row * 16 + slot] = ss;
}

struct EpiNull {
    static constexpr bool PERM = true; static constexpr bool EARLYPF = false; EPI_NOPRE
    float* sink;
    __device__ __forceinline__ void operator()(Acc& acc, const Unit& u, int wr, int wc, int fr, int fq, const Pre&, LAS unsigned* pbuf) const {
        float z = 0.f;
#pragma unroll
        for (int ai = 0; ai < 2; ++ai)
#pragma unroll
            for (int bj = 0; bj < 2; ++bj)
#pragma unroll
                for (int m = 0; m < 4; ++m)
#pragma unroll
                    for (int n = 0; n < 2; ++n) z += (acc[ai][bj][m][n][0] + acc[ai][bj][m][n][1]) + (acc[ai][bj][m][n][2] + acc[ai][bj][m][n][3]);
        if (z == 1.2345e-30f) sink[0] = z;
    }
};
struct EpiBf16 {
    static constexpr bool PERM = true; static constexpr bool EARLYPF = false; EPI_NOPRE
    bf16_t* O; int ldc;
    __device__ __forceinline__ void operator()(Acc& acc, const Unit& u, int wr, int wc, int fr, int fq, const Pre&, LAS unsigned* pbuf) const {
        const int col0 = u.pn * 256 + wc * 32 + 8 * fq;
#pragma unroll
        for (int ai = 0; ai < 2; ++ai)
#pragma unroll
            for (int m = 0; m < 4; ++m) { bf16_t* rowp = O + (size_t)EPI_ROW(u, ai, wr, m, fr) * ldc + col0;
#pragma unroll
                for (int bj = 0; bj < 2; ++bj) st16(rowp + bj * 128, pack8(acc[ai][bj][m][0], acc[ai][bj][m][1])); }
    }
};
struct EpiInProj {
    static constexpr bool PERM = true; static constexpr bool EARLYPF = false; typedef NoPre Pre;
    bf16_t* gate; bf16_t* xb; const float* rstd0;
    __device__ __forceinline__ void prefetch(const Unit& u, int wr, int wc, int fr, int fq, Pre&, LAS unsigned* pbuf) const {
#pragma unroll
        for (int ai = 0; ai < 2; ++ai)
#pragma unroll
            for (int m = 0; m < 4; ++m) dma4(rstd0 + EPI_ROW(u, ai, wr, m, fr), pbuf, ai * 4 + m);
    }
    __device__ __forceinline__ void operator()(Acc& acc, const Unit& u, int wr, int wc, int fr, int fq, const Pre&, LAS unsigned* pbuf) const {
        const bool isg = u.pn < 4;
        bf16_t* dst = isg ? gate : xb;
        const int col0 = (u.pn & 3) * 256 + wc * 32 + 8 * fq;
#pragma unroll
        for (int ai = 0; ai < 2; ++ai)
#pragma unroll
            for (int m = 0; m < 4; ++m) { const int row = EPI_ROW(u, ai, wr, m, fr); const float rs = __uint_as_float(pbuf[(ai * 4 + m) * 64 + (threadIdx.x & 63)]); bf16_t* rowp = dst + (size_t)row * D + col0;
#pragma unroll
                for (int bj = 0; bj < 2; ++bj) { f32x4 v0 = amul4(acc[ai][bj][m][0], rs), v1 = amul4(acc[ai][bj][m][1], rs);
                    if (isg) {
#pragma unroll
                        for (int i = 0; i < 4; ++i) {
                            float r0, r1; gelu2(v0[i], v1[i], -2.302208198f, -0.10294324f, r0, r1); v0[i] = r0; v1[i] = r1; }
                    }
                    st16(rowp + bj * 128, pack8(v0, v1)); } }
    }
};
struct EpiGates {
    static constexpr bool PERM = true; static constexpr bool EARLYPF = false; EPI_NOPRE
    const bf16_t* xc; const float* bga; const float* bgx; const float* c8g; bf16_t* hl; bf16_t* pc; float* aggA; float* aggH;
    __device__ __forceinline__ void operator()(Acc& acc, const Unit& u, int wr, int wc, int fr, int fq, const Pre&, LAS unsigned* pbuf) const {
        const int ch0 = (u.pn >> 1) * 256 + (u.pn & 1) * 128 + wc * 32 + 8 * fq;
        const int t0 = u.pm * 256 + 8 * (fr + 16 * wr);
        u32x4 xw[8]; u32x2 hkeep[8], pkeep[8];
        { const bf16_t* xp = xc + (size_t)t0 * D + ch0;
#pragma unroll
          for (int j = 0; j < 8; ++j) xw[j] = *(const u32x4*)(xp + j * D); }
#pragma unroll
        for (int n = 0; n < 2; ++n) { const int ch = ch0 + 4 * n;
            __builtin_amdgcn_sched_barrier(0);
            const f32x4 ba = *(const f32x4*)(bga + ch), bx = *(const f32x4*)(bgx + ch), c8 = *(const f32x4*)(c8g + ch);
            float hp[4], pp[4];
#pragma unroll
            for (int i = 0; i < 4; ++i) { hp[i] = 0.f; pp[i] = 1.f; }
#pragma unroll
            for (int j = 0; j < 8; ++j) { const int ai = j >> 2, m = j & 3; const bool first = ((t0 + j) & (SEQ - 1)) == 0;
                const unsigned xa = n ? xw[j].z : xw[j].x, xb2 = n ? xw[j].w : xw[j].y;
                const float xv[4] = {bflo(xa), bfhi(xa), bflo(xb2), bfhi(xb2)};
#pragma unroll
                for (int i = 0; i < 4; ++i) {
                    const float rr = fsig(acc[ai][0][m][n][i] + ba[i]), ii = fsig(acc[ai][1][m][n][i] + bx[i]);
                    const float a = __builtin_amdgcn_exp2f(c8[i] * rr);
                    const float mult = first ? 1.0f : __builtin_amdgcn_sqrtf(fmaf(-a, a, 1.0f));
                    const float b = mult * ii * xv[i];
                    hp[i] = fmaf(a, hp[i], b); pp[i] *= a;
                    acc[ai][0][m][n][i] = hp[i]; acc[ai][1][m][n][i] = pp[i]; }
                __builtin_amdgcn_sched_barrier(0); }
#pragma unroll
            for (int d = 1; d < 16; d <<= 1)
#pragma unroll
                for (int i = 0; i < 4; ++i) { const float Ao = __shfl_up(pp[i], d, 16), Ho = __shfl_up(hp[i], d, 16);
                    if (fr >= d) { hp[i] = fmaf(pp[i], Ho, hp[i]); pp[i] *= Ao; } }
            float Ae[4], He[4];
#pragma unroll
            for (int i = 0; i < 4; ++i) { const float Ao = __shfl_up(pp[i], 1, 16), Ho = __shfl_up(hp[i], 1, 16); Ae[i] = fr ? Ao : 1.0f; He[i] = fr ? Ho : 0.0f; }
            if (fr == 15) { const int chunk = 2 * u.pm + wr;
                st16f(aggA + (size_t)chunk * D + ch, (f32x4){pp[0], pp[1], pp[2], pp[3]}); st16f(aggH + (size_t)chunk * D + ch, (f32x4){hp[0], hp[1], hp[2], hp[3]}); }
            { bf16_t* hq = hl + (size_t)t0 * D + ch0; bf16_t* pq = pc + (size_t)t0 * D + ch0;
#pragma unroll
              for (int j = 0; j < 8; ++j) { const int ai = j >> 2, m = j & 3; f32x4 hv, pv;
#pragma unroll
                for (int i = 0; i < 4; ++i) { hv[i] = fmaf(acc[ai][1][m][n][i], He[i], acc[ai][0][m][n][i]); pv[i] = acc[ai][1][m][n][i] * Ae[i]; }
                u32x2 hw, pw; hw.x = pk2(hv[0], hv[1]); hw.y = pk2(hv[2], hv[3]); pw.x = pk2(pv[0], pv[1]); pw.y = pk2(pv[2], pv[3]);
                if (n == 0) { hkeep[j] = hw; pkeep[j] = pw; }
                else { st16(hq + j * D, (u32x4){hkeep[j].x, hkeep[j].y, hw.x, hw.y}); st16(pq + j * D, (u32x4){pkeep[j].x, pkeep[j].y, pw.x, pw.y}); } } }
        }
    }
};
struct EpiGatesF {
    static constexpr bool PERM = true; static constexpr bool EARLYPF = false; EPI_NOPRE
    const bf16_t* xc; const float* bga; const float* bgx; const float* c8g; const bf16_t* gate; bf16_t* y; float* aggA; float* aggH; float* rc; const XcdBarrier* xb;
    __device__ __forceinline__ void operator()(Acc& acc, const Unit& u, int wr, int wc, int fr, int fq, const Pre&, LAS unsigned* pbuf) const {
        const int ch0 = (u.pn >> 1) * 256 + (u.pn & 1) * 128 + wc * 32 + 8 * fq;
        const int t0 = u.pm * 256 + 8 * (fr + 16 * wr);
        const int chunk = 2 * u.pm + wr;
        { u32x4 xw[8];
          { const bf16_t* xp = xc + (size_t)t0 * D + ch0;
#pragma unroll
            for (int j = 0; j < 8; ++j) xw[j] = *(const u32x4*)(xp + j * D); }
#pragma unroll
          for (int n = 0; n < 2; ++n) { const int ch = ch0 + 4 * n;
            __builtin_amdgcn_sched_barrier(0);
            const f32x4 ba = *(const f32x4*)(bga + ch), bx = *(const f32x4*)(bgx + ch), c8 = *(const f32x4*)(c8g + ch);
            float hp[4], pp[4];
#pragma unroll
            for (int i = 0; i < 4; ++i) { hp[i] = 0.f; pp[i] = 1.f; }
#pragma unroll
            for (int j = 0; j < 8; ++j) { const int ai = j >> 2, m = j & 3; const bool first = ((t0 + j) & (SEQ - 1)) == 0;
                const unsigned xa = n ? xw[j].z : xw[j].x, xb2 = n ? xw[j].w : xw[j].y;
                const float xv[4] = {bflo(xa), bfhi(xa), bflo(xb2), bfhi(xb2)};
#pragma unroll
                for (int i = 0; i < 4; ++i) {
                    const float rr = fsig(acc[ai][0][m][n][i] + ba[i]), ii = fsig(acc[ai][1][m][n][i] + bx[i]);
                    const float a = __builtin_amdgcn_exp2f(c8[i] * rr);
                    const float mult = first ? 1.0f : __builtin_amdgcn_sqrtf(fmaf(-a, a, 1.0f));
                    const float b = mult * ii * xv[i];
                    hp[i] = fmaf(a, hp[i], b); pp[i] *= a;
                    acc[ai][0][m][n][i] = hp[i]; acc[ai][1][m][n][i] = pp[i]; }
                __builtin_amdgcn_sched_barrier(0); }
#pragma unroll
            for (int d = 1; d < 16; d <<= 1)
#pragma unroll
                for (int i = 0; i < 4; ++i) { const float Ao = __shfl_up(pp[i], d, 16), Ho = __shfl_up(hp[i], d, 16);
                    if (fr >= d) { hp[i] = fmaf(pp[i], Ho, hp[i]); pp[i] *= Ao; } }
            float Ae[4], He[4];
#pragma unroll
            for (int i = 0; i < 4; ++i) { const float Ao = __shfl_up(pp[i], 1, 16), Ho = __shfl_up(hp[i], 1, 16); Ae[i] = fr ? Ao : 1.0f; He[i] = fr ? Ho : 0.0f; }
            if (fr == 15) { st16f(aggA + (size_t)chunk * D + ch, (f32x4){pp[0], pp[1], pp[2], pp[3]}); st16f(aggH + (size_t)chunk * D + ch, (f32x4){hp[0], hp[1], hp[2], hp[3]}); }
#pragma unroll
            for (int j = 0; j < 8; ++j) { const int ai = j >> 2, m = j & 3;
#pragma unroll
                for (int i = 0; i < 4; ++i) { const float P = acc[ai][1][m][n][i]; acc[ai][0][m][n][i] = fmaf(P, He[i], acc[ai][0][m][n][i]); acc[ai][1][m][n][i] = P * Ae[i]; } }
          } }
        xcd_barrier(*xb);
        const int b = u.pm >> 5, tt = u.pm & 31, rnd = tt >> 3, c0 = b * 64 + 16 * rnd;
        f32x4 cr0 = {0.f, 0.f, 0.f, 0.f}, cr1 = {0.f, 0.f, 0.f, 0.f};
        if (rnd > 0) { const float* rp = rc + ((size_t)(b * 4 + rnd)) * D + ch0; cr0 = *(const f32x4*)rp; cr1 = *(const f32x4*)(rp + 4); }
        for (int cc = c0; cc < chunk; ++cc) { const f32x4 a0 = *(const f32x4*)(aggA + (size_t)cc * D + ch0), a1 = *(const f32x4*)(aggA + (size_t)cc * D + ch0 + 4);
            const f32x4 h0 = *(const f32x4*)(aggH + (size_t)cc * D + ch0), h1 = *(const f32x4*)(aggH + (size_t)cc * D + ch0 + 4);
#pragma unroll
            for (int i = 0; i < 4; ++i) { cr0[i] = fmaf(a0[i], cr0[i], h0[i]); cr1[i] = fmaf(a1[i], cr1[i], h1[i]); } }
        if ((tt & 7) == 7 && wr == 1 && rnd < 3 && fr == 0) {
            const f32x4 a0 = *(const f32x4*)(aggA + (size_t)chunk * D + ch0), a1 = *(const f32x4*)(aggA + (size_t)chunk * D + ch0 + 4);
            const f32x4 h0 = *(const f32x4*)(aggH + (size_t)chunk * D + ch0), h1 = *(const f32x4*)(aggH + (size_t)chunk * D + ch0 + 4);
            f32x4 e0, e1;
#pragma unroll
            for (int i = 0; i < 4; ++i) { e0[i] = fmaf(a0[i], cr0[i], h0[i]); e1[i] = fmaf(a1[i], cr1[i], h1[i]); }
            float* rp = rc + ((size_t)(b * 4 + rnd + 1)) * D + ch0; st16f(rp, e0); st16f(rp + 4, e1); }
        { u32x4 gw[8]; const bf16_t* gp = gate + (size_t)t0 * D + ch0;
#pragma unroll
          for (int j = 0; j < 8; ++j) gw[j] = *(const u32x4*)(gp + j * D);
          bf16_t* yp = y + (size_t)t0 * D + ch0;
#pragma unroll
          for (int j = 0; j < 8; ++j) { const int ai = j >> 2, m = j & 3; f32x4 g0, g1, o0, o1; unpack8(gw[j], g0, g1);
#pragma unroll
            for (int i = 0; i < 4; ++i) { o0[i] = fmaf(acc[ai][1][m][0][i], cr0[i], acc[ai][0][m][0][i]) * g0[i]; o1[i] = fmaf(acc[ai][1][m][1][i], cr1[i], acc[ai][0][m][1][i]) * g1[i]; }
            st16(yp + j * D, pack8(o0, o1)); } }
    }
};
template <bool RF32> struct EpiRes {
    static constexpr bool PERM = true; static constexpr bool EARLYPF = false; EPI_NOPRE
    const void* R; bf16_t* X; float* SS; LAS float* sst;
    __device__ __forceinline__ void operator()(Acc& acc, const Unit& u, int wr, int wc, int fr, int fq, const Pre&, LAS unsigned* pbuf) const {
        const int col0 = u.pn * 256 + wc * 32 + 8 * fq;
        if (RF32) {
#pragma unroll
            for (int ai = 0; ai < 2; ++ai) { f32x4 rv[4][2][2];
#pragma unroll
                for (int m = 0; m < 4; ++m)
#pragma unroll
                    for (int bj = 0; bj < 2; ++bj) { const float* rp = (const float*)R + (size_t)EPI_ROW(u, ai, wr, m, fr) * D + col0 + bj * 128; rv[m][bj][0] = *(const f32x4*)rp; rv[m][bj][1] = *(const f32x4*)(rp + 4); }
                __builtin_amdgcn_sched_barrier(0);
#pragma unroll
                for (int m = 0; m < 4; ++m) { const int row = EPI_ROW(u, ai, wr, m, fr); float ss = 0.f;
#pragma unroll
                    for (int bj = 0; bj < 2; ++bj) { const f32x4 v0 = aadd4(acc[ai][bj][m][0], rv[m][bj][0]), v1 = aadd4(acc[ai][bj][m][1], rv[m][bj][1]);
                        ss = aadd(ss, sumsq8(v0, v1)); st16(X + (size_t)row * D + col0 + bj * 128, pack8(v0, v1)); }
                    ss += __shfl_xor(ss, 16); ss += __shfl_xor(ss, 32); ss_stage(sst, ai, wr, m, fr, wc, fq, ss); }
                __builtin_amdgcn_sched_barrier(0); }
        } else {
#pragma unroll
            for (int ai = 0; ai < 2; ++ai) { u32x4 rv[4][2];
#pragma unroll
                for (int m = 0; m < 4; ++m)
#pragma unroll
                    for (int bj = 0; bj < 2; ++bj) rv[m][bj] = *(const u32x4*)((const bf16_t*)R + (size_t)EPI_ROW(u, ai, wr, m, fr) * D + col0 + bj * 128);
                __builtin_amdgcn_sched_barrier(0);
#pragma unroll
                for (int m = 0; m < 4; ++m) { const int row = EPI_ROW(u, ai, wr, m, fr); float ss = 0.f;
#pragma unroll
                    for (int bj = 0; bj < 2; ++bj) { f32x4 r0, r1; unpack8(rv[m][bj], r0, r1);
                        const f32x4 v0 = aadd4(acc[ai][bj][m][0], r0), v1 = aadd4(acc[ai][bj][m][1], r1);
                        ss = aadd(ss, sumsq8(v0, v1)); st16(X + (size_t)row * D + col0 + bj * 128, pack8(v0, v1)); }
                    ss += __shfl_xor(ss, 16); ss += __shfl_xor(ss, 32); ss_stage(sst, ai, wr, m, fr, wc, fq, ss); }
                __builtin_amdgcn_sched_barrier(0); }
        }
        ss_flush(sst, SS, u, nullptr);
    }
};
struct EpiSwiglu {
    static constexpr bool PERM = true; static constexpr bool EARLYPF = true; static constexpr int NVM = 12; typedef NoPre Pre;
    struct Regs { float ns[2][4], ic[2][4]; };
    bf16_t* O; int ldc; const float* SSin; const unsigned* slotp;
    __device__ __forceinline__ void prefetch(const Unit& u, int wr, int wc, int fr, int fq, Pre&, LAS unsigned* pbuf) const {
#pragma unroll
        for (int ai = 0; ai < 2; ++ai)
#pragma unroll
            for (int m = 0; m < 4; ++m) { const int row = EPI_ROW(u, ai, wr, m, fr); dma4(SSin ? (const void*)(SSin + SS1_IDX(row, fq)) : (const void*)(slotp + row), pbuf, ai * 4 + m); }
    }
    __device__ __forceinline__ void consume(const Unit& u, int wr, int wc, int fr, int fq, LAS unsigned* pbuf, Regs& rg) const {
        const int lane = threadIdx.x & 63;
#pragma unroll
        for (int ai = 0; ai < 2; ++ai)
#pragma unroll
            for (int m = 0; m < 4; ++m) { const unsigned w = pbuf[(ai * 4 + m) * 64 + lane];
                if (SSin) { float q = __uint_as_float(w); q += __shfl_xor(q, 16); q += __shfl_xor(q, 32); q = q * (1.0f / D) + EPS; rg.ic[ai][m] = q; rg.ns[ai][m] = -LOG2E * __builtin_amdgcn_rsqf(q); }
                else { float s_, sw_; unpack_h2(w, s_, sw_); rg.ns[ai][m] = -LOG2E * s_; rg.ic[ai][m] = fminf(__builtin_amdgcn_rcpf(s_ * sw_), 1e30f); } }
    }
    __device__ __forceinline__ void body(Acc& acc, const Unit& u, int wr, int wc, int fr, int fq, const Regs& rg) const {
        const int col0 = u.pn * 128 + wc * 32 + 8 * fq;
        const int na = EPI_NA(u);
#pragma unroll
        for (int ai = 0; ai < 2; ++ai) if (ai < na)
#pragma unroll
            for (int m = 0; m < 4; ++m) { const int row = EPI_ROW(u, ai, wr, m, fr); const float n_ = rg.ns[ai][m], c_ = rg.ic[ai][m];
                f32x4 o0, o1;
#pragma unroll
                for (int i = 0; i < 4; ++i) { const float g0 = acc[ai][0][m][0][i], u0 = acc[ai][1][m][0][i], g1 = acc[ai][0][m][1][i], u1 = acc[ai][1][m][1][i];
                    float r0, r1; swiglu2(g0, u0, g1, u1, n_, c_, r0, r1); o0[i] = r0; o1[i] = r1; }
                st16(O + (size_t)row * ldc + col0, pack8(o0, o1)); }
    }
};
template <bool OUTF32, bool IN16 = false> struct EpiPle {
    static constexpr bool PERM = true; static constexpr bool EARLYPF = false; typedef Pre8 Pre;
    const bf16_t* X; const bf16_t* PP; void* O; const float* SSin; float* SSout; LAS float* sst;
    __device__ __forceinline__ void prefetch(const Unit& u, int wr, int wc, int fr, int fq, Pre& p, LAS unsigned* pbuf) const { if (IN16) ss16_prefetch(SSin, u, wr, fr, fq, p); else ss_prefetch(SSin, u, wr, fr, fq, p); }
    __device__ __forceinline__ void operator()(Acc& acc, const Unit& u, int wr, int wc, int fr, int fq, const Pre& pre, LAS unsigned* pbuf) const {
        const int col0 = u.pn * 256 + wc * 32 + 8 * fq;
        float rs[2][4]; ss_finish(pre, rs);
#pragma unroll
        for (int ai = 0; ai < 2; ++ai)
#pragma unroll
            for (int mh = 0; mh < 2; ++mh) { u32x4 xv[2][2], pv[2][2];
#pragma unroll
                for (int ml = 0; ml < 2; ++ml)
#pragma unroll
                    for (int bj = 0; bj < 2; ++bj) { const size_t off = (size_t)EPI_ROW(u, ai, wr, 2 * mh + ml, fr) * D + col0 + bj * 128; xv[ml][bj] = *(const u32x4*)(X + off); pv[ml][bj] = *(const u32x4*)(PP + off); }
                __builtin_amdgcn_sched_barrier(0);
#pragma unroll
                for (int ml = 0; ml < 2; ++ml) { const int m = 2 * mh + ml; const int row = EPI_ROW(u, ai, wr, m, fr); const float s = -LOG2E * rs[ai][m]; float ss = 0.f;
#pragma unroll
                    for (int bj = 0; bj < 2; ++bj) { const size_t off = (size_t)row * D + col0 + bj * 128; f32x4 x0, x1, p0, p1;
                        unpack8(xv[ml][bj], x0, x1); unpack8(pv[ml][bj], p0, p1);
                        f32x4 v0, v1;
#pragma unroll
                        for (int i = 0; i < 4; ++i) {
                            float r0, r1; plesig2(acc[ai][bj][m][0][i], acc[ai][bj][m][1][i], s, p0[i], p1[i], x0[i], x1[i], r0, r1); v0[i] = r0; v1[i] = r1; }
                        ss = aadd(ss, sumsq8(v0, v1));
                        if (OUTF32) { st16f((float*)O + off, v0); st16f((float*)O + off + 4, v1); }
                        else st16((bf16_t*)O + off, pack8(v0, v1)); }
                    ss += __shfl_xor(ss, 16); ss += __shfl_xor(ss, 32); ss_stage(sst, ai, wr, m, fr, wc, fq, ss); }
                __builtin_amdgcn_sched_barrier(0); }
        ss_flush(sst, SSout, u, nullptr);
    }
};
struct EpiQkv {
    static constexpr bool PERM = true; static constexpr bool EARLYPF = false;
    typedef NoPre Pre;
    bf16_t* KV; bf16_t* Q; const float* SSin; const int* pos;
    __device__ __forceinline__ void prefetch(const Unit& u, int wr, int wc, int fr, int fq, Pre& p, LAS unsigned* pbuf) const {
#pragma unroll
        for (int ai = 0; ai < 2; ++ai)
#pragma unroll
            for (int m = 0; m < 4; ++m) { const int row = EPI_ROW(u, ai, wr, m, fr); dma4(SSin + SS1_IDX(row, fq), pbuf, ai * 4 + m); }
        LAS unsigned* p2 = pbuf2_of(pbuf);
#pragma unroll
        for (int h = 0; h < 2; ++h) dma4(pos + EPI_ROW(u, h, wr, fq, fr), p2, h);
    }
    __device__ __forceinline__ void operator()(Acc& acc, const Unit& u, int wr, int wc, int fr, int fq, const Pre& pre, LAS unsigned* pbuf) const {
        float rs[2][4]; int ps[2][4];
        const int lane = threadIdx.x & 63; LAS unsigned* p2 = pbuf2_of(pbuf);
#pragma unroll
        for (int ai = 0; ai < 2; ++ai)
#pragma unroll
            for (int m = 0; m < 4; ++m) { float s = __uint_as_float(pbuf[(ai * 4 + m) * 64 + lane]); s += __shfl_xor(s, 16); s += __shfl_xor(s, 32); rs[ai][m] = 1.0f / sqrtf(s * (1.0f / D) + EPS); ps[ai][m] = (int)p2[ai * 64 + m * 16 + fr]; }
        const bool isq = u.pn >= 1;
        const bool rot_lane = ((wc & 1) == 0) && (fq < 2);
        const float QS = 0.125f * LOG2E;
        const int na = EPI_NA(u);
#pragma unroll
        for (int ai = 0; ai < 2; ++ai) if (ai < na)
#pragma unroll
            for (int m = 0; m < 4; ++m) { const int row = EPI_ROW(u, ai, wr, m, fr); const float s = rs[ai][m];
                float cs[4], sn[4];
                if (rot_lane) { const float p = (float)ps[ai][m];
#pragma unroll
                    for (int i = 0; i < 4; ++i) { const int f = 4 * fq + i;
                        const float fr2pi = f == 0 ? 0.15915494309189535f : f == 1 ? 0.03086376340470123f : f == 2 ? 0.005985185712713705f : f == 3 ? 0.001160663641240061f
                                          : f == 4 ? 0.00022507907903927653f : f == 5 ? 4.364795279280289e-05f : f == 6 ? 8.464330808241401e-06f : 1.6414262627950345e-06f;
                        float rev = p * fr2pi; rev -= floorf(rev);
                        sn[i] = __builtin_amdgcn_sinf(rev); cs[i] = __builtin_amdgcn_cosf(rev); } }
#pragma unroll
                for (int bj = 0; bj < 2; ++bj) { f32x4 v0 = acc[ai][bj][m][0] * s, v1 = acc[ai][bj][m][1] * s;
                    const bool rot = rot_lane && (isq || bj == 0);
                    if (rot) {
#pragma unroll
                        for (int i = 0; i < 4; ++i) { const float t1 = v0[i], t2 = v1[i]; v0[i] = t1 * cs[i] - t2 * sn[i]; v1[i] = t2 * cs[i] + t1 * sn[i]; } }
                    if (isq) { v0 = v0 * QS; v1 = v1 * QS; st16(Q + (size_t)row * D + (u.pn - 1) * 256 + bj * 128 + wc * 32 + 8 * fq, pack8(v0, v1)); }
                    else st16(KV + (size_t)row * 256 + bj * 128 + wc * 32 + 8 * fq, pack8(v0, v1)); } }
    }
};
struct EpiMoeDown {
    static constexpr bool PERM = true; static constexpr bool EARLYPF = false; typedef NoPre Pre;
    const int* toklist; bf16_t* X; float* SS;
    __device__ __forceinline__ void prefetch(const Unit& u, int wr, int wc, int fr, int fq, Pre& p, LAS unsigned* pbuf) const {
        LAS unsigned* p2 = pbuf2_of(pbuf);
#pragma unroll
        for (int h = 0; h < 2; ++h) dma4(toklist + EPI_ROW(u, h, wr, fq, fr), p2, h);
    }
    __device__ __forceinline__ void operator()(Acc& acc, const Unit& u, int wr, int wc, int fr, int fq, const Pre&, LAS unsigned* pbuf) const {
        const int col0 = u.pn * 256 + wc * 32 + 8 * fq;
        int tk[2][4]; LAS unsigned* p2 = pbuf2_of(pbuf);
#pragma unroll
        for (int ai = 0; ai < 2; ++ai)
#pragma unroll
            for (int m = 0; m < 4; ++m) tk[ai][m] = (ai < EPI_NA(u)) ? (int)p2[ai * 64 + m * 16 + fr] : -1;
#pragma unroll
        for (int ai = 0; ai < 2; ++ai) if (ai < EPI_NA(u)) { u32x4 rv[4][2];
#pragma unroll
            for (int m = 0; m < 4; ++m) { const int tok = tk[ai][m] < 0 ? 0 : tk[ai][m];
#pragma unroll
                for (int bj = 0; bj < 2; ++bj) rv[m][bj] = *(const u32x4*)(X + (size_t)tok * D + col0 + bj * 128); }
            __builtin_amdgcn_sched_barrier(0);
#pragma unroll
            for (int m = 0; m < 4; ++m) { const int tok = tk[ai][m]; float ss = 0.f;
#pragma unroll
                for (int bj = 0; bj < 2; ++bj) { f32x4 r0, r1; unpack8(rv[m][bj], r0, r1);
                    const f32x4 v0 = aadd4(acc[ai][bj][m][0], r0), v1 = aadd4(acc[ai][bj][m][1], r1);
                    ss = aadd(ss, sumsq8(v0, v1));
                    if (tok >= 0) st16(X + (size_t)tok * D + col0 + bj * 128, pack8(v0, v1)); }
                if (SS) { ss += __shfl_xor(ss, 16); ss += __shfl_xor(ss, 32); if (fq == 0 && tok >= 0) SS[(size_t)tok * 16 + u.pn * 4 + wc] = ss; } }
            __builtin_amdgcn_sched_barrier(0); }
    }
};
#define LDS_WAIT() asm volatile("s_waitcnt lgkmcnt(0)" ::: "memory")

__device__ __forceinline__ int rope_perm(int d) { return d < 4 ? d : d < 8 ? d + 4 : d < 12 ? d - 4 : d; }
__device__ __forceinline__ int dst_row(int map, int p0, int p1, int n) {
    if (map == 0) return p0 + n;
    if (map == 1) { const int nn = n < p0 ? n : n - p0; return p1 + (nn >> 7) * 256 + (n < p0 ? 0 : 128) + (nn & 127); }
    if (map == 2) return (p0 + (n >> 7)) * 256 + p1 + (n & 127);
    return p0 + (n < p1 ? (n & ~63) + rope_perm(n & 63) : n);
}
struct TJob { const float* W; const float* gain; bf16_t* dst; int K, N, dpitch, map, p0, p1; };
__device__ __forceinline__ void transpose_item(const TJob& J, LAS float* scr, int item, int lane) {
    const int nblk = J.N / 32, kb = item / nblk, nb = item % nblk, k0 = 64 * kb, n0 = 32 * nb;
    f32x4 v[8];
#pragma unroll
    for (int i = 0; i < 8; ++i) v[i] = __builtin_nontemporal_load((const f32x4*)(J.W + (size_t)(k0 + (lane >> 3) + 8 * i) * J.N + n0 + 4 * (lane & 7)));
#pragma unroll
    for (int i = 0; i < 8; ++i) { const int kk = (lane >> 3) + 8 * i; f32x4 w = v[i]; if (J.gain) w = w * J.gain[k0 + kk];
        LAS float* d = scr + kk * 33 + 4 * (lane & 7); d[0] = w[0]; d[1] = w[1]; d[2] = w[2]; d[3] = w[3]; }
    LDS_WAIT(); asm volatile("" ::: "memory");
    const int c = lane & 7;
#pragma unroll
    for (int j = 0; j < 4; ++j) { const int n = (lane >> 3) + 8 * j; const LAS float* s = scr + (8 * c) * 33 + n;
        u32x4 o; o.x = pk2(s[0 * 33], s[1 * 33]); o.y = pk2(s[2 * 33], s[3 * 33]); o.z = pk2(s[4 * 33], s[5 * 33]); o.w = pk2(s[6 * 33], s[7 * 33]);
        st16(J.dst + (size_t)dst_row(J.map, J.p0, J.p1, n0 + n) * J.dpitch + k0 + 8 * c, o); }
    LDS_WAIT(); asm volatile("" ::: "memory");
}
template <int NR> __device__ __forceinline__ void cvt_rows(const float* xrow, bf16_t* orow, float* rstd_out, int lane) {
    f32x4 v[NR][4];
#pragma unroll
    for (int r = 0; r < NR; ++r)
#pragma unroll
        for (int j = 0; j < 4; ++j) v[r][j] = __builtin_nontemporal_load((const f32x4*)(xrow + (size_t)r * D) + lane + 64 * j);
#pragma unroll
    for (int r = 0; r < NR; ++r) { float s = 0.f; u32x2* o = (u32x2*)(orow + (size_t)r * D);
#pragma unroll
        for (int j = 0; j < 4; ++j) { const f32x4 a = v[r][j]; s += (a[0] * a[0] + a[1] * a[1]) + (a[2] * a[2] + a[3] * a[3]); u32x2 w; w.x = pk2(a[0], a[1]); w.y = pk2(a[2], a[3]); o[lane + 64 * j] = w; }
        if (rstd_out) { s = wave_sum(s); if (lane == 0) rstd_out[r] = 1.0f / sqrtf(s * (1.0f / D) + EPS); } }
}

__device__ __forceinline__ void conv_phase(const bf16_t* XB, const float* cw, const float* cb, bf16_t* XC, int gtid, int gthreads) {
    for (int it = gtid; it < (T / 16) * 128; it += gthreads) {
        const int cgp = it & 127, strip = it >> 7, c0 = cgp * 8, t0 = strip * 16;
        float w[4][8], b[8];
#pragma unroll
        for (int k = 0; k < 4; ++k) { const f32x4 a = *(const f32x4*)(cw + k * D + c0), bb = *(const f32x4*)(cw + k * D + c0 + 4);
#pragma unroll
            for (int i = 0; i < 4; ++i) { w[k][i] = a[i]; w[k][4 + i] = bb[i]; } }
        { const f32x4 a = *(const f32x4*)(cb + c0), bb = *(const f32x4*)(cb + c0 + 4);
#pragma unroll
          for (int i = 0; i < 4; ++i) { b[i] = a[i]; b[4 + i] = bb[i]; } }
        const bool seq0 = (t0 & (SEQ - 1)) == 0;
        u32x4 xw[19];
#pragma unroll
        for (int j = 0; j < 19; ++j) { if (j < 3 && seq0) xw[j] = (u32x4){0u, 0u, 0u, 0u}; else xw[j] = *(const u32x4*)(XB + (size_t)(t0 - 3 + j) * D + c0); }
#pragma unroll
        for (int j = 0; j < 16; ++j) {
            f32x4 o0, o1;
#pragma unroll
            for (int i = 0; i < 4; ++i) { o0[i] = b[i]; o1[i] = b[4 + i]; }
#pragma unroll
            for (int k = 0; k < 4; ++k) { f32x4 x0, x1; unpack8(xw[j + 3 - k], x0, x1);
#pragma unroll
                for (int i = 0; i < 4; ++i) { o0[i] = fmaf(w[k][i], x0[i], o0[i]); o1[i] = fmaf(w[k][4 + i], x1[i], o1[i]); } }
            st16(XC + (size_t)(t0 + j) * D + c0, pack8(o0, o1)); }
    }
}
__device__ __forceinline__ void carry_phase(const float* aggA, const float* aggH, float* carry, int gtid, int gthreads) {
    for (int it = gtid; it < BATCH * D; it += gthreads) {
        const int b = it >> 10, c = it & 1023; const size_t base = (size_t)b * 64 * D + c;
        float h = 0.f;
#pragma unroll 8
        for (int k = 0; k < 64; ++k) { carry[base + (size_t)k * D] = h; h = fmaf(aggA[base + (size_t)k * D], h, aggH[base + (size_t)k * D]); }
    }
}
__device__ __forceinline__ void ypass_phase(const bf16_t* HL, const bf16_t* PC, const bf16_t* GATE, const float* carry, bf16_t* Y, int gtid, int gthreads) {
    for (int it = gtid; it < (T / 16) * 128; it += gthreads) {
        const int cgp = it & 127, strip = it >> 7, c0 = cgp * 8, t0 = strip * 16, chunk = t0 >> 7;
        const f32x4 ca = *(const f32x4*)(carry + (size_t)chunk * D + c0), cb2 = *(const f32x4*)(carry + (size_t)chunk * D + c0 + 4);
#pragma unroll 8
        for (int j = 0; j < 16; ++j) { const size_t off = (size_t)(t0 + j) * D + c0;
            f32x4 h0, h1, p0, p1, g0, g1; unpack8(*(const u32x4*)(HL + off), h0, h1); unpack8(*(const u32x4*)(PC + off), p0, p1); unpack8(*(const u32x4*)(GATE + off), g0, g1);
            f32x4 o0, o1;
#pragma unroll
            for (int i = 0; i < 4; ++i) { o0[i] = fmaf(p0[i], ca[i], h0[i]) * g0[i]; o1[i] = fmaf(p1[i], cb2[i], h1[i]) * g1[i]; }
            st16(Y + off, pack8(o0, o1)); }
    }
}
constexpr int ATT_KP = 144, ATT_VP = 520, ATT_KS = 0, ATT_VS = 256 * ATT_KP, ATT_OS = 73728;
__device__ __forceinline__ void attn_phase(LAS unsigned char* lds, const bf16_t* Q, const bf16_t* KV, const float* sinks, bf16_t* O, int blk, int nblk) {
    const int tid = threadIdx.x, lane = tid & 63, wid = __builtin_amdgcn_readfirstlane(tid >> 6), r = lane & 31, hh = lane >> 5;
    for (int unit = blk; unit < BATCH * 64 * 2; unit += nblk) {
        const int kvh = unit & 1, nb = (unit >> 1) & 63, b = unit >> 7;
        const long row0 = (long)b * SEQ + nb * 128;
#pragma unroll
        for (int i = 0; i < 4; ++i) { const int id = tid + 512 * i, key = id >> 3, c = id & 7;
            u32x4 kw = (u32x4){0u, 0u, 0u, 0u}, vw = (u32x4){0u, 0u, 0u, 0u};
            if (nb > 0 || key >= 128) { const bf16_t* src = KV + (size_t)(row0 - 128 + key) * 256 + kvh * 64 + c * 8; kw = *(const u32x4*)src; vw = *(const u32x4*)(src + 128); }
            *(LAS u32x4*)(lds + ATT_KS + key * ATT_KP + c * 16) = kw;
            LAS bf16_t* vt = (LAS bf16_t*)(lds + ATT_VS + (c * 8) * ATT_VP + key * 2);
            vt[0 * (ATT_VP / 2)] = (bf16_t)(vw.x & 0xffffu); vt[1 * (ATT_VP / 2)] = (bf16_t)(vw.x >> 16); vt[2 * (ATT_VP / 2)] = (bf16_t)(vw.y & 0xffffu); vt[3 * (ATT_VP / 2)] = (bf16_t)(vw.y >> 16);
            vt[4 * (ATT_VP / 2)] = (bf16_t)(vw.z & 0xffffu); vt[5 * (ATT_VP / 2)] = (bf16_t)(vw.z >> 16); vt[6 * (ATT_VP / 2)] = (bf16_t)(vw.w & 0xffffu); vt[7 * (ATT_VP / 2)] = (bf16_t)(vw.w >> 16); }
        __syncthreads();
        const int h = kvh * 8 + wid;
        const float sink2 = sinks[h] * LOG2E;
        for (int qs = 0; qs < 4; ++qs) {
            const long qrow = row0 + 32 * qs + r;
            bf16x8 qf[4];
#pragma unroll
            for (int s = 0; s < 4; ++s) qf[s] = *(const bf16x8*)(Q + (size_t)qrow * D + h * 64 + 16 * s + 8 * hh);
            f32x16 st[5];
#pragma unroll
            for (int kt = 0; kt < 5; ++kt) { f32x16 a = {};
                const LAS unsigned char* kp = lds + ATT_KS + (32 * (qs + kt) + r) * ATT_KP + 16 * hh;
#pragma unroll
                for (int s = 0; s < 4; ++s) { const bf16x8 kf = *(const LAS bf16x8*)(kp + 32 * s); a = __builtin_amdgcn_mfma_f32_32x32x16_bf16(kf, qf[s], a, 0, 0, 0); }
                st[kt] = a; }
            float mx = sink2;
#pragma unroll
            for (int kt = 0; kt < 5; ++kt) { const bool dead = (nb == 0) && (qs + kt < 4);
#pragma unroll
                for (int rg = 0; rg < 16; ++rg) { const int kk = (rg & 3) + 8 * (rg >> 2) + 4 * hh;
                    bool ok = !dead; if (kt == 0) ok = ok && (kk > r); if (kt == 4) ok = ok && (kk <= r);
                    const float v = ok ? st[kt][rg] : -1e30f; st[kt][rg] = v; mx = fmaxf(mx, v); } }
            mx = fmaxf(mx, __shfl_xor(mx, 32));
            float sum = 0.f;
#pragma unroll
            for (int kt = 0; kt < 5; ++kt)
#pragma unroll
                for (int rg = 0; rg < 16; ++rg) { const float p = __builtin_amdgcn_exp2f(st[kt][rg] - mx); st[kt][rg] = p; sum += p; }
            sum += __shfl_xor(sum, 32);
            const float inv = 1.0f / (sum + __builtin_amdgcn_exp2f(sink2 - mx));
            f32x16 o0 = {}, o1 = {};
#pragma unroll
            for (int kt = 0; kt < 5; ++kt)
#pragma unroll
                for (int s2 = 0; s2 < 2; ++s2) {
                    u32x4 pw; pw.x = pk2(st[kt][8 * s2 + 0] * inv, st[kt][8 * s2 + 1] * inv); pw.y = pk2(st[kt][8 * s2 + 2] * inv, st[kt][8 * s2 + 3] * inv);
                    pw.z = pk2(st[kt][8 * s2 + 4] * inv, st[kt][8 * s2 + 5] * inv); pw.w = pk2(st[kt][8 * s2 + 6] * inv, st[kt][8 * s2 + 7] * inv);
                    const bf16x8 pa = __builtin_bit_cast(bf16x8, pw);
                    const int kbase = 32 * (qs + kt) + 16 * s2 + 4 * hh;
#pragma unroll
                    for (int dh = 0; dh < 2; ++dh) { const LAS unsigned char* vp = lds + ATT_VS + (32 * dh + r) * ATT_VP + kbase * 2;
                        const u32x2 lo = *(const LAS u32x2*)vp, hi = *(const LAS u32x2*)(vp + 16);
                        const u32x4 vv = (u32x4){lo.x, lo.y, hi.x, hi.y}; const bf16x8 vf = __builtin_bit_cast(bf16x8, vv);
                        if (dh == 0) o0 = __builtin_amdgcn_mfma_f32_32x32x16_bf16(pa, vf, o0, 0, 0, 0); else o1 = __builtin_amdgcn_mfma_f32_32x32x16_bf16(pa, vf, o1, 0, 0, 0); } }
            LAS unsigned char* ost = lds + ATT_OS + wid * (32 * 144);
#pragma unroll
            for (int rg = 0; rg < 16; ++rg) { const int q = (rg & 3) + 8 * (rg >> 2) + 4 * hh;
                *(LAS bf16_t*)(ost + q * 144 + 2 * r) = (bf16_t)(pk2(o0[rg], 0.f) & 0xffffu); *(LAS bf16_t*)(ost + q * 144 + 64 + 2 * r) = (bf16_t)(pk2(o1[rg], 0.f) & 0xffffu); }
            LDS_WAIT();
#pragma unroll
            for (int i = 0; i < 4; ++i) { const int q = 8 * i + (lane >> 3), ch = lane & 7;
                const u32x4 v = *(const LAS u32x4*)(ost + q * 144 + 16 * ch);
                *(u32x4*)(O + (size_t)(row0 + 32 * qs + q) * D + h * 64 + 8 * ch) = v; }
            LDS_WAIT();
        }
        __syncthreads();
    }
}
__device__ __forceinline__ void router_phase(LAS unsigned char* lds, const bf16_t* X, const float* SS, const bf16_t* WR16, const float* br,
                                             unsigned* TOKE, float* TOKW0, float* TOKW1, float* TOKR, int* CNT, int blk, int nblk) {
    const int tid = threadIdx.x, lane = tid & 63, wid = tid >> 6, r16 = lane & 15, kq = lane >> 4;
    LAS unsigned* se = (LAS unsigned*)lds;
    LAS float* slg = (LAS float*)(lds + 1024) + wid * 16 * 9;
    for (int tile = blk; tile < T / 128; tile += nblk) {
        const int tok0 = tile * 128 + wid * 16;
        const bf16_t* xa = X + (size_t)(tok0 + r16) * D + 8 * kq;
        const bf16_t* wb = WR16 + (size_t)r16 * D + 8 * kq;
        f32x4 acc = {0.f, 0.f, 0.f, 0.f};
#pragma unroll
        for (int sb = 0; sb < 4; ++sb) { bf16x8 af[8], bfr[8];
#pragma unroll
            for (int s = 0; s < 8; ++s) { af[s] = *(const bf16x8*)(xa + 32 * (8 * sb + s)); bfr[s] = *(const bf16x8*)(wb + 32 * (8 * sb + s)); }
#pragma unroll
            for (int s = 0; s < 8; ++s) acc = __builtin_amdgcn_mfma_f32_16x16x32_bf16(af[s], bfr[s], acc, 0, 0, 0); }
#pragma unroll
        for (int r = 0; r < 4; ++r) { const float lo = __shfl_down(acc[r], 8, 16); if (r16 < 8) slg[(4 * kq + r) * 9 + r16] = acc[r] + lo; }
        LDS_WAIT();
        if (lane < 16) { const int tok = tok0 + lane;
            const float ssum = (SS[SS1_IDX(tok, 0)] + SS[SS1_IDX(tok, 1)]) + (SS[SS1_IDX(tok, 2)] + SS[SS1_IDX(tok, 3)]);
            const float rstd = 1.0f / sqrtf(ssum * (1.0f / D) + EPS);
            float lg[8];
#pragma unroll
            for (int e = 0; e < 8; ++e) lg[e] = fmaf(slg[lane * 9 + e], rstd, br[e]);
            int i0 = 0; float v0 = lg[0];
#pragma unroll
            for (int e = 1; e < 8; ++e) if (lg[e] > v0) { v0 = lg[e]; i0 = e; }
            int i1 = -1; float v1 = -3.0e38f;
#pragma unroll
            for (int e = 0; e < 8; ++e) if (e != i0 && lg[e] > v1) { v1 = lg[e]; i1 = e; }
            const float e1 = __expf(v1 - v0), w0 = 1.0f / (1.0f + e1), w1 = e1 * w0;
            const unsigned pe = (unsigned)i0 | ((unsigned)i1 << 8); TOKE[tok] = pe; TOKW0[tok] = w0; TOKW1[tok] = w1; TOKR[tok] = rstd; se[wid * 16 + lane] = pe; }
        __syncthreads();
        if (tid < 16) { int c = 0; const unsigned e = (unsigned)(tid & 7), sh = (tid >> 3) * 8;
            for (int t = 0; t < 128; ++t) c += (((se[t] >> sh) & 0xffu) == e) ? 1 : 0;
            CNT[tile * 16 + tid] = c; }
        __syncthreads();
    }
}
__device__ __forceinline__ void gather_phase(LAS unsigned char* lds, const bf16_t* X, const unsigned* TOKE, const float* TOKW0, const float* TOKW1, const float* TOKR, const int* CNT,
                                             int* TOKLIST, unsigned* SLOTP, int blk, int nblk) {
    const int tid = threadIdx.x, lane = tid & 63, wid = tid >> 6;
    LAS int* s_tot = (LAS int*)lds;
    LAS int* s_bef = s_tot + 16;
    LAS int* s_start = s_bef + 16;
    LAS unsigned* s_e = (LAS unsigned*)(s_start + 32);
    LAS int* s_slot = (LAS int*)(s_e + 128);
    for (int tile = blk; tile < T / 128; tile += nblk) {
        if (tid < 32) s_tot[tid] = 0;
        __syncthreads();
        { int tot = 0, bef = 0;
#pragma unroll
          for (int k = 0; k < 8; ++k) { const int t = (tid >> 4) + 32 * k; const int c = CNT[t * 16 + (tid & 15)]; tot += c; bef += (t < tile) ? c : 0; }
          atomicAdd((int*)(s_tot + (tid & 15)), tot); atomicAdd((int*)(s_bef + (tid & 15)), bef); }
        if (tid >= 64 && tid < 192) s_e[tid - 64] = TOKE[tile * 128 + tid - 64];
        __syncthreads();
        if (tid == 0) { int s = 0; for (int g = 0; g < 16; ++g) { s_start[g] = s; s += (s_tot[g] + 255) & ~255; } s_start[16] = s; }
        __syncthreads();
        if (tile == 0) {
            for (int g = 0; g < 16; ++g) { const int lo = s_start[g] + s_tot[g], hi = s_start[g + 1]; for (int s = lo + tid; s < hi; s += 512) { TOKLIST[s] = -1; SLOTP[s] = 0u; } }
        }
        if (tid < 128) { const unsigned me = s_e[tid]; const unsigned e0 = me & 0xffu, e1 = (me >> 8) & 0xffu; int r0 = 0, r1 = 0;
            for (int t = 0; t < tid; ++t) { const unsigned o = s_e[t]; r0 += ((o & 0xffu) == e0) ? 1 : 0; r1 += (((o >> 8) & 0xffu) == e1) ? 1 : 0; }
            const int tok = tile * 128 + tid;
            const int sl0 = s_start[e0] + s_bef[e0] + r0, sl1 = s_start[8 + e1] + s_bef[8 + e1] + r1;
            const float rs = TOKR[tok];
            TOKLIST[sl0] = tok; SLOTP[sl0] = pack_h2(rs, rs * TOKW0[tok]); TOKLIST[sl1] = tok; SLOTP[sl1] = pack_h2(rs, rs * TOKW1[tok]); }
        __syncthreads();
    }
}
__device__ __forceinline__ void moe_table(LAS int* tstart, const int* CNT) {
    const int tid = threadIdx.x;
    LAS int* s_tot = tstart + 32;
    if (tid < 16) s_tot[tid] = 0;
    __syncthreads();
    { int tot = 0;
#pragma unroll
      for (int k = 0; k < 8; ++k) tot += CNT[((tid >> 4) + 32 * k) * 16 + (tid & 15)];
      atomicAdd((int*)(s_tot + (tid & 15)), tot); }
    __syncthreads();
    if (tid == 0) { int s = 0; for (int g = 0; g < 16; ++g) { tstart[g] = s; s += (s_tot[g] + 255) >> 8; } tstart[16] = s; }
    __syncthreads();
}
template <bool HALVES> struct OrdMoeT : pg8::OrderHalf {
    const LAS int* tstart; int g_lo; unsigned bexp, btile; const int* toklist;
    __device__ __forceinline__ void setup(const LAS int* ts, int glo, int ng, int nN_, int G_, int c_, unsigned bexp_, unsigned btile_) {
        tstart = ts; g_lo = glo; bexp = bexp_; btile = btile_; init(ts[glo + ng] - ts[glo], nN_, G_, c_); }
    __device__ __forceinline__ bool next(int i, Unit& u) const {
        int pm, pn, half = 0; if (HALVES ? !tileh(i, pm, pn, half) : !tile(i, pm, pn)) return false;
        const int mt = tstart[g_lo] + pm; int g = 0;
#pragma unroll
        for (int k = 1; k < 16; ++k) g += (tstart[k] <= mt) ? 1 : 0;
        u.pm = mt; u.pn = pn; u.rb = mt * 256 + (half == 2 ? 128 : 0); u.half = half; u.aoff = (unsigned)mt * (256u * 2048u) + (half == 2 ? 128u * 2048u : 0u); u.boff = (unsigned)(g & 7) * bexp + (unsigned)pn * btile; return true;
    }
};
__device__ __forceinline__ void final_phase(const bf16_t* X6, float* out, const float* SS, const float* gf, int gwave, int nwaves, int lane) {
    for (int row = 2 * gwave; row < T; row += 2 * nwaves) {
        u32x4 xv[2][2]; float sv[2];
#pragma unroll
        for (int r = 0; r < 2; ++r) { xv[r][0] = *(const u32x4*)(X6 + (size_t)(row + r) * D + 8 * lane); xv[r][1] = *(const u32x4*)(X6 + (size_t)(row + r) * D + 512 + 8 * lane); sv[r] = (lane < 4) ? SS[SS1_IDX(row + r, lane)] : 0.f; }
        const f32x4 g0 = *(const f32x4*)(gf + 8 * lane), g1 = *(const f32x4*)(gf + 8 * lane + 4), g2 = *(const f32x4*)(gf + 512 + 8 * lane), g3 = *(const f32x4*)(gf + 512 + 8 * lane + 4);
#pragma unroll
        for (int r = 0; r < 2; ++r) { const float rs = 1.0f / sqrtf(wave_sum(sv[r]) * (1.0f / D) + EPS);
            f32x4 a, b, c, d; unpack8(xv[r][0], a, b); unpack8(xv[r][1], c, d);
            float* o = out + (size_t)(row + r) * D;
            __builtin_nontemporal_store(a * rs * g0, (f32x4*)(o + 8 * lane)); __builtin_nontemporal_store(b * rs * g1, (f32x4*)(o + 8 * lane + 4)); __builtin_nontemporal_store(c * rs * g2, (f32x4*)(o + 512 + 8 * lane)); __builtin_nontemporal_store(d * rs * g3, (f32x4*)(o + 512 + 8 * lane + 4)); }
    }
}
constexpr size_t MiB = 1u << 20, KiB = 1u << 10;
constexpr size_t WS_BAR = 0, WS_C8G = 32 * KiB, WS_RSTD0 = 64 * KiB, WS_TOKE = 192 * KiB, WS_TOKW0 = 320 * KiB, WS_TOKW1 = 448 * KiB, WS_TOKR = 576 * KiB, WS_CNT = 704 * KiB, WS_TOKLIST = 720 * KiB, WS_SLOTW = 1008 * KiB, WS_SLOTR = 1296 * KiB, WS_WR16 = 1600 * KiB;
constexpr size_t WS_SSA = 2 * MiB, WS_SSB = 4 * MiB, WS_AGGA = 2 * MiB, WS_AGGH = 3 * MiB, WS_CARRY = 4 * MiB;
constexpr size_t WS_W = 6 * MiB;
constexpr size_t W_IN = WS_W, W_GATE = W_IN + 4 * MiB, W_OUT = W_GATE + 1 * MiB, W_FFI = W_OUT + 2 * MiB, W_FFO = W_FFI + 12 * MiB, W_PG0 = W_FFO + 6 * MiB, W_PG1 = W_PG0 + 2 * MiB,
                 W_PP0 = W_PG1 + 2 * MiB, W_PP1 = W_PP0 + MiB / 2, W_QKV = W_PP1 + MiB / 2, W_O = W_QKV + 5 * MiB / 2, W_EI = W_O + 2 * MiB, W_EO = W_EI + 32 * MiB, W_END = W_EO + 16 * MiB;
constexpr size_t SL_A = 92 * MiB, SL_B = 156 * MiB, SL_C = 220 * MiB, SL_D = 284 * MiB, SL_E = 348 * MiB, SL_F = 412 * MiB, SL_G = 476 * MiB, WS_NEED = 512 * MiB;
static_assert(W_END <= SL_A, "weights overlap slots");
static_assert(SL_C + (size_t)XG_ROWS * 2048 <= SL_E + 8 * MiB && SL_E + 8 * MiB + (size_t)XG_ROWS * 2048 <= WS_NEED, "moe buffers");
constexpr size_t WS_XG = SL_C, WS_HEXP = SL_E + 8 * MiB;
constexpr int LDS_BYTES = 163840;
constexpr int LDS_MISC = 131072;
constexpr int NPHASE = 20;

struct Args { const void* in[29]; float* out; unsigned char* ws; int ph_lo, ph_hi; };

struct OrdGates : pg8::OrderBase {
    __device__ __forceinline__ bool next(int i, Unit& u) const { if (!tile(i, u.pm, u.pn)) return false; u.aoff = (unsigned)u.pm * (256u * 2048u) + (unsigned)(u.pn >> 1) * 512u; u.boff = (unsigned)u.pn * (256u * 512u); u.rb = u.pm * 256; u.half = 0; return true; }
};

struct OrdGatesT { int c;
    __device__ __forceinline__ bool next(int i, Unit& u) const { if (i >= 4) return false; const int x = c & 7, yv = c >> 3, b = (yv >> 4) * 2 + (x >> 2), h = x & 3, half = (yv >> 3) & 1, j = yv & 7;
        u.pn = 2 * h + half; u.pm = b * 32 + 8 * i + j; u.rb = u.pm * 256; u.half = 0; u.aoff = (unsigned)u.pm * (256u * 2048u) + (unsigned)h * 512u; u.boff = (unsigned)u.pn * (256u * 512u); return true; }
};
__device__ __forceinline__ bool get_job(const Args& a, int j, TJob& J) {
    unsigned char* ws = a.ws;
    const float* g_mix = (const float*)a.in[3]; const float* g_ffn = (const float*)a.in[4]; const float* g_ple = (const float*)a.in[5];
    J.gain = nullptr; J.map = 0; J.p0 = 0; J.p1 = 0;
    if (j == 0) { J.W = (const float*)a.in[8]; J.K = 1024; J.N = 2048; J.gain = g_mix; J.dst = (bf16_t*)(ws + W_IN); J.dpitch = 1024; return true; }
    if (j == 1) { J.W = (const float*)a.in[16]; J.K = 1024; J.N = 1024; J.dst = (bf16_t*)(ws + W_OUT); J.dpitch = 1024; return true; }
    if (j == 2) { J.W = (const float*)a.in[22]; J.K = 1024; J.N = 6144; J.gain = g_ffn; J.dst = (bf16_t*)(ws + W_FFI); J.dpitch = 1024; J.map = 1; J.p0 = 3072; return true; }
    if (j == 3) { J.W = (const float*)a.in[23]; J.K = 3072; J.N = 1024; J.dst = (bf16_t*)(ws + W_FFO); J.dpitch = 3072; return true; }
    if (j == 4 || j == 5) { const int l = j - 4; J.W = (const float*)a.in[6] + (size_t)l * D * D; J.K = 1024; J.N = 1024; J.gain = g_ple + l * D; J.dst = (bf16_t*)(ws + (l ? W_PG1 : W_PG0)); J.dpitch = 1024; return true; }
    if (j == 6 || j == 7) { const int l = j - 6; J.W = (const float*)a.in[7] + (size_t)l * PLE * D; J.K = 256; J.N = 1024; J.dst = (bf16_t*)(ws + (l ? W_PP1 : W_PP0)); J.dpitch = 256; return true; }
    if (j == 8) { J.W = (const float*)a.in[18]; J.K = 1024; J.N = 256; J.gain = (const float*)a.in[17]; J.dst = (bf16_t*)(ws + W_QKV); J.dpitch = 1024; J.map = 3; J.p0 = 0; J.p1 = 128; return true; }
    if (j == 9) { J.W = (const float*)a.in[19]; J.K = 1024; J.N = 1024; J.gain = g_mix + D; J.dst = (bf16_t*)(ws + W_QKV); J.dpitch = 1024; J.map = 3; J.p0 = 256; J.p1 = 1024; return true; }
    if (j == 10) { J.W = (const float*)a.in[21]; J.K = 1024; J.N = 1024; J.dst = (bf16_t*)(ws + W_O); J.dpitch = 1024; return true; }
    if (j < 19) { const int q = j - 11, gx = q >> 2, h = q & 3;
        J.W = (const float*)a.in[gx ? 13 : 11] + (size_t)h * 65536; J.K = 256; J.N = 256; J.dst = (bf16_t*)(ws + W_GATE); J.dpitch = 256; J.map = 2; J.p0 = 2 * h; J.p1 = gx ? 128 : 0; return true; }
    if (j < 27) { const int e = j - 19; J.W = (const float*)a.in[26] + (size_t)e * D * 2048; J.K = 1024; J.N = 2048; J.gain = g_ffn + D; J.dst = (bf16_t*)(ws + W_EI); J.dpitch = 1024; J.map = 1; J.p0 = 1024; J.p1 = e * 2048; return true; }
    if (j < 35) { const int e = j - 27; J.W = (const float*)a.in[27] + (size_t)e * D * D; J.K = 1024; J.N = 1024; J.dst = (bf16_t*)(ws + W_EO); J.dpitch = 1024; J.p0 = e * 1024; return true; }
    return false;
}

__device__ __forceinline__ void convert_jobs(const Args& args, int jlo, int jhi, int w, int nw, LAS float* scr, int lane) {
    int off = 0; TJob J;
    for (int j = jlo; j < jhi && get_job(args, j, J); ++j) { const int n = (J.K / 64) * (J.N / 32); const int start = (w + nw - off % nw) % nw;
        for (int it = start; it < n; it += nw) transpose_item(J, scr, it, lane);
        off += n; }
}
constexpr int JOB_EI = 19, JOB_EO = 27, JOB_END = 35;

__global__ void __launch_bounds__(512, 2) fwd(Args args) {
    extern __shared__ __attribute__((aligned(16))) unsigned char lds_raw[];
    LAS unsigned char* lds = (LAS unsigned char*)lds_raw;
#define tid ((int)threadIdx.x)
#define lane (tid & 63)
#define wave (__builtin_amdgcn_readfirstlane(tid >> 6))
    const int G = gridDim.x, bx = blockIdx.x;
#define gtid (bx * 512 + tid)
#define gw (bx * 8 + wave)
    const int gthreads = G * 512, NGW = G * 8;
    unsigned char* ws = args.ws;
    const int lo = args.ph_lo, hi = args.ph_hi;
    cg::grid_group grid = cg::this_grid();
#ifndef PHMASK
#define PHMASK 0xFFFFFu
#endif
#define IN(k) ((((PHMASK) >> (k)) & 1u) && lo <= (k) && (k) < hi)
    XcdBarrier xbar; xbar.bar = (unsigned*)(ws + WS_BAR); xbar.x = 0; xbar.st = (volatile LAS unsigned*)(lds + LDS_MISC + 8192);
    if (hi - lo > 1) { if (tid < 4) ((LAS unsigned*)(lds + LDS_MISC + 8192))[tid] = 0u; __syncthreads(); xbar = xcd_barrier_post((unsigned*)(ws + WS_BAR), (volatile LAS unsigned*)(lds + LDS_MISC + 8192)); }
#ifndef REPMASK
#define REPMASK 0u
#endif
#define REPL(k) for (int rep_ = 0; rep_ <= (int)(((REPMASK) >> (k)) & 1u); ++rep_)
#define SEAM(k) do { if (IN(k) && IN((k) + 1)) { if (lo < 0) grid.sync(); else xcd_barrier(xbar); } } while (0)
    const float* x = (const float*)args.in[0]; const float* p = (const float*)args.in[1]; const int* pos = (const int*)args.in[2];
#define X0 ((bf16_t*)(ws + SL_A))
#define P16 ((bf16_t*)(ws + SL_G))
#define GATE ((bf16_t*)(ws + SL_D))
#define XB ((bf16_t*)(ws + SL_E))
#define XC ((bf16_t*)(ws + SL_F))
#define PP1 ((bf16_t*)(ws + SL_A))
#define HL ((bf16_t*)(ws + SL_B))
#define PC ((bf16_t*)(ws + SL_E))
#define Y ((bf16_t*)(ws + SL_E))
#define X1 ((bf16_t*)(ws + SL_C))
#define PP0 ((bf16_t*)(ws + SL_B))
#define HFF ((bf16_t*)(ws + SL_D))
#define X3 ((bf16_t*)(ws + SL_B))
#define KV ((bf16_t*)(ws + SL_G))
#define Q ((bf16_t*)(ws + SL_C))
#define ATT ((bf16_t*)(ws + SL_D))
#define HEXP ((bf16_t*)(ws + WS_HEXP))
#define SSA ((float*)(ws + WS_SSA))
#define SSB ((float*)(ws + WS_SSB))
#define RSTD0 ((float*)(ws + WS_RSTD0))
#define AGGA ((float*)(ws + WS_AGGA))
#define AGGH ((float*)(ws + WS_AGGH))
#define CARRY ((float*)(ws + WS_CARRY))
#define TOKE ((unsigned*)(ws + WS_TOKE))
#define TOKW0 ((float*)(ws + WS_TOKW0))
#define TOKW1 ((float*)(ws + WS_TOKW1))
#define TOKR ((float*)(ws + WS_TOKR))
#define C8G ((float*)(ws + WS_C8G))
#define CNT ((int*)(ws + WS_CNT))
#define TOKLIST ((int*)(ws + WS_TOKLIST))
#define SLOTP ((unsigned*)(ws + WS_SLOTW))
#define WR16 ((bf16_t*)(ws + WS_WR16))
    if (IN(0)) REPL(0) { if (rep_) xcd_barrier(xbar);
        LAS float* scr = (LAS float*)(lds + wave * 16384);
        convert_jobs(args, 0, JOB_EI, gw, NGW, scr, lane);
        if (G != 256) convert_jobs(args, JOB_EI, JOB_END, gw, NGW, scr, lane);
        if (gtid < D * 8) { const int kk = gtid >> 3, e = gtid & 7; const float w = ((const float*)args.in[24])[gtid] * ((const float*)args.in[4])[D + kk];
            const unsigned hi = pk2(w, 0.f) & 0xffffu; const float rem = w - __uint_as_float(hi << 16); WR16[(size_t)e * D + kk] = (bf16_t)hi; WR16[(size_t)(8 + e) * D + kk] = (bf16_t)(pk2(rem, 0.f) & 0xffffu); }
        if (gtid < D) { const float l = -((const float*)args.in[15])[gtid]; C8G[gtid] = -8.0f * LOG2E * (fmaxf(l, 0.f) + log1pf(expf(-fabsf(l)))); }
        for (int m = 4 * gw; m < T; m += 4 * NGW) cvt_rows<4>(x + (size_t)m * D, X0 + (size_t)m * D, RSTD0 + m, lane);
        for (int m = 4 * gw; m < 2 * T / 4; m += 4 * NGW) cvt_rows<4>(p + (size_t)m * D, P16 + (size_t)m * D, nullptr, lane);
    }
    SEAM(0);
    if (IN(1)) REPL(1) { if (rep_) xcd_barrier(xbar);
        Gemm g{(const char*)X0, (const char*)(ws + W_IN), 2048u, 2048u, 128u * 2048u, 1024, 0}; OrdStd S; S.init(T / 256, 8, G, bx); S.atile = 256u * 2048u; S.btile = 256u * 2048u;
        EpiInProj E{GATE, XB, RSTD0}; gemm_phase(lds, g, S, E);
    }
    SEAM(1);
    if (IN(2)) REPL(2) { if (rep_) xcd_barrier(xbar);
        conv_phase(XB, (const float*)args.in[9], (const float*)args.in[10], XC, gtid, gthreads);
    }
    SEAM(2);
    if (IN(3)) {
        Gemm g{(const char*)XC, (const char*)(ws + W_GATE), 2048u, 512u, 4u * 2048u, 256, 1}; OrdGatesT S; S.c = bx;
        EpiGatesF E{XC, (const float*)args.in[12], (const float*)args.in[14], C8G, GATE, Y, AGGA, AGGH, CARRY, &xbar}; gemm_phase(lds, g, S, E);
        convert_jobs(args, JOB_EI + 5, JOB_EO, gw, NGW, (LAS float*)(lds + wave * 16384), lane);
    }
    SEAM(3);
    if (IN(6)) REPL(6) { if (rep_) xcd_barrier(xbar);
#ifndef NO6A
        { Gemm g{(const char*)Y, (const char*)(ws + W_OUT), 2048u, 2048u, 128u * 2048u, 1024, 0}; OrdStd S; S.init(T / 256, 4, G, bx); S.atile = 256u * 2048u; S.btile = 256u * 2048u;
          EpiRes<false> E{X0, X1, SSA, (LAS float*)(lds + LDS_MISC + 1024)}; gemm_phase(lds, g, S, E); }
#endif
#ifndef NO6B
        { Gemm g{(const char*)P16, (const char*)(ws + W_PP0), 512u, 512u, 128u * 512u, 256, 0}; OrdStd S; S.init(T / 256, 4, G, bx); S.atile = 256u * 512u; S.btile = 256u * 512u;
          EpiBf16 E{PP0, D}; gemm_phase(lds, g, S, E); }
#endif
    }
    SEAM(6);
    if (IN(7)) REPL(7) { if (rep_) xcd_barrier(xbar);
        Gemm g{(const char*)X1, (const char*)(ws + W_FFI), 2048u, 2048u, 128u * 2048u, 1024, 0}; OrdStd S; S.init(T / 256, 24, G, bx); S.atile = 256u * 2048u; S.btile = 256u * 2048u;
        EpiSwiglu E{HFF, DFF, SSA, nullptr}; gemm_phase(lds, g, S, E);
#ifdef PROBE_NOEPI
        xcd_barrier(xbar); { EpiNull E0{(float*)(ws + WS_BAR + 16384)}; gemm_phase(lds, g, S, E0); }
#endif

    }
    SEAM(7);
    if (IN(8)) REPL(8) { if (rep_) xcd_barrier(xbar);
        Gemm g{(const char*)HFF, (const char*)(ws + W_FFO), 6144u, 6144u, 128u * 6144u, 3072, 0}; OrdStd S; S.init(T / 256, 4, G, bx); S.atile = 256u * 6144u; S.btile = 256u * 6144u;
        EpiRes<false> E{X1, X1, SSB, (LAS float*)(lds + LDS_MISC + 1024)}; gemm_phase(lds, g, S, E);
    }
    SEAM(8);
    if (IN(9)) REPL(9) { if (rep_) xcd_barrier(xbar);
        Gemm g{(const char*)X1, (const char*)(ws + W_PG0), 2048u, 2048u, 128u * 2048u, 1024, 0}; OrdStd S; S.init(T / 256, 4, G, bx); S.atile = 256u * 2048u; S.btile = 256u * 2048u;
        EpiPle<false> E{X1, PP0, X3, SSB, SSA, (LAS float*)(lds + LDS_MISC + 1024)}; gemm_phase(lds, g, S, E);
    }
    SEAM(9);
    if (IN(10)) REPL(10) { if (rep_) xcd_barrier(xbar);
        Gemm g{(const char*)X3, (const char*)(ws + W_QKV), 2048u, 2048u, 128u * 2048u, 1024, 0}; OrdStd S; S.init(T / 256, 5, G, bx); S.atile = 256u * 2048u; S.btile = 256u * 2048u;
        EpiQkv E{KV, Q, SSA, pos}; gemm_phase(lds, g, S, E);
        if (G == 256 && bx >= 128) convert_jobs(args, JOB_EI, JOB_EI + 5, (bx - 128) * 8 + wave, 128 * 8, (LAS float*)(lds + wave * 16384), lane);
    }
    SEAM(10);
    if (IN(11)) REPL(11) { if (rep_) xcd_barrier(xbar); attn_phase(lds, Q, KV, (const float*)args.in[20], ATT, bx, G); }
    SEAM(11);
    if (IN(12)) REPL(12) { if (rep_) xcd_barrier(xbar);
        Gemm g{(const char*)ATT, (const char*)(ws + W_O), 2048u, 2048u, 128u * 2048u, 1024, 0}; OrdStd S; S.init(T / 256, 4, G, bx); S.atile = 256u * 2048u; S.btile = 256u * 2048u;
        EpiRes<false> E{X3, X3, SSB, (LAS float*)(lds + LDS_MISC + 1024)}; gemm_phase(lds, g, S, E);
    }
    SEAM(12);
    if (IN(13)) REPL(13) { if (rep_) xcd_barrier(xbar); router_phase(lds, X3, SSB, WR16, (const float*)args.in[25], TOKE, TOKW0, TOKW1, TOKR, CNT, bx, G); }
    SEAM(13);
    if (IN(14)) REPL(14) { if (rep_) xcd_barrier(xbar); gather_phase(lds, X3, TOKE, TOKW0, TOKW1, TOKR, CNT, TOKLIST, SLOTP, bx, G); }
    SEAM(14);
    if (IN(15) || IN(16) || IN(17)) moe_table((LAS int*)(lds + LDS_MISC), CNT);
    if (IN(15)) REPL(15) { if (rep_) xcd_barrier(xbar);
        Gemm g{(const char*)X3, (const char*)(ws + W_EI), 2048u, 2048u, 128u * 2048u, 1024, 0}; OrdMoeT<false> S; S.setup((const LAS int*)(lds + LDS_MISC), 0, 16, 8, G, bx, 2048u * 2048u, 256u * 2048u); S.toklist = TOKLIST;
        EpiSwiglu E{HEXP, D, nullptr, SLOTP}; gemm_phase<EpiSwiglu, OrdMoeT<false>, true, false>(lds, g, S, E);
        if (G == 256) { int nidle = G - pg8::last_round_busy(S.nwg, G, false); if (nidle < 32) nidle = G; const int first = G - nidle;
            if (bx >= first) convert_jobs(args, JOB_EO, JOB_END, (bx - first) * 8 + wave, nidle * 8, (LAS float*)(lds + wave * 16384), lane); }
    }
    SEAM(15);
    if (IN(16)) REPL(16) { if (rep_) xcd_barrier(xbar);
        Gemm g{(const char*)HEXP, (const char*)(ws + W_EO), 2048u, 2048u, 128u * 2048u, 1024, 0}; OrdMoeT<true> S; S.setup((const LAS int*)(lds + LDS_MISC), 0, 8, 4, G, bx, 1024u * 2048u, 256u * 2048u); S.toklist = TOKLIST;
        EpiMoeDown E{TOKLIST, X3, nullptr}; gemm_phase<EpiMoeDown, OrdMoeT<true>, false, true>(lds, g, S, E);
        {
          int nidle = G - pg8::last_round_busy(S.nwg, G, true); if (nidle < 32) nidle = G; const int first = G - nidle;
          if (bx >= first) { Gemm g2{(const char*)(P16 + (size_t)T * PLE), (const char*)(ws + W_PP1), 512u, 512u, 128u * 512u, 256, 0}; OrdStd S2; S2.init(T / 512, 4, nidle, bx - first); S2.atile = 256u * 512u; S2.btile = 256u * 512u;
              EpiBf16 E2{PP1, D}; gemm_phase(lds, g2, S2, E2); } }
    }
    SEAM(16);
    if (IN(17)) REPL(17) { if (rep_) xcd_barrier(xbar);
        Gemm g{(const char*)HEXP, (const char*)(ws + W_EO), 2048u, 2048u, 128u * 2048u, 1024, 0}; OrdMoeT<true> S; S.setup((const LAS int*)(lds + LDS_MISC), 8, 8, 4, G, bx, 1024u * 2048u, 256u * 2048u); S.toklist = TOKLIST;
        EpiMoeDown E{TOKLIST, X3, SSA}; gemm_phase<EpiMoeDown, OrdMoeT<true>, false, true>(lds, g, S, E);
        {
          int nidle = G - pg8::last_round_busy(S.nwg, G, true); if (nidle < 32) nidle = G; const int first = G - nidle;
          if (bx >= first) { Gemm g2{(const char*)(P16 + (size_t)T * PLE + (size_t)(T / 2) * PLE), (const char*)(ws + W_PP1), 512u, 512u, 128u * 512u, 256, 0}; OrdStd S2; S2.init(T / 512, 4, nidle, bx - first); S2.atile = 256u * 512u; S2.btile = 256u * 512u;
              EpiBf16 E2{PP1 + (size_t)(T / 2) * D, D}; gemm_phase(lds, g2, S2, E2); } }
    }
    SEAM(17);
    if (IN(18)) REPL(18) { if (rep_) xcd_barrier(xbar);
        Gemm g{(const char*)X3, (const char*)(ws + W_PG1), 2048u, 2048u, 128u * 2048u, 1024, 0}; OrdStd S; S.init(T / 256, 4, G, bx); S.atile = 256u * 2048u; S.btile = 256u * 2048u;
        EpiPle<false, true> E{X3, PP1, PP1, SSA, SSB, (LAS float*)(lds + LDS_MISC + 1024)}; gemm_phase(lds, g, S, E);
    }
    SEAM(18);
    if (IN(19)) final_phase(PP1, args.out, SSB, (const float*)args.in[28], gw, NGW, lane);
#undef IN
#undef tid
#undef lane
#undef wave
#undef gtid
#undef gw
#undef SEAM
}
#ifndef SPLICE
#define SPLICE 0
#endif
#ifndef ONE_LAUNCH
#define ONE_LAUNCH 0
#endif
#if SPLICE
namespace nv {
__global__ void import_k(const bf16_t* __restrict__ src, float* __restrict__ dst, size_t n) {
    const size_t i = (size_t)blockIdx.x * blockDim.x + threadIdx.x; if (i < n) dst[i] = __uint_as_float((unsigned)src[i] << 16);
}
}
using namespace nv;
static inline void ngemm_l(hipStream_t s, const float* A, int lda, const float* B, int ldb, const float* R, int ldr, float* C, int ldc, int M, int N, int K) {
    hipLaunchKernelGGL(ngemm, dim3(N / NBN, M / NBM), dim3(256), 0, s, A, lda, B, ldb, R, ldr, C, ldc, K);
}
static inline int nb(size_t n) { return (int)((n + 255) / 256); }
#endif

extern "C" void kernel_launch(void* const* d_in, const int* in_sizes, int n_in, void* d_out, int out_size, void* d_ws, size_t ws_size, hipStream_t s) {
    static int inited = 0, grid_blocks = 0;
    if (!inited) {
        if (n_in != 29 || ws_size < WS_NEED) { fprintf(stderr, "kernel_launch: unexpected n_in %d / ws_size %zu (need %zu)\n", n_in, ws_size, (size_t)WS_NEED); inited = -1; return; }
        if (hipFuncSetAttribute((const void*)fwd, hipFuncAttributeMaxDynamicSharedMemorySize, LDS_BYTES) != hipSuccess) { fprintf(stderr, "kernel_launch: hipFuncSetAttribute failed\n"); inited = -1; return; }
        int dev = 0, cus = 0, per_cu = 0;
        if (hipGetDevice(&dev) != hipSuccess || hipDeviceGetAttribute(&cus, hipDeviceAttributeMultiprocessorCount, dev) != hipSuccess || cus < 1) { fprintf(stderr, "kernel_launch: device query failed\n"); inited = -1; return; }
        if (hipOccupancyMaxActiveBlocksPerMultiprocessor(&per_cu, (const void*)fwd, 512, LDS_BYTES) != hipSuccess || per_cu < 1) { fprintf(stderr, "kernel_launch: occupancy query reports %d workgroups per CU\n", per_cu); inited = -1; return; }
        grid_blocks = cus;
        if (cus != 256) { fprintf(stderr, "kernel_launch: built for a 256-CU device (got %d CUs)\n", cus); inited = -1; return; }
        inited = 1;
    }
    if (inited < 0) return;
    Args a{};
    for (int i = 0; i < 29; ++i) a.in[i] = d_in[i];
    a.out = (float*)d_out; a.ws = (unsigned char*)d_ws;
    const int grid = grid_blocks;
    (void)hipMemsetAsync((char*)d_ws + WS_BAR, 0, 32 * KiB, s);
#if ONE_LAUNCH
#ifdef PROBE_SPLIT
    { a.ph_lo = 0; a.ph_hi = PROBE_SPLIT + PROBE_REP; void* kargs[] = {&a};
      hipError_t e = hipLaunchCooperativeKernel((const void*)fwd, dim3(grid), dim3(512), kargs, LDS_BYTES, s);
      if (e != hipSuccess) fprintf(stderr, "cooperative launch failed: %s\n", hipGetErrorString(e)); }
    (void)hipMemsetAsync((char*)d_ws + WS_BAR, 0, 32 * KiB, s);
    { a.ph_lo = PROBE_SPLIT; a.ph_hi = NPHASE; void* kargs[] = {&a};
      hipError_t e = hipLaunchCooperativeKernel((const void*)fwd, dim3(grid), dim3(512), kargs, LDS_BYTES, s);
      if (e != hipSuccess) fprintf(stderr, "cooperative launch failed: %s\n", hipGetErrorString(e)); }
#else
    a.ph_lo = 0; a.ph_hi = NPHASE;
    void* kargs[] = {&a};
    hipError_t e = hipLaunchCooperativeKernel((const void*)fwd, dim3(grid), dim3(512), kargs, LDS_BYTES, s);
    if (e != hipSuccess) fprintf(stderr, "cooperative launch failed: %s\n", hipGetErrorString(e));
#endif
#else
    const int last = SPLICE ? SPLICE : NPHASE - 1;
    for (int ph = 0; ph <= last; ++ph) { a.ph_lo = ph; a.ph_hi = ph + 1; hipLaunchKernelGGL(fwd, dim3(grid), dim3(512), LDS_BYTES, s, a); }
#endif
#if SPLICE
    const float* x = (const float*)d_in[0]; const float* p = (const float*)d_in[1]; const int* pos = (const int*)d_in[2];
    const float* g_mix = (const float*)d_in[3]; const float* g_ffn = (const float*)d_in[4]; const float* g_ple = (const float*)d_in[5];
    const float* w_ple_gate = (const float*)d_in[6]; const float* w_ple_proj = (const float*)d_in[7];
    const float* w_lru_in = (const float*)d_in[8]; const float* conv_w = (const float*)d_in[9]; const float* conv_b = (const float*)d_in[10];
    const float* w_ga = (const float*)d_in[11]; const float* b_ga = (const float*)d_in[12]; const float* w_gx = (const float*)d_in[13]; const float* b_gx = (const float*)d_in[14];
    const float* lam = (const float*)d_in[15]; const float* w_lru_out = (const float*)d_in[16]; const float* g_kv = (const float*)d_in[17]; const float* w_kv = (const float*)d_in[18];
    const float* w_q = (const float*)d_in[19]; const float* sinks = (const float*)d_in[20]; const float* w_o = (const float*)d_in[21];
    const float* w_ff_in = (const float*)d_in[22]; const float* w_ff_out = (const float*)d_in[23]; const float* w_router = (const float*)d_in[24]; const float* b_router = (const float*)d_in[25];
    const float* w_exp_in = (const float*)d_in[26]; const float* w_exp_out = (const float*)d_in[27]; const float* g_final = (const float*)d_in[28];
    float* out = (float*)d_out; char* ws = (char*)d_ws;
    float* hf = (float*)(ws); float* xr = (float*)(ws + 96 * MiB); float* kvb = (float*)(ws + 128 * MiB); float* gts = (float*)(ws + 136 * MiB);
    float* big = (float*)(ws + 284 * MiB); float* xn = (float*)(ws + 476 * MiB);
    const int R = SEQ;
    for (int b = 0; b < BATCH; ++b) {
        const float* xb_in = x + (size_t)b * SEQ * D; const int* posb = pos + (size_t)b * SEQ; const size_t boff = (size_t)b * SEQ * D;
        float* h = big; float* xc = big + (size_t)R * 2048; float* rr = xc + (size_t)R * 1024; float* ig = rr + (size_t)R * 1024; float* y = ig + (size_t)R * 1024;
        if (SPLICE == 5) {
            hipLaunchKernelGGL(import_k, dim3(nb((size_t)R * D)), dim3(256), 0, s, (const bf16_t*)(ws + SL_B) + boff, xn, (size_t)R * D);
            ngemm_l(s, xn, D, w_lru_out, D, xb_in, D, xr, D, R, D, D);
        }
        if (SPLICE == 6 || SPLICE == 8) hipLaunchKernelGGL(import_k, dim3(nb((size_t)R * D)), dim3(256), 0, s, (const bf16_t*)(ws + SL_C) + boff, xr, (size_t)R * D);
        if (SPLICE == 9 || SPLICE == 12 || SPLICE == 17) hipLaunchKernelGGL(import_k, dim3(nb((size_t)R * D)), dim3(256), 0, s, (const bf16_t*)(ws + SL_B) + boff, xr, (size_t)R * D);
        if (SPLICE <= 6) {
            hipLaunchKernelGGL(rmsnorm_k, dim3(R / 4), dim3(256), 0, s, xr, g_ffn, xn, R);
            ngemm_l(s, xn, D, w_ff_in, 2 * DFF, nullptr, 0, big, 2 * DFF, R, 2 * DFF, D);
            hipLaunchKernelGGL(swiglu_k, dim3(nb((size_t)R * DFF)), dim3(256), 0, s, big, hf, R, DFF, (const float*)nullptr, 0);
            ngemm_l(s, hf, DFF, w_ff_out, D, xr, D, xr, D, R, D, DFF);
        }
        float* pg = big; float* pp = big + (size_t)R * 1024;
        if (SPLICE <= 8) {
            hipLaunchKernelGGL(rmsnorm_k, dim3(R / 4), dim3(256), 0, s, xr, g_ple, xn, R);
            ngemm_l(s, xn, D, w_ple_gate, D, nullptr, 0, pg, D, R, D, D);
            ngemm_l(s, p + (size_t)b * SEQ * PLE, PLE, w_ple_proj, D, nullptr, 0, pp, D, R, D, PLE);
            hipLaunchKernelGGL(ple_k, dim3(nb((size_t)R * 1024)), dim3(256), 0, s, xr, pg, pp, R);
        }
        float* q = big; float* at = big + (size_t)R * 1024;
        if (SPLICE <= 9) {
            hipLaunchKernelGGL(rmsnorm_k, dim3(R / 4), dim3(256), 0, s, xr, g_kv, xn, R);
            ngemm_l(s, xn, D, w_kv, 256, nullptr, 0, kvb, 256, R, 256, D);
            hipLaunchKernelGGL(rope_k, dim3(nb((size_t)R * 2 * 8)), dim3(256), 0, s, kvb, 256, 2, posb, R);
            hipLaunchKernelGGL(rmsnorm_k, dim3(R / 4), dim3(256), 0, s, xr, g_mix + D, xn, R);
            ngemm_l(s, xn, D, w_q, D, nullptr, 0, q, D, R, D, D);
            hipLaunchKernelGGL(rope_k, dim3(nb((size_t)R * 16 * 8)), dim3(256), 0, s, q, 1024, 16, posb, R);
            hipLaunchKernelGGL(attn_k, dim3(R * 16 / 4), dim3(256), 0, s, q, kvb, sinks, at, R);
            ngemm_l(s, at, D, w_o, D, xr, D, xr, D, R, D, D);
        }
        if (SPLICE <= 12) {
            hipLaunchKernelGGL(rmsnorm_k, dim3(R / 4), dim3(256), 0, s, xr, g_ffn + D, xn, R);
            hipLaunchKernelGGL(router_k, dim3(R / 4), dim3(256), 0, s, xn, w_router, b_router, gts, R);
            for (int e = 0; e < NE; ++e) {
                ngemm_l(s, xn, D, w_exp_in + (size_t)e * D * 2048, 2048, nullptr, 0, big, 2048, R, 2048, D);
                hipLaunchKernelGGL(swiglu_k, dim3(nb((size_t)R * 1024)), dim3(256), 0, s, big, hf, R, 1024, gts, e);
                ngemm_l(s, hf, D, w_exp_out + (size_t)e * D * D, D, xr, D, xr, D, R, D, D);
            }
        }
        if (SPLICE <= 17) {
            hipLaunchKernelGGL(rmsnorm_k, dim3(R / 4), dim3(256), 0, s, xr, g_ple + D, xn, R);
            ngemm_l(s, xn, D, w_ple_gate + (size_t)D * D, D, nullptr, 0, pg, D, R, D, D);
            ngemm_l(s, p + (size_t)(BATCH + b) * SEQ * PLE, PLE, w_ple_proj + (size_t)PLE * D, D, nullptr, 0, pp, D, R, D, PLE);
            hipLaunchKernelGGL(ple_k, dim3(nb((size_t)R * 1024)), dim3(256), 0, s, xr, pg, pp, R);
            hipLaunchKernelGGL(rmsnorm_k, dim3(R / 4), dim3(256), 0, s, xr, g_final, out + boff, R);
        }
        if (SPLICE == 18) hipLaunchKernelGGL(rmsnorm_k, dim3(R / 4), dim3(256), 0, s, out + boff, g_final, out + boff, R);
        (void)w_lru_in; (void)conv_w; (void)conv_b; (void)w_ga; (void)b_ga; (void)w_gx; (void)b_gx; (void)lam; (void)g_mix; (void)h; (void)y;
    }
#endif
}
```

```cpp
#include <hip/hip_runtime.h>
#include <hip/hip_cooperative_groups.h>
#include <cstdio>
#include <cstdint>
namespace cg = cooperative_groups;

#define LAS __attribute__((address_space(3)))
typedef unsigned short bf16_t;
typedef short bf16x8 __attribute__((ext_vector_type(8)));
typedef short s16x4 __attribute__((ext_vector_type(4)));
typedef float f32x4 __attribute__((ext_vector_type(4)));
typedef float f32x2 __attribute__((ext_vector_type(2)));
typedef float f32x16 __attribute__((ext_vector_type(16)));
typedef unsigned u32x4 __attribute__((ext_vector_type(4)));
typedef unsigned u32x2 __attribute__((ext_vector_type(2)));
typedef __bf16 bf16x2_t __attribute__((ext_vector_type(2)));

constexpr int D = 1024, BATCH = 4, SEQ = 8192, T = BATCH * SEQ, DFF = 3072, NE = 8, PLE = 256;
constexpr float EPS = 1e-6f;
constexpr float LOG2E = 1.4426950408889634f;
constexpr int XG_ROWS = 2 * T + 16 * 256;

__device__ __forceinline__ unsigned pk2(float lo, float hi) { f32x2 v = {lo, hi}; bf16x2_t b = __builtin_convertvector(v, bf16x2_t); return __builtin_bit_cast(unsigned, b); }
__device__ __forceinline__ float bflo(unsigned u) { return __uint_as_float(u << 16); }
__device__ __forceinline__ float bfhi(unsigned u) { return __uint_as_float(u & 0xffff0000u); }
__device__ __forceinline__ float amul(float a, float b) { float r; asm("v_mul_f32_e32 %0, %1, %2" : "=v"(r) : "v"(a), "v"(b)); return r; }
__device__ __forceinline__ float aadd(float a, float b) { float r; asm("v_add_f32_e32 %0, %1, %2" : "=v"(r) : "v"(a), "v"(b)); return r; }
__device__ __forceinline__ float asub(float a, float b) { float r; asm("v_sub_f32_e32 %0, %1, %2" : "=v"(r) : "v"(a), "v"(b)); return r; }
__device__ __forceinline__ float afma(float a, float b, float c) { float r; asm("v_fma_f32 %0, %1, %2, %3" : "=v"(r) : "v"(a), "v"(b), "v"(c)); return r; }
__device__ __forceinline__ void swiglu2(float g0, float u0, float g1, float u1, float n, float c, float& o0, float& o1) {
    float t0, t1, p0, p1;
    asm("v_mul_f32_e32 %0, %4, %8\n\tv_mul_f32_e32 %1, %6, %8\n\tv_exp_f32_e32 %0, %0\n\tv_exp_f32_e32 %1, %1\n\tv_mul_f32_e32 %2, %4, %5\n\t"
        "v_fma_f32 %0, %0, %9, %9\n\tv_fma_f32 %1, %1, %9, %9\n\tv_rcp_f32_e32 %0, %0\n\tv_rcp_f32_e32 %1, %1\n\tv_mul_f32_e32 %3, %6, %7\n\t"
        "v_mul_f32_e32 %0, %2, %0\n\tv_mul_f32_e32 %1, %3, %1"
        : "=&v"(t0), "=&v"(t1), "=&v"(p0), "=&v"(p1) : "v"(g0), "v"(u0), "v"(g1), "v"(u1), "v"(n), "v"(c));
    o0 = t0; o1 = t1;
}
__device__ __forceinline__ void plesig2(float a0, float a1, float n, float p0, float p1, float x0, float x1, float& o0, float& o1) {
    float t0, t1;
    asm("v_mul_f32_e32 %0, %2, %4\n\tv_mul_f32_e32 %1, %3, %4\n\tv_exp_f32_e32 %0, %0\n\tv_exp_f32_e32 %1, %1\n\ts_nop 0\n\tv_add_f32_e32 %0, 1.0, %0\n\tv_add_f32_e32 %1, 1.0, %1\n\t"
        "v_rcp_f32_e32 %0, %0\n\tv_rcp_f32_e32 %1, %1\n\ts_nop 0\n\tv_fma_f32 %0, %0, %5, %7\n\tv_fma_f32 %1, %1, %6, %8"
        : "=&v"(t0), "=&v"(t1) : "v"(a0), "v"(a1), "v"(n), "v"(p0), "v"(p1), "v"(x0), "v"(x1));
    o0 = t0; o1 = t1;
}
__device__ __forceinline__ void gelu2(float v0, float v1, float k1, float k2, float& o0, float& o1) {
    float t0, t1;
    asm("v_mul_f32_e32 %0, %2, %2\n\tv_mul_f32_e32 %1, %3, %3\n\tv_fma_f32 %0, %0, %5, %4\n\tv_fma_f32 %1, %1, %5, %4\n\tv_mul_f32_e32 %0, %0, %2\n\tv_mul_f32_e32 %1, %1, %3\n\t"
        "v_exp_f32_e32 %0, %0\n\tv_exp_f32_e32 %1, %1\n\ts_nop 0\n\tv_add_f32_e32 %0, 1.0, %0\n\tv_add_f32_e32 %1, 1.0, %1\n\tv_rcp_f32_e32 %0, %0\n\tv_rcp_f32_e32 %1, %1\n\ts_nop 0\n\t"
        "v_mul_f32_e32 %0, %2, %0\n\tv_mul_f32_e32 %1, %3, %1"
        : "=&v"(t0), "=&v"(t1) : "v"(v0), "v"(v1), "v"(k1), "v"(k2));
    o0 = t0; o1 = t1;
}
__device__ __forceinline__ float fsig(float x) { return __builtin_amdgcn_rcpf(1.0f + __builtin_amdgcn_exp2f(-LOG2E * x)); }
__device__ __forceinline__ float wave_sum(float v) {
#pragma unroll
    for (int o = 1; o < 64; o <<= 1) v += __shfl_xor(v, o);
    return v;
}
__device__ __forceinline__ u32x4 pack8(f32x4 a, f32x4 b) { u32x4 w; w.x = pk2(a[0], a[1]); w.y = pk2(a[2], a[3]); w.z = pk2(b[0], b[1]); w.w = pk2(b[2], b[3]); return w; }
__device__ __forceinline__ void unpack8(u32x4 w, f32x4& a, f32x4& b) { a[0] = bflo(w.x); a[1] = bfhi(w.x); a[2] = bflo(w.y); a[3] = bfhi(w.y); b[0] = bflo(w.z); b[1] = bfhi(w.z); b[2] = bflo(w.w); b[3] = bfhi(w.w); }

#ifndef WT_STORES
#define WT_STORES 0
#endif
__device__ __forceinline__ void st16(void* p, u32x4 v) {
#if WT_STORES
    asm volatile("global_store_dwordx4 %0, %1, off sc1\n\ts_nop 1" :: "v"(p), "v"(v) : "memory");
#else
    *(u32x4*)p = v;
#endif
}
__device__ __forceinline__ void st16f(void* p, f32x4 v) { st16(p, __builtin_bit_cast(u32x4, v)); }

typedef _Float16 f16x2_t __attribute__((ext_vector_type(2)));
__device__ __forceinline__ unsigned pack_h2(float a, float b) { f16x2_t v = {(_Float16)a, (_Float16)b}; return __builtin_bit_cast(unsigned, v); }
__device__ __forceinline__ void unpack_h2(unsigned w, float& a, float& b) { const f16x2_t v = __builtin_bit_cast(f16x2_t, w); a = (float)v.x; b = (float)v.y; }
#define SPLICE 0
#define ONE_LAUNCH 1
typedef __attribute__((address_space(1))) unsigned gu32;
#define RLX_AGENT __ATOMIC_RELAXED, __HIP_MEMORY_SCOPE_AGENT
#define XB_TMO      128
#define XB_XCNT(j)  (256  + 64 * (j))
#define XB_XSUB(j)  (1280 + 64 * (j))
#define XB_XGEN(j)  (2304 + 64 * (j))
#define XB_TOP      3328
#define XB_TOPGEN   3392
#define XCD_BAR_WORDS 3456
#define XB_SPIN_CAP (1u << 18)

__device__ __forceinline__ unsigned xb_ld(unsigned* p)              { return __hip_atomic_load(p, __ATOMIC_RELAXED, __HIP_MEMORY_SCOPE_AGENT); }
__device__ __forceinline__ unsigned xb_add(unsigned* p, unsigned v) { return __hip_atomic_fetch_add(p, v, __ATOMIC_RELAXED, __HIP_MEMORY_SCOPE_AGENT); }
__device__ __forceinline__ unsigned xb_xcc_id() { return (unsigned)__builtin_amdgcn_s_getreg((3 << 11) | 20) & 0xFu; }
#define XB_SPIN(cond, bar) do { unsigned _sp = 0; while (cond) { __builtin_amdgcn_s_sleep(1); \
    if ((++_sp & 255u) == 0u) { if (xb_ld(&(bar)[XB_TMO])) break; if (_sp > XB_SPIN_CAP) { atomicAdd(&(bar)[XB_TMO], 1u); break; } } } } while (0)

struct XcdBarrier {
    unsigned* bar; unsigned x;
    volatile LAS unsigned* st;
};

__device__ __forceinline__ XcdBarrier xcd_barrier_post(unsigned* bar, volatile LAS unsigned* st) {
    XcdBarrier b; b.bar = bar; b.x = xb_xcc_id(); b.st = st;
    if (threadIdx.x == 0) (void)xb_add(&bar[XB_XCNT(b.x)], 1u);
    return b;
}
__device__ __forceinline__ void xcd_barrier_complete(unsigned* bar, unsigned x, unsigned& nloc, unsigned& nx) {
    const unsigned G = gridDim.x * gridDim.y * gridDim.z;
    unsigned sum, cnt, mine, sp = 0u;
    for (;;) {
        sum = 0u; cnt = 0u; mine = 0u;
#pragma unroll
        for (unsigned j = 0; j < 16; ++j) { const unsigned c = xb_ld(&bar[XB_XCNT(j)]); sum += c; cnt += (c > 0u) ? 1u : 0u; mine = (j == x) ? c : mine; }
        if (sum == G) break;
        __builtin_amdgcn_s_sleep(1);
        if ((++sp & 255u) == 0u) { if (xb_ld(&bar[XB_TMO])) break; if (sp > XB_SPIN_CAP) { atomicAdd(&bar[XB_TMO], 1u); break; } }
    }
    nloc = mine > 0u ? mine : 1u; nx = cnt > 0u ? cnt : 1u;
}

__device__ __forceinline__ void xcd_barrier(const XcdBarrier& b) {
    asm volatile("s_waitcnt vmcnt(0)" ::: "memory");
    __syncthreads();
    if (threadIdx.x == 0) {
        unsigned* bar = b.bar;
        __builtin_amdgcn_s_waitcnt(0);
        unsigned nloc = b.st[0], nx = b.st[1];
        if (nloc == 0u) { xcd_barrier_complete(bar, b.x, nloc, nx); b.st[0] = nloc; b.st[1] = nx; }
        const unsigned old = xb_add(&bar[XB_XSUB(b.x)], 1u);
        const unsigned gen = old / nloc;
        if (old + 1u == (gen + 1u) * nloc) {
            __builtin_amdgcn_fence(__ATOMIC_RELEASE, "agent");
            asm volatile("s_waitcnt vmcnt(0)" ::: "memory");
            const unsigned og = xb_add(&bar[XB_TOP], 1u);
            const unsigned tg = og / nx;
            __builtin_amdgcn_fence(__ATOMIC_ACQUIRE, "agent");
            if (og + 1u == (tg + 1u) * nx) xb_add(&bar[XB_TOPGEN], 1u);
            else XB_SPIN(xb_ld(&bar[XB_TOPGEN]) == tg, bar);
            xb_add(&bar[XB_XGEN(b.x)], 1u);
            asm volatile("s_waitcnt vmcnt(0)" ::: "memory");
        } else {
            __builtin_amdgcn_fence(__ATOMIC_ACQUIRE, "agent");
            XB_SPIN(xb_ld(&bar[XB_XGEN(b.x)]) == gen, bar);
            asm volatile("s_waitcnt vmcnt(0)" ::: "memory");
        }
    }
    __syncthreads();
}

namespace pg8 {
constexpr int BM = 256, BK = 64, HALF = 128, HTB = HALF * BK * 2, STAGE_BYTES = 8 * HTB, NXCD = 8, WGM = 8;
__host__ __device__ __forceinline__ int lds_byte(int r, int c) { const int st = (r >> 4) * 2 + (c >> 5), rr = r & 15, cc = c & 31, ob = rr * 64 + cc * 2; return st * 1024 + (ob ^ (((ob >> 9) & 1) << 5)); }
__host__ __device__ __forceinline__ void stage_rc(int b, int& R, int& C) { const int st = b / 1024, sb = b % 1024, swz = sb ^ (((sb >> 9) & 1) << 5); R = (st >> 1) * 16 + swz / 64; C = (st & 1) * 32 + (swz % 64) / 2; }
__host__ __device__ __forceinline__ int perm32(int rho) { const int n = rho >> 4, i = rho & 15; return 8 * (i >> 2) + 4 * n + (i & 3); }

struct Unit { unsigned aoff, boff; int pm, pn, rb, half; };
struct Gemm { const char* A; const char* Bt; unsigned lda2, ldb2, hstepA; int K; int aperm; };

struct OrderBase {
    int nM, nN, nwg, G, c;
    __device__ __forceinline__ void init(int nM_, int nN_, int G_, int c_) { nM = nM_; nN = nN_; nwg = nM * nN; G = G_; c = c_; }
    __device__ __forceinline__ bool tile(int i, int& pm, int& pn) const {
        const long L = (long)i * G + c; if (L >= nwg) return false;
        int wgid = (int)L; { const int q = nwg / NXCD, r = nwg % NXCD, xcd = wgid % NXCD, off = wgid / NXCD; wgid = (xcd < r ? xcd * (q + 1) : r * (q + 1) + (xcd - r) * q) + off; }
        const int nig = WGM * nN, gid = wgid / nig, fm = gid * WGM, gsz = (nM - fm) < WGM ? (nM - fm) : WGM;
        pm = fm + ((wgid % nig) % gsz); pn = (wgid % nig) / gsz; return true;
    }
};
struct OrderHalf : OrderBase {
    __device__ __forceinline__ bool tileh(int i, int& pm, int& pn, int& half) const {
        const int nfull = (nwg / G) * G, rem = nwg - nfull; const bool split = rem > 0 && 2 * rem <= G;
        const long L = (long)i * G + c; int t;
        if (L < nfull || !split) { if (L >= nwg) return false; t = (int)L; half = 0; }
        else { const int x = (int)(L - nfull); if (x >= 2 * rem) return false; t = nfull + (x >> 1); half = 1 + (x & 1); }
        int wgid = t; { const int q = nwg / NXCD, r = nwg % NXCD, xcd = wgid % NXCD, off = wgid / NXCD; wgid = (xcd < r ? xcd * (q + 1) : r * (q + 1) + (xcd - r) * q) + off; }
        const int nig = WGM * nN, gid = wgid / nig, fm = gid * WGM, gsz = (nM - fm) < WGM ? (nM - fm) : WGM;
        pm = fm + ((wgid % nig) % gsz); pn = (wgid % nig) / gsz; return true;
    }
};
__device__ __forceinline__ int last_round_busy(int nwg, int G, bool halves) { const int rem = nwg % G; if (rem == 0) return 0; return (halves && 2 * rem <= G) ? 2 * rem : rem; }
struct OrdStd : OrderBase {
    unsigned atile, btile;
    __device__ __forceinline__ bool next(int i, Unit& u) const { if (!tile(i, u.pm, u.pn)) return false; u.aoff = (unsigned)u.pm * atile; u.boff = (unsigned)u.pn * btile; u.rb = u.pm * 256; u.half = 0; return true; }
};
struct OrdStdH : OrderHalf {
    unsigned atile, btile;
    __device__ __forceinline__ bool next(int i, Unit& u) const { if (!tileh(i, u.pm, u.pn, u.half)) return false; u.rb = u.pm * 256 + (u.half == 2 ? 128 : 0); u.aoff = (unsigned)u.pm * atile + (u.half == 2 ? atile / 2 : 0u); u.boff = (unsigned)u.pn * btile; return true; }
};

template <class Epi, class Sched, bool GATHER = false, bool HALFOK = false>
__device__ __forceinline__ void gemm_phase(LAS unsigned char* lds, const Gemm g, const Sched& S, const Epi& E) {
    const int tid = threadIdx.x, wid = __builtin_amdgcn_readfirstlane(tid >> 6), lane = tid & 63, wr = wid >> 2, wc = wid & 3, fr = lane & 15, fq = lane >> 4;
    int nt = g.K / BK; asm volatile("" : "+s"(nt));
    unsigned voffA[2], voffB[2]; int Rrow[2];
#pragma unroll
    for (int i = 0; i < 2; ++i) { int R, C; stage_rc(tid * 16 + i * 8192, R, C); const int Rb = Epi::PERM ? ((R & ~31) + perm32(R & 31)) : R;
        const int Ra = g.aperm ? (8 * ((R & 15) + 16 * (R >> 6)) + ((R >> 4) & 3)) : R;
        voffA[i] = GATHER ? (unsigned)C * 2u : (unsigned)Ra * g.lda2 + (unsigned)C * 2u; voffB[i] = (unsigned)Rb * g.ldb2 + (unsigned)C * 2u; Rrow[i] = R; }
    const size_t kstep = (size_t)(BK * 2);
    const size_t hstepA = g.hstepA, hstepB = (size_t)HALF * g.ldb2;
    const unsigned ldsw = (unsigned)wid * 1024u;
    const int aoff = lds_byte(wr * 64 + fr, fq * 8), boff = lds_byte(wc * 32 + fr, fq * 8);
#define PG8_SA(b, h) (((b) * 2 + (h)) * HTB)
#define PG8_SB(b, h) ((4 + (b) * 2 + (h)) * HTB)
#define PG8_STAGE(bufoff, gbase, voff) do { _Pragma("unroll") for (int _i = 0; _i < 2; ++_i) \
        __builtin_amdgcn_global_load_lds((const unsigned*)((const char*)(gbase) + (voff)[_i]), (LAS unsigned*)(lds + (bufoff) + ldsw + _i * 8192), 16, 0, 0); } while (0)
#define PG8_STAGE_A(bufoff, h, kptr, koff, usenext) do { if constexpr (GATHER) { unsigned vo_[2]; _Pragma("unroll") for (int _i = 0; _i < 2; ++_i) vo_[_i] = (usenext) ? gaN[h][_i] : gaC[h][_i]; \
        PG8_STAGE(bufoff, g.A + (koff), vo_); } else { PG8_STAGE(bufoff, (kptr) + (h) * hstepA, voffA); } } while (0)
#define PG8_LDA(dst, b, h) do { _Pragma("unroll") for (int m = 0; m < 4; ++m) _Pragma("unroll") for (int k = 0; k < 2; ++k) dst[m][k] = *(const LAS bf16x8*)(lds + PG8_SA(b, h) + aoff + m * 2048 + k * 1024); } while (0)
#define PG8_LDB(dst, b, h) do { _Pragma("unroll") for (int n = 0; n < 2; ++n) _Pragma("unroll") for (int k = 0; k < 2; ++k) dst[n][k] = *(const LAS bf16x8*)(lds + PG8_SB(b, h) + boff + n * 2048 + k * 1024); } while (0)
#define PG8_MMA(ai, bj, At, Bt) do { __builtin_amdgcn_s_setprio(1); _Pragma("unroll") for (int m = 0; m < 4; ++m) _Pragma("unroll") for (int n = 0; n < 2; ++n) _Pragma("unroll") for (int k = 0; k < 2; ++k) \
        acc[ai][bj][m][n] = __builtin_amdgcn_mfma_f32_16x16x32_bf16(Bt[n][k], At[m][k], acc[ai][bj][m][n], 0, 0, 0); __builtin_amdgcn_s_setprio(0); } while (0)
#define PG8_WAIT_V(n) asm volatile("s_waitcnt vmcnt(" #n ")" ::: "memory")
#define PG8_WAIT_L(n) asm volatile("s_waitcnt lgkmcnt(" #n ")" ::: "memory")
#define PG8_BAR __builtin_amdgcn_s_barrier()
#define PG8_SCHED __builtin_amdgcn_sched_barrier(0)
    Unit cur, nxt; int ui = 0;
    if (!S.next(0, cur)) return;
    f32x4 acc[2][2][4][2];
#pragma unroll
    for (int a = 0; a < 2; ++a)
#pragma unroll
        for (int b = 0; b < 2; ++b)
#pragma unroll
            for (int m = 0; m < 4; ++m)
#pragma unroll
                for (int n = 0; n < 2; ++n) acc[a][b][m][n] = (f32x4){0.f, 0.f, 0.f, 0.f};
    bf16x8 At[4][2], B0[2][2], B1[2][2];
    LAS unsigned* pbuf = (LAS unsigned*)(lds + 147456 + wid * 2048);
    typename Epi::Pre pre; E.prefetch(cur, wr, wc, fr, fq, pre, pbuf);
    const char* cA = g.A + cur.aoff; const char* cB = g.Bt + cur.boff;
    unsigned gaC[2][2], gaN[2][2];
    if constexpr (GATHER) {
#pragma unroll
        for (int h = 0; h < 2; ++h)
#pragma unroll
            for (int i = 0; i < 2; ++i) { const int tk = (HALFOK && cur.half && h == 1) ? 0 : S.toklist[cur.rb + h * 128 + Rrow[i]]; gaC[h][i] = (unsigned)(tk < 0 ? 0 : tk) * g.lda2 + voffA[i]; gaN[h][i] = gaC[h][i]; } }
    PG8_STAGE(PG8_SB(0, 0), cB, voffB); PG8_STAGE(PG8_SB(0, 1), cB + hstepB, voffB); PG8_STAGE_A(PG8_SA(0, 0), 0, cA, 0, false); PG8_STAGE_A(PG8_SA(0, 1), 1, cA, 0, false);
    if (wr == 1) PG8_BAR;
    PG8_WAIT_V(2); PG8_BAR;
    PG8_STAGE(PG8_SB(1, 0), cB + kstep, voffB); PG8_STAGE_A(PG8_SA(1, 0), 0, cA + kstep, kstep, false); PG8_STAGE(PG8_SB(1, 1), cB + hstepB + kstep, voffB);
    PG8_WAIT_V(6); PG8_BAR;
    for (;;) {
        const bool fullu = cur.half == 0;
        const bool has_next = S.next(ui + 1, nxt);
        const char* nA = has_next ? g.A + nxt.aoff : cA; const char* nB = has_next ? g.Bt + nxt.boff : cB;
        if constexpr (GATHER) { if (has_next) {
#pragma unroll
            for (int h = 0; h < 2; ++h)
#pragma unroll
                for (int i = 0; i < 2; ++i) { const int tk = (HALFOK && nxt.half && h == 1) ? 0 : S.toklist[nxt.rb + h * 128 + Rrow[i]]; gaN[h][i] = (unsigned)(tk < 0 ? 0 : tk) * g.lda2 + voffA[i]; } } }
#pragma unroll 1
        for (int t = 0; t < nt; t += 2) {
            const bool last = (t == nt - 2);
            const char* a1 = cA + (size_t)(t + 1) * kstep;
            const char* a2 = last ? nA : cA + (size_t)(t + 2) * kstep; const char* b2 = last ? nB : cB + (size_t)(t + 2) * kstep;
            const char* a3 = a2 + kstep; const char* b3 = b2 + kstep;
            const size_t k1 = (size_t)(t + 1) * kstep, k2 = last ? 0 : (size_t)(t + 2) * kstep, k3 = k2 + kstep;
            PG8_LDB(B0, 0, 0); PG8_LDB(B1, 0, 1); PG8_SCHED; PG8_LDA(At, 0, 0); PG8_STAGE_A(PG8_SA(1, 1), 1, a1, k1, false);
            PG8_WAIT_V(8); PG8_WAIT_L(0); PG8_BAR; PG8_MMA(0, 0, At, B0); PG8_MMA(0, 1, At, B1); PG8_BAR; PG8_SCHED;
            PG8_LDA(At, 0, 1); PG8_STAGE(PG8_SB(0, 0), b2, voffB); PG8_STAGE(PG8_SB(0, 1), b2 + hstepB, voffB); PG8_STAGE_A(PG8_SA(0, 0), 0, a2, k2, last);
            PG8_WAIT_V(8); PG8_WAIT_L(0); PG8_BAR; if (!HALFOK || fullu) { PG8_MMA(1, 0, At, B0); PG8_MMA(1, 1, At, B1); } PG8_BAR; PG8_SCHED;
            PG8_LDB(B0, 1, 0); PG8_LDB(B1, 1, 1); PG8_SCHED; PG8_LDA(At, 1, 0); PG8_STAGE_A(PG8_SA(0, 1), 1, a2, k2, last);
            PG8_WAIT_V(8); PG8_WAIT_L(0); PG8_BAR; PG8_MMA(0, 0, At, B0); PG8_MMA(0, 1, At, B1); PG8_BAR; PG8_SCHED;
            PG8_LDA(At, 1, 1); PG8_STAGE(PG8_SB(1, 0), b3, voffB); PG8_STAGE(PG8_SB(1, 1), b3 + hstepB, voffB); PG8_STAGE_A(PG8_SA(1, 0), 0, a3, k3, last);
            PG8_WAIT_V(8); PG8_WAIT_L(0); PG8_BAR; if (!HALFOK || fullu) { PG8_MMA(1, 0, At, B0); PG8_MMA(1, 1, At, B1); } PG8_BAR; PG8_SCHED;
        }
        if (wr == 0) PG8_BAR;
        if constexpr (Epi::EARLYPF) {
            typename Epi::Regs rg; E.consume(cur, wr, wc, fr, fq, pbuf, rg);
            asm volatile("s_waitcnt lgkmcnt(0)" ::: "memory");
            if (has_next) E.prefetch(nxt, wr, wc, fr, fq, pre, pbuf);
            E.body(acc, cur, wr, wc, fr, fq, rg);
        } else E(acc, cur, wr, wc, fr, fq, pre, pbuf);
        if (!has_next) break;
#pragma unroll
        for (int a = 0; a < 2; ++a)
#pragma unroll
            for (int b = 0; b < 2; ++b)
#pragma unroll
                for (int m = 0; m < 4; ++m)
#pragma unroll
                    for (int n = 0; n < 2; ++n) acc[a][b][m][n] = (f32x4){0.f, 0.f, 0.f, 0.f};
        cur = nxt; cA = nA; cB = nB; ++ui;
        if constexpr (!Epi::EARLYPF) {
            asm volatile("s_waitcnt lgkmcnt(0)" ::: "memory");
            E.prefetch(cur, wr, wc, fr, fq, pre, pbuf); }
        if constexpr (GATHER) {
#pragma unroll
            for (int h = 0; h < 2; ++h)
#pragma unroll
                for (int i = 0; i < 2; ++i) gaC[h][i] = gaN[h][i]; }
        if (wr == 1) PG8_BAR;
    }
    PG8_WAIT_V(0);
    PG8_BAR;
#undef PG8_SA
#undef PG8_SB
#undef PG8_STAGE
#undef PG8_STAGE_A
#undef PG8_LDA
#undef PG8_LDB
#undef PG8_MMA
#undef PG8_WAIT_V
#undef PG8_WAIT_L
#undef PG8_BAR
#undef PG8_SCHED
}
}
using pg8::Unit; using pg8::Gemm; using pg8::OrdStd; using pg8::gemm_phase;
typedef f32x4 Acc[2][2][4][2];
struct NoPre {};
__device__ __forceinline__ void dma4(const void* gsrc, LAS unsigned* pbuf, int k) { __builtin_amdgcn_global_load_lds((const unsigned*)gsrc, pbuf + k * 64, 4, 0, 0); }
__device__ __forceinline__ LAS unsigned* pbuf2_of(LAS unsigned* pbuf) { const int wid = threadIdx.x >> 6; return pbuf - (147456 / 4 + wid * 512) + ((131072 + 1024) / 4 + wid * 128); }
#define EPI_NOPRE typedef NoPre Pre; __device__ __forceinline__ void prefetch(const Unit&, int, int, int, int, Pre&, LAS unsigned*) const {}
#define EPI_ROW(u, ai, wr, m, fr) ((u).rb + (ai) * 128 + (wr) * 64 + (m) * 16 + (fr))
#define EPI_NA(u) ((u).half ? 1 : 2)

#define SS1_IDX(row, pn) ((size_t)(pn) * T + (size_t)(row))
struct Pre8 { float v[2][4]; };
__device__ __forceinline__ void ss_prefetch(const float* SS, const Unit& u, int wr, int fr, int fq, Pre8& p) {
#pragma unroll
    for (int ai = 0; ai < 2; ++ai)
#pragma unroll
        for (int m = 0; m < 4; ++m) p.v[ai][m] = SS[SS1_IDX(EPI_ROW(u, ai, wr, m, fr), fq)];
}
__device__ __forceinline__ void ss16_prefetch(const float* SS, const Unit& u, int wr, int fr, int fq, Pre8& p) {
#pragma unroll
    for (int ai = 0; ai < 2; ++ai)
#pragma unroll
        for (int m = 0; m < 4; ++m) { const f32x4 v = *(const f32x4*)(SS + (size_t)EPI_ROW(u, ai, wr, m, fr) * 16 + fq * 4); p.v[ai][m] = (v[0] + v[1]) + (v[2] + v[3]); }
}
__device__ __forceinline__ void ss_finish(const Pre8& p, float (&rs)[2][4]) {
#pragma unroll
    for (int ai = 0; ai < 2; ++ai)
#pragma unroll
        for (int m = 0; m < 4; ++m) { float s = p.v[ai][m]; s += __shfl_xor(s, 16); s += __shfl_xor(s, 32); rs[ai][m] = 1.0f / sqrtf(s * (1.0f / D) + EPS); }
}
__device__ __forceinline__ void ss_stage(LAS float* sst, int ai, int wr, int m, int fr, int wc, int fq, float ss) { if (fq == 0) sst[(ai * 128 + wr * 64 + m * 16 + fr) * 4 + wc] = ss; }
__device__ __forceinline__ void ss_flush(LAS float* sst, float* SS, const Unit& u, const int* toklist) {
    asm volatile("s_waitcnt lgkmcnt(0)" ::: "memory"); __syncthreads();
    const int t = threadIdx.x;
    if (t < (u.half ? 128 : 256)) { const f32x4 v = *(const LAS f32x4*)(sst + t * 4); int row = u.rb + t; if (toklist) row = toklist[row];
        if (row >= 0) SS[SS1_IDX(row, u.pn)] = (v[0] + v[1]) + (v[2] + v[3]); }
}
__device__ __forceinline__ float sumsq8(f32x4 a, f32x4 b) { float s0 = amul(a[0], a[0]), s1 = amul(b[0], b[0]);
#pragma unroll
    for (int i = 1; i < 4; ++i) { s0 = afma(a[i], a[i], s0); s1 = afma(b[i], b[i], s1); }
    return aadd(s0, s1); }
__device__ __forceinline__ f32x4 aadd4(f32x4 a, f32x4 b) { f32x4 r; r[0] = aadd(a[0], b[0]); r[1] = aadd(a[1], b[1]); r[2] = aadd(a[2], b[2]); r[3] = aadd(a[3], b[3]); return r; }
__device__ __forceinline__ f32x4 amul4(f32x4 a, float b) { f32x4 r; r[0] = amul(a[0], b); r[1] = amul(a[1], b); r[2] = amul(a[2], b); r[3] = amul(a[3], b); return r; }
__device__ __forceinline__ void put_ss(float* SS, int row, int slot, float ss, int fq) {
    ss += __shfl_xor(ss, 16); ss += __shfl_xor(ss, 32);
    if (fq == 0) SS[(size_t)row * 16 + slot] = ss;
}

struct EpiNull {
    static constexpr bool PERM = true; static constexpr bool EARLYPF = false; EPI_NOPRE
    float* sink;
    __device__ __forceinline__ void operator()(Acc& acc, const Unit& u, int wr, int wc, int fr, int fq, const Pre&, LAS unsigned* pbuf) const {
        float z = 0.f;
#pragma unroll
        for (int ai = 0; ai < 2; ++ai)
#pragma unroll
            for (int bj = 0; bj < 2; ++bj)
#pragma unroll
                for (int m = 0; m < 4; ++m)
#pragma unroll
                    for (int n = 0; n < 2; ++n) z += (acc[ai][bj][m][n][0] + acc[ai][bj][m][n][1]) + (acc[ai][bj][m][n][2] + acc[ai][bj][m][n][3]);
        if (z == 1.2345e-30f) sink[0] = z;
    }
};
struct EpiBf16 {
    static constexpr bool PERM = true; static constexpr bool EARLYPF = false; EPI_NOPRE
    bf16_t* O; int ldc;
    __device__ __forceinline__ void operator()(Acc& acc, const Unit& u, int wr, int wc, int fr, int fq, const Pre&, LAS unsigned* pbuf) const {
        const int col0 = u.pn * 256 + wc * 32 + 8 * fq;
#pragma unroll
        for (int ai = 0; ai < 2; ++ai)
#pragma unroll
            for (int m = 0; m < 4; ++m) { bf16_t* rowp = O + (size_t)EPI_ROW(u, ai, wr, m, fr) * ldc + col0;
#pragma unroll
                for (int bj = 0; bj < 2; ++bj) st16(rowp + bj * 128, pack8(acc[ai][bj][m][0], acc[ai][bj][m][1])); }
    }
};
struct EpiInProj {
    static constexpr bool PERM = true; static constexpr bool EARLYPF = false; typedef NoPre Pre;
    bf16_t* gate; bf16_t* xb; const float* rstd0;
    __device__ __forceinline__ void prefetch(const Unit& u, int wr, int wc, int fr, int fq, Pre&, LAS unsigned* pbuf) const {
#pragma unroll
        for (int ai = 0; ai < 2; ++ai)
#pragma unroll
            for (int m = 0; m < 4; ++m) dma4(rstd0 + EPI_ROW(u, ai, wr, m, fr), pbuf, ai * 4 + m);
    }
    __device__ __forceinline__ void operator()(Acc& acc, const Unit& u, int wr, int wc, int fr, int fq, const Pre&, LAS unsigned* pbuf) const {
        const bool isg = u.pn < 4;
        bf16_t* dst = isg ? gate : xb;
        const int col0 = (u.pn & 3) * 256 + wc * 32 + 8 * fq;
#pragma unroll
        for (int ai = 0; ai < 2; ++ai)
#pragma unroll
            for (int m = 0; m < 4; ++m) { const int row = EPI_ROW(u, ai, wr, m, fr); const float rs = __uint_as_float(pbuf[(ai * 4 + m) * 64 + (threadIdx.x & 63)]); bf16_t* rowp = dst + (size_t)row * D + col0;
#pragma unroll
                for (int bj = 0; bj < 2; ++bj) { f32x4 v0 = amul4(acc[ai][bj][m][0], rs), v1 = amul4(acc[ai][bj][m][1], rs);
                    if (isg) {
#pragma unroll
                        for (int i = 0; i < 4; ++i) {
                            float r0, r1; gelu2(v0[i], v1[i], -2.302208198f, -0.10294324f, r0, r1); v0[i] = r0; v1[i] = r1; }
                    }
                    st16(rowp + bj * 128, pack8(v0, v1)); } }
    }
};
struct EpiGates {
    static constexpr bool PERM = true; static constexpr bool EARLYPF = false; EPI_NOPRE
    const bf16_t* xc; const float* bga; const float* bgx; const float* c8g; bf16_t* hl; bf16_t* pc; float* aggA; float* aggH;
    __device__ __forceinline__ void operator()(Acc& acc, const Unit& u, int wr, int wc, int fr, int fq, const Pre&, LAS unsigned* pbuf) const {
        const int ch0 = (u.pn >> 1) * 256 + (u.pn & 1) * 128 + wc * 32 + 8 * fq;
        const int t0 = u.pm * 256 + 8 * (fr + 16 * wr);
        u32x4 xw[8]; u32x2 hkeep[8], pkeep[8];
        { const bf16_t* xp = xc + (size_t)t0 * D + ch0;
#pragma unroll
          for (int j = 0; j < 8; ++j) xw[j] = *(const u32x4*)(xp + j * D); }
#pragma unroll
        for (int n = 0; n < 2; ++n) { const int ch = ch0 + 4 * n;
            __builtin_amdgcn_sched_barrier(0);
            const f32x4 ba = *(const f32x4*)(bga + ch), bx = *(const f32x4*)(bgx + ch), c8 = *(const f32x4*)(c8g + ch);
            float hp[4], pp[4];
#pragma unroll
            for (int i = 0; i < 4; ++i) { hp[i] = 0.f; pp[i] = 1.f; }
#pragma unroll
            for (int j = 0; j < 8; ++j) { const int ai = j >> 2, m = j & 3; const bool first = ((t0 + j) & (SEQ - 1)) == 0;
                const unsigned xa = n ? xw[j].z : xw[j].x, xb2 = n ? xw[j].w : xw[j].y;
                const float xv[4] = {bflo(xa), bfhi(xa), bflo(xb2), bfhi(xb2)};
#pragma unroll
                for (int i = 0; i < 4; ++i) {
                    const float rr = fsig(acc[ai][0][m][n][i] + ba[i]), ii = fsig(acc[ai][1][m][n][i] + bx[i]);
                    const float a = __builtin_amdgcn_exp2f(c8[i] * rr);
                    const float mult = first ? 1.0f : __builtin_amdgcn_sqrtf(fmaf(-a, a, 1.0f));
                    const float b = mult * ii * xv[i];
                    hp[i] = fmaf(a, hp[i], b); pp[i] *= a;
                    acc[ai][0][m][n][i] = hp[i]; acc[ai][1][m][n][i] = pp[i]; }
                __builtin_amdgcn_sched_barrier(0); }
#pragma unroll
            for (int d = 1; d < 16; d <<= 1)
#pragma unroll
                for (int i = 0; i < 4; ++i) { const float Ao = __shfl_up(pp[i], d, 16), Ho = __shfl_up(hp[i], d, 16);
                    if (fr >= d) { hp[i] = fmaf(pp[i], Ho, hp[i]); pp[i] *= Ao; } }
            float Ae[4], He[4];
#pragma unroll
            for (int i = 0; i < 4; ++i) { const float Ao = __shfl_up(pp[i], 1, 16), Ho = __shfl_up(hp[i], 1, 16); Ae[i] = fr ? Ao : 1.0f; He[i] = fr ? Ho : 0.0f; }
            if (fr == 15) { const int chunk = 2 * u.pm + wr;
                st16f(aggA + (size_t)chunk * D + ch, (f32x4){pp[0], pp[1], pp[2], pp[3]}); st16f(aggH + (size_t)chunk * D + ch, (f32x4){hp[0], hp[1], hp[2], hp[3]}); }
            { bf16_t* hq = hl + (size_t)t0 * D + ch0; bf16_t* pq = pc + (size_t)t0 * D + ch0;
#pragma unroll
              for (int j = 0; j < 8; ++j) { const int ai = j >> 2, m = j & 3; f32x4 hv, pv;
#pragma unroll
                for (int i = 0; i < 4; ++i) { hv[i] = fmaf(acc[ai][1][m][n][i], He[i], acc[ai][0][m][n][i]); pv[i] = acc[ai][1][m][n][i] * Ae[i]; }
                u32x2 hw, pw; hw.x = pk2(hv[0], hv[1]); hw.y = pk2(hv[2], hv[3]); pw.x = pk2(pv[0], pv[1]); pw.y = pk2(pv[2], pv[3]);
                if (n == 0) { hkeep[j] = hw; pkeep[j] = pw; }
                else { st16(hq + j * D, (u32x4){hkeep[j].x, hkeep[j].y, hw.x, hw.y}); st16(pq + j * D, (u32x4){pkeep[j].x, pkeep[j].y, pw.x, pw.y}); } } }
        }
    }
};
struct EpiGatesF {
    static constexpr bool PERM = true; static constexpr bool EARLYPF = false; EPI_NOPRE
    const bf16_t* xc; const float* bga; const float* bgx; const float* c8g; const bf16_t* gate; bf16_t* y; float* aggA; float* aggH; float* rc; const XcdBarrier* xb;
    __device__ __forceinline__ void operator()(Acc& acc, const Unit& u, int wr, int wc, int fr, int fq, const Pre&, LAS unsigned* pbuf) const {
        const int ch0 = (u.pn >> 1) * 256 + (u.pn & 1) * 128 + wc * 32 + 8 * fq;
        const int t0 = u.pm * 256 + 8 * (fr + 16 * wr);
        const int chunk = 2 * u.pm + wr;
        { u32x4 xw[8];
          { const bf16_t* xp = xc + (size_t)t0 * D + ch0;
#pragma unroll
            for (int j = 0; j < 8; ++j) xw[j] = *(const u32x4*)(xp + j * D); }
#pragma unroll
          for (int n = 0; n < 2; ++n) { const int ch = ch0 + 4 * n;
            __builtin_amdgcn_sched_barrier(0);
            const f32x4 ba = *(const f32x4*)(bga + ch), bx = *(const f32x4*)(bgx + ch), c8 = *(const f32x4*)(c8g + ch);
            float hp[4], pp[4];
#pragma unroll
            for (int i = 0; i < 4; ++i) { hp[i] = 0.f; pp[i] = 1.f; }
#pragma unroll
            for (int j = 0; j < 8; ++j) { const int ai = j >> 2, m = j & 3; const bool first = ((t0 + j) & (SEQ - 1)) == 0;
                const unsigned xa = n ? xw[j].z : xw[j].x, xb2 = n ? xw[j].w : xw[j].y;
                const float xv[4] = {bflo(xa), bfhi(xa), bflo(xb2), bfhi(xb2)};
#pragma unroll
                for (int i = 0; i < 4; ++i) {
                    const float rr = fsig(acc[ai][0][m][n][i] + ba[i]), ii = fsig(acc[ai][1][m][n][i] + bx[i]);
                    const float a = __builtin_amdgcn_exp2f(c8[i] * rr);
                    const float mult = first ? 1.0f : __builtin_amdgcn_sqrtf(fmaf(-a, a, 1.0f));
                    const float b = mult * ii * xv[i];
                    hp[i] = fmaf(a, hp[i], b); pp[i] *= a;
                    acc[ai][0][m][n][i] = hp[i]; acc[ai][1][m][n][i] = pp[i]; }
                __builtin_amdgcn_sched_barrier(0); }
#pragma unroll
            for (int d = 1; d < 16; d <<= 1)
#pragma unroll
                for (int i = 0; i < 4; ++i) { const float Ao = __shfl_up(pp[i], d, 16), Ho = __shfl_up(hp[i], d, 16);
                    if (fr >= d) { hp[i] = fmaf(pp[i], Ho, hp[i]); pp[i] *= Ao; } }
            float Ae[4], He[4];
#pragma unroll
            for (int i = 0; i < 4; ++i) { const float Ao = __shfl_up(pp[i], 1, 16), Ho = __shfl_up(hp[i], 1, 16); Ae[i] = fr ? Ao : 1.0f; He[i] = fr ? Ho : 0.0f; }
            if (fr == 15) { st16f(aggA + (size_t)chunk * D + ch, (f32x4){pp[0], pp[1], pp[2], pp[3]}); st16f(aggH + (size_t)chunk * D + ch, (f32x4){hp[0], hp[1], hp[2], hp[3]}); }
#pragma unroll
            for (int j = 0; j < 8; ++j) { const int ai = j >> 2, m = j & 3;
#pragma unroll
                for (int i = 0; i < 4; ++i) { const float P = acc[ai][1][m][n][i]; acc[ai][0][m][n][i] = fmaf(P, He[i], acc[ai][0][m][n][i]); acc[ai][1][m][n][i] = P * Ae[i]; } }
          } }
        xcd_barrier(*xb);
        const int b = u.pm >> 5, tt = u.pm & 31, rnd = tt >> 3, c0 = b * 64 + 16 * rnd;
        f32x4 cr0 = {0.f, 0.f, 0.f, 0.f}, cr1 = {0.f, 0.f, 0.f, 0.f};
        if (rnd > 0) { const float* rp = rc + ((size_t)(b * 4 + rnd)) * D + ch0; cr0 = *(const f32x4*)rp; cr1 = *(const f32x4*)(rp + 4); }
        for (int cc = c0; cc < chunk; ++cc) { const f32x4 a0 = *(const f32x4*)(aggA + (size_t)cc * D + ch0), a1 = *(const f32x4*)(aggA + (size_t)cc * D + ch0 + 4);
            const f32x4 h0 = *(const f32x4*)(aggH + (size_t)cc * D + ch0), h1 = *(const f32x4*)(aggH + (size_t)cc * D + ch0 + 4);
#pragma unroll
            for (int i = 0; i < 4; ++i) { cr0[i] = fmaf(a0[i], cr0[i], h0[i]); cr1[i] = fmaf(a1[i], cr1[i], h1[i]); } }
        if ((tt & 7) == 7 && wr == 1 && rnd < 3 && fr == 0) {
            const f32x4 a0 = *(const f32x4*)(aggA + (size_t)chunk * D + ch0), a1 = *(const f32x4*)(aggA + (size_t)chunk * D + ch0 + 4);
            const f32x4 h0 = *(const f32x4*)(aggH + (size_t)chunk * D + ch0), h1 = *(const f32x4*)(aggH + (size_t)chunk * D + ch0 + 4);
            f32x4 e0, e1;
#pragma unroll
            for (int i = 0; i < 4; ++i) { e0[i] = fmaf(a0[i], cr0[i], h0[i]); e1[i] = fmaf(a1[i], cr1[i], h1[i]); }
            float* rp = rc + ((size_t)(b * 4 + rnd + 1)) * D + ch0; st16f(rp, e0); st16f(rp + 4, e1); }
        { u32x4 gw[8]; const bf16_t* gp = gate + (size_t)t0 * D + ch0;
#pragma unroll
          for (int j = 0; j < 8; ++j) gw[j] = *(const u32x4*)(gp + j * D);
          bf16_t* yp = y + (size_t)t0 * D + ch0;
#pragma unroll
          for (int j = 0; j < 8; ++j) { const int ai = j >> 2, m = j & 3; f32x4 g0, g1, o0, o1; unpack8(gw[j], g0, g1);
#pragma unroll
            for (int i = 0; i < 4; ++i) { o0[i] = fmaf(acc[ai][1][m][0][i], cr0[i], acc[ai][0][m][0][i]) * g0[i]; o1[i] = fmaf(acc[ai][1][m][1][i], cr1[i], acc[ai][0][m][1][i]) * g1[i]; }
            st16(yp + j * D, pack8(o0, o1)); } }
    }
};
template <bool RF32> struct EpiRes {
    static constexpr bool PERM = true; static constexpr bool EARLYPF = false; EPI_NOPRE
    const void* R; bf16_t* X; float* SS; LAS float* sst;
    __device__ __forceinline__ void operator()(Acc& acc, const Unit& u, int wr, int wc, int fr, int fq, const Pre&, LAS unsigned* pbuf) const {
        const int col0 = u.pn * 256 + wc * 32 + 8 * fq;
        if (RF32) {
#pragma unroll
            for (int ai = 0; ai < 2; ++ai) { f32x4 rv[4][2][2];
#pragma unroll
                for (int m = 0; m < 4; ++m)
#pragma unroll
                    for (int bj = 0; bj < 2; ++bj) { const float* rp = (const float*)R + (size_t)EPI_ROW(u, ai, wr, m, fr) * D + col0 + bj * 128; rv[m][bj][0] = *(const f32x4*)rp; rv[m][bj][1] = *(const f32x4*)(rp + 4); }
                __builtin_amdgcn_sched_barrier(0);
#pragma unroll
                for (int m = 0; m < 4; ++m) { const int row = EPI_ROW(u, ai, wr, m, fr); float ss = 0.f;
#pragma unroll
                    for (int bj = 0; bj < 2; ++bj) { const f32x4 v0 = aadd4(acc[ai][bj][m][0], rv[m][bj][0]), v1 = aadd4(acc[ai][bj][m][1], rv[m][bj][1]);
                        ss = aadd(ss, sumsq8(v0, v1)); st16(X + (size_t)row * D + col0 + bj * 128, pack8(v0, v1)); }
                    ss += __shfl_xor(ss, 16); ss += __shfl_xor(ss, 32); ss_stage(sst, ai, wr, m, fr, wc, fq, ss); }
                __builtin_amdgcn_sched_barrier(0); }
        } else {
#pragma unroll
            for (int ai = 0; ai < 2; ++ai) { u32x4 rv[4][2];
#pragma unroll
                for (int m = 0; m < 4; ++m)
#pragma unroll
                    for (int bj = 0; bj < 2; ++bj) rv[m][bj] = *(const u32x4*)((const bf16_t*)R + (size_t)EPI_ROW(u, ai, wr, m, fr) * D + col0 + bj * 128);
                __builtin_amdgcn_sched_barrier(0);
#pragma unroll
                for (int m = 0; m < 4; ++m) { const int row = EPI_ROW(u, ai, wr, m, fr); float ss = 0.f;
#pragma unroll
                    for (int bj = 0; bj < 2; ++bj) { f32x4 r0, r1; unpack8(rv[m][bj], r0, r1);
                        const f32x4 v0 = aadd4(acc[ai][bj][m][0], r0), v1 = aadd4(acc[ai][bj][m][1], r1);
                        ss = aadd(ss, sumsq8(v0, v1)); st16(X + (size_t)row * D + col0 + bj * 128, pack8(v0, v1)); }
                    ss += __shfl_xor(ss, 16); ss += __shfl_xor(ss, 32); ss_stage(sst, ai, wr, m, fr, wc, fq, ss); }
                __builtin_amdgcn_sched_barrier(0); }
        }
        ss_flush(sst, SS, u, nullptr);
    }
};
struct EpiSwiglu {
    static constexpr bool PERM = true; static constexpr bool EARLYPF = true; static constexpr int NVM = 12; typedef NoPre Pre;
    struct Regs { float ns[2][4], ic[2][4]; };
    bf16_t* O; int ldc; const float* SSin; const unsigned* slotp;
    __device__ __forceinline__ void prefetch(const Unit& u, int wr, int wc, int fr, int fq, Pre&, LAS unsigned* pbuf) const {
#pragma unroll
        for (int ai = 0; ai < 2; ++ai)
#pragma unroll
            for (int m = 0; m < 4; ++m) { const int row = EPI_ROW(u, ai, wr, m, fr); dma4(SSin ? (const void*)(SSin + SS1_IDX(row, fq)) : (const void*)(slotp + row), pbuf, ai * 4 + m); }
    }
    __device__ __forceinline__ void consume(const Unit& u, int wr, int wc, int fr, int fq, LAS unsigned* pbuf, Regs& rg) const {
        const int lane = threadIdx.x & 63;
#pragma unroll
        for (int ai = 0; ai < 2; ++ai)
#pragma unroll
            for (int m = 0; m < 4; ++m) { const unsigned w = pbuf[(ai * 4 + m) * 64 + lane];
                if (SSin) { float q = __uint_as_float(w); q += __shfl_xor(q, 16); q += __shfl_xor(q, 32); q = q * (1.0f / D) + EPS; rg.ic[ai][m] = q; rg.ns[ai][m] = -LOG2E * __builtin_amdgcn_rsqf(q); }
                else { float s_, sw_; unpack_h2(w, s_, sw_); rg.ns[ai][m] = -LOG2E * s_; rg.ic[ai][m] = fminf(__builtin_amdgcn_rcpf(s_ * sw_), 1e30f); } }
    }
    __device__ __forceinline__ void body(Acc& acc, const Unit& u, int wr, int wc, int fr, int fq, const Regs& rg) const {
        const int col0 = u.pn * 128 + wc * 32 + 8 * fq;
        const int na = EPI_NA(u);
#pragma unroll
        for (int ai = 0; ai < 2; ++ai) if (ai < na)
#pragma unroll
            for (int m = 0; m < 4; ++m) { const int row = EPI_ROW(u, ai, wr, m, fr); const float n_ = rg.ns[ai][m], c_ = rg.ic[ai][m];
                f32x4 o0, o1;
#pragma unroll
                for (int i = 0; i < 4; ++i) { const float g0 = acc[ai][0][m][0][i], u0 = acc[ai][1][m][0][i], g1 = acc[ai][0][m][1][i], u1 = acc[ai][1][m][1][i];
                    float r0, r1; swiglu2(g0, u0, g1, u1, n_, c_, r0, r1); o0[i] = r0; o1[i] = r1; }
                st16(O + (size_t)row * ldc + col0, pack8(o0, o1)); }
    }
};
template <bool OUTF32, bool IN16 = false> struct EpiPle {
    static constexpr bool PERM = true; static constexpr bool EARLYPF = false; typedef Pre8 Pre;
    const bf16_t* X; const bf16_t* PP; void* O; const float* SSin; float* SSout; LAS float* sst;
    __device__ __forceinline__ void prefetch(const Unit& u, int wr, int wc, int fr, int fq, Pre& p, LAS unsigned* pbuf) const { if (IN16) ss16_prefetch(SSin, u, wr, fr, fq, p); else ss_prefetch(SSin, u, wr, fr, fq, p); }
    __device__ __forceinline__ void operator()(Acc& acc, const Unit& u, int wr, int wc, int fr, int fq, const Pre& pre, LAS unsigned* pbuf) const {
        const int col0 = u.pn * 256 + wc * 32 + 8 * fq;
        float rs[2][4]; ss_finish(pre, rs);
#pragma unroll
        for (int ai = 0; ai < 2; ++ai)
#pragma unroll
            for (int mh = 0; mh < 2; ++mh) { u32x4 xv[2][2], pv[2][2];
#pragma unroll
                for (int ml = 0; ml < 2; ++ml)
#pragma unroll
                    for (int bj = 0; bj < 2; ++bj) { const size_t off = (size_t)EPI_ROW(u, ai, wr, 2 * mh + ml, fr) * D + col0 + bj * 128; xv[ml][bj] = *(const u32x4*)(X + off); pv[ml][bj] = *(const u32x4*)(PP + off); }
                __builtin_amdgcn_sched_barrier(0);
#pragma unroll
                for (int ml = 0; ml < 2; ++ml) { const int m = 2 * mh + ml; const int row = EPI_ROW(u, ai, wr, m, fr); const float s = -LOG2E * rs[ai][m]; float ss = 0.f;
#pragma unroll
                    for (int bj = 0; bj < 2; ++bj) { const size_t off = (size_t)row * D + col0 + bj * 128; f32x4 x0, x1, p0, p1;
                        unpack8(xv[ml][bj], x0, x1); unpack8(pv[ml][bj], p0, p1);
                        f32x4 v0, v1;
#pragma unroll
                        for (int i = 0; i < 4; ++i) {
                            float r0, r1; plesig2(acc[ai][bj][m][0][i], acc[ai][bj][m][1][i], s, p0[i], p1[i], x0[i], x1[i], r0, r1); v0[i] = r0; v1[i] = r1; }
                        ss = aadd(ss, sumsq8(v0, v1));
                        if (OUTF32) { st16f((float*)O + off, v0); st16f((float*)O + off + 4, v1); }
                        else st16((bf16_t*)O + off, pack8(v0, v1)); }
                    ss += __shfl_xor(ss, 16); ss += __shfl_xor(ss, 32); ss_stage(sst, ai, wr, m, fr, wc, fq, ss); }
                __builtin_amdgcn_sched_barrier(0); }
        ss_flush(sst, SSout, u, nullptr);
    }
};
struct EpiQkv {
    static constexpr bool PERM = true; static constexpr bool EARLYPF = false;
    typedef NoPre Pre;
    bf16_t* KV; bf16_t* Q; const float* SSin; const int* pos;
    __device__ __forceinline__ void prefetch(const Unit& u, int wr, int wc, int fr, int fq, Pre& p, LAS unsigned* pbuf) const {
#pragma unroll
        for (int ai = 0; ai < 2; ++ai)
#pragma unroll
            for (int m = 0; m < 4; ++m) { const int row = EPI_ROW(u, ai, wr, m, fr); dma4(SSin + SS1_IDX(row, fq), pbuf, ai * 4 + m); }
        LAS unsigned* p2 = pbuf2_of(pbuf);
#pragma unroll
        for (int h = 0; h < 2; ++h) dma4(pos + EPI_ROW(u, h, wr, fq, fr), p2, h);
    }
    __device__ __forceinline__ void operator()(Acc& acc, const Unit& u, int wr, int wc, int fr, int fq, const Pre& pre, LAS unsigned* pbuf) const {
        float rs[2][4]; int ps[2][4];
        const int lane = threadIdx.x & 63; LAS unsigned* p2 = pbuf2_of(pbuf);
#pragma unroll
        for (int ai = 0; ai < 2; ++ai)
#pragma unroll
            for (int m = 0; m < 4; ++m) { float s = __uint_as_float(pbuf[(ai * 4 + m) * 64 + lane]); s += __shfl_xor(s, 16); s += __shfl_xor(s, 32); rs[ai][m] = 1.0f / sqrtf(s * (1.0f / D) + EPS); ps[ai][m] = (int)p2[ai * 64 + m * 16 + fr]; }
        const bool isq = u.pn >= 1;
        const bool rot_lane = ((wc & 1) == 0) && (fq < 2);
        const float QS = 0.125f * LOG2E;
        const int na = EPI_NA(u);
#pragma unroll
        for (int ai = 0; ai < 2; ++ai) if (ai < na)
#pragma unroll
            for (int m = 0; m < 4; ++m) { const int row = EPI_ROW(u, ai, wr, m, fr); const float s = rs[ai][m];
                float cs[4], sn[4];
                if (rot_lane) { const float p = (float)ps[ai][m];
#pragma unroll
                    for (int i = 0; i < 4; ++i) { const int f = 4 * fq + i;
                        const float fr2pi = f == 0 ? 0.15915494309189535f : f == 1 ? 0.03086376340470123f : f == 2 ? 0.005985185712713705f : f == 3 ? 0.001160663641240061f
                                          : f == 4 ? 0.00022507907903927653f : f == 5 ? 4.364795279280289e-05f : f == 6 ? 8.464330808241401e-06f : 1.6414262627950345e-06f;
                        float rev = p * fr2pi; rev -= floorf(rev);
                        sn[i] = __builtin_amdgcn_sinf(rev); cs[i] = __builtin_amdgcn_cosf(rev); } }
#pragma unroll
                for (int bj = 0; bj < 2; ++bj) { f32x4 v0 = acc[ai][bj][m][0] * s, v1 = acc[ai][bj][m][1] * s;
                    const bool rot = rot_lane && (isq || bj == 0);
                    if (rot) {
#pragma unroll
                        for (int i = 0; i < 4; ++i) { const float t1 = v0[i], t2 = v1[i]; v0[i] = t1 * cs[i] - t2 * sn[i]; v1[i] = t2 * cs[i] + t1 * sn[i]; } }
                    if (isq) { v0 = v0 * QS; v1 = v1 * QS; st16(Q + (size_t)row * D + (u.pn - 1) * 256 + bj * 128 + wc * 32 + 8 * fq, pack8(v0, v1)); }
                    else st16(KV + (size_t)row * 256 + bj * 128 + wc * 32 + 8 * fq, pack8(v0, v1)); } }
    }
};
struct EpiMoeDown {
    static constexpr bool PERM = true; static constexpr bool EARLYPF = false; typedef NoPre Pre;
    const int* toklist; bf16_t* X; float* SS;
    __device__ __forceinline__ void prefetch(const Unit& u, int wr, int wc, int fr, int fq, Pre& p, LAS unsigned* pbuf) const {
        LAS unsigned* p2 = pbuf2_of(pbuf);
#pragma unroll
        for (int h = 0; h < 2; ++h) dma4(toklist + EPI_ROW(u, h, wr, fq, fr), p2, h);
    }
    __device__ __forceinline__ void operator()(Acc& acc, const Unit& u, int wr, int wc, int fr, int fq, const Pre&, LAS unsigned* pbuf) const {
        const int col0 = u.pn * 256 + wc * 32 + 8 * fq;
        int tk[2][4]; LAS unsigned* p2 = pbuf2_of(pbuf);
#pragma unroll
        for (int ai = 0; ai < 2; ++ai)
#pragma unroll
            for (int m = 0; m < 4; ++m) tk[ai][m] = (ai < EPI_NA(u)) ? (int)p2[ai * 64 + m * 16 + fr] : -1;
#pragma unroll
        for (int ai = 0; ai < 2; ++ai) if (ai < EPI_NA(u)) { u32x4 rv[4][2];
#pragma unroll
            for (int m = 0; m < 4; ++m) { const int tok = tk[ai][m] < 0 ? 0 : tk[ai][m];
#pragma unroll
                for (int bj = 0; bj < 2; ++bj) rv[m][bj] = *(const u32x4*)(X + (size_t)tok * D + col0 + bj * 128); }
            __builtin_amdgcn_sched_barrier(0);
#pragma unroll
            for (int m = 0; m < 4; ++m) { const int tok = tk[ai][m]; float ss = 0.f;
#pragma unroll
                for (int bj = 0; bj < 2; ++bj) { f32x4 r0, r1; unpack8(rv[m][bj], r0, r1);
                    const f32x4 v0 = aadd4(acc[ai][bj][m][0], r0), v1 = aadd4(acc[ai][bj][m][1], r1);
                    ss = aadd(ss, sumsq8(v0, v1));
                    if (tok >= 0) st16(X + (size_t)tok * D + col0 + bj * 128, pack8(v0, v1)); }
                if (SS) { ss += __shfl_xor(ss, 16); ss += __shfl_xor(ss, 32); if (fq == 0 && tok >= 0) SS[(size_t)tok * 16 + u.pn * 4 + wc] = ss; } }
            __builtin_amdgcn_sched_barrier(0); }
    }
};
#define LDS_WAIT() asm volatile("s_waitcnt lgkmcnt(0)" ::: "memory")

__device__ __forceinline__ int rope_perm(int d) { return d < 4 ? d : d < 8 ? d + 4 : d < 12 ? d - 4 : d; }
__device__ __forceinline__ int dst_row(int map, int p0, int p1, int n) {
    if (map == 0) return p0 + n;
    if (map == 1) { const int nn = n < p0 ? n : n - p0; return p1 + (nn >> 7) * 256 + (n < p0 ? 0 : 128) + (nn & 127); }
    if (map == 2) return (p0 + (n >> 7)) * 256 + p1 + (n & 127);
    return p0 + (n < p1 ? (n & ~63) + rope_perm(n & 63) : n);
}
struct TJob { const float* W; const float* gain; bf16_t* dst; int K, N, dpitch, map, p0, p1; };
__device__ __forceinline__ void transpose_item(const TJob& J, LAS float* scr, int item, int lane) {
    const int nblk = J.N / 32, kb = item / nblk, nb = item % nblk, k0 = 64 * kb, n0 = 32 * nb;
    f32x4 v[8];
#pragma unroll
    for (int i = 0; i < 8; ++i) v[i] = __builtin_nontemporal_load((const f32x4*)(J.W + (size_t)(k0 + (lane >> 3) + 8 * i) * J.N + n0 + 4 * (lane & 7)));
#pragma unroll
    for (int i = 0; i < 8; ++i) { const int kk = (lane >> 3) + 8 * i; f32x4 w = v[i]; if (J.gain) w = w * J.gain[k0 + kk];
        LAS float* d = scr + kk * 33 + 4 * (lane & 7); d[0] = w[0]; d[1] = w[1]; d[2] = w[2]; d[3] = w[3]; }
    LDS_WAIT(); asm volatile("" ::: "memory");
    const int c = lane & 7;
#pragma unroll
    for (int j = 0; j < 4; ++j) { const int n = (lane >> 3) + 8 * j; const LAS float* s = scr + (8 * c) * 33 + n;
        u32x4 o; o.x = pk2(s[0 * 33], s[1 * 33]); o.y = pk2(s[2 * 33], s[3 * 33]); o.z = pk2(s[4 * 33], s[5 * 33]); o.w = pk2(s[6 * 33], s[7 * 33]);
        st16(J.dst + (size_t)dst_row(J.map, J.p0, J.p1, n0 + n) * J.dpitch + k0 + 8 * c, o); }
    LDS_WAIT(); asm volatile("" ::: "memory");
}
template <int NR> __device__ __forceinline__ void cvt_rows(const float* xrow, bf16_t* orow, float* rstd_out, int lane) {
    f32x4 v[NR][4];
#pragma unroll
    for (int r = 0; r < NR; ++r)
#pragma unroll
        for (int j = 0; j < 4; ++j) v[r][j] = __builtin_nontemporal_load((const f32x4*)(xrow + (size_t)r * D) + lane + 64 * j);
#pragma unroll
    for (int r = 0; r < NR; ++r) { float s = 0.f; u32x2* o = (u32x2*)(orow + (size_t)r * D);
#pragma unroll
        for (int j = 0; j < 4; ++j) { const f32x4 a = v[r][j]; s += (a[0] * a[0] + a[1] * a[1]) + (a[2] * a[2] + a[3] * a[3]); u32x2 w; w.x = pk2(a[0], a[1]); w.y = pk2(a[2], a[3]); o[lane + 64 * j] = w; }
        if (rstd_out) { s = wave_sum(s); if (lane == 0) rstd_out[r] = 1.0f / sqrtf(s * (1.0f / D) + EPS); } }
}

__device__ __forceinline__ void conv_phase(const bf16_t* XB, const float* cw, const float* cb, bf16_t* XC, int gtid, int gthreads) {
    for (int it = gtid; it < (T / 16) * 128; it += gthreads) {
        const int cgp = it & 127, strip = it >> 7, c0 = cgp * 8, t0 = strip * 16;
        float w[4][8], b[8];
#pragma unroll
        for (int k = 0; k < 4; ++k) { const f32x4 a = *(const f32x4*)(cw + k * D + c0), bb = *(const f32x4*)(cw + k * D + c0 + 4);
#pragma unroll
            for (int i = 0; i < 4; ++i) { w[k][i] = a[i]; w[k][4 + i] = bb[i]; } }
        { const f32x4 a = *(const f32x4*)(cb + c0), bb = *(const f32x4*)(cb + c0 + 4);
#pragma unroll
          for (int i = 0; i < 4; ++i) { b[i] = a[i]; b[4 + i] = bb[i]; } }
        const bool seq0 = (t0 & (SEQ - 1)) == 0;
        u32x4 xw[19];
#pragma unroll
        for (int j = 0; j < 19; ++j) { if (j < 3 && seq0) xw[j] = (u32x4){0u, 0u, 0u, 0u}; else xw[j] = *(const u32x4*)(XB + (size_t)(t0 - 3 + j) * D + c0); }
#pragma unroll
        for (int j = 0; j < 16; ++j) {
            f32x4 o0, o1;
#pragma unroll
            for (int i = 0; i < 4; ++i) { o0[i] = b[i]; o1[i] = b[4 + i]; }
#pragma unroll
            for (int k = 0; k < 4; ++k) { f32x4 x0, x1; unpack8(xw[j + 3 - k], x0, x1);
#pragma unroll
                for (int i = 0; i < 4; ++i) { o0[i] = fmaf(w[k][i], x0[i], o0[i]); o1[i] = fmaf(w[k][4 + i], x1[i], o1[i]); } }
            st16(XC + (size_t)(t0 + j) * D + c0, pack8(o0, o1)); }
    }
}
__device__ __forceinline__ void carry_phase(const float* aggA, const float* aggH, float* carry, int gtid, int gthreads) {
    for (int it = gtid; it < BATCH * D; it += gthreads) {
        const int b = it >> 10, c = it & 1023; const size_t base = (size_t)b * 64 * D + c;
        float h = 0.f;
#pragma unroll 8
        for (int k = 0; k < 64; ++k) { carry[base + (size_t)k * D] = h; h = fmaf(aggA[base + (size_t)k * D], h, aggH[base + (size_t)k * D]); }
    }
}
__device__ __forceinline__ void ypass_phase(const bf16_t* HL, const bf16_t* PC, const bf16_t* GATE, const float* carry, bf16_t* Y, int gtid, int gthreads) {
    for (int it = gtid; it < (T / 16) * 128; it += gthreads) {
        const int cgp = it & 127, strip = it >> 7, c0 = cgp * 8, t0 = strip * 16, chunk = t0 >> 7;
        const f32x4 ca = *(const f32x4*)(carry + (size_t)chunk * D + c0), cb2 = *(const f32x4*)(carry + (size_t)chunk * D + c0 + 4);
#pragma unroll 8
        for (int j = 0; j < 16; ++j) { const size_t off = (size_t)(t0 + j) * D + c0;
            f32x4 h0, h1, p0, p1, g0, g1; unpack8(*(const u32x4*)(HL + off), h0, h1); unpack8(*(const u32x4*)(PC + off), p0, p1); unpack8(*(const u32x4*)(GATE + off), g0, g1);
            f32x4 o0, o1;
#pragma unroll
            for (int i = 0; i < 4; ++i) { o0[i] = fmaf(p0[i], ca[i], h0[i]) * g0[i]; o1[i] = fmaf(p1[i], cb2[i], h1[i]) * g1[i]; }
            st16(Y + off, pack8(o0, o1)); }
    }
}
constexpr int ATT_KP = 144, ATT_VP = 520, ATT_KS = 0, ATT_VS = 256 * ATT_KP, ATT_OS = 73728;
__device__ __forceinline__ void attn_phase(LAS unsigned char* lds, const bf16_t* Q, const bf16_t* KV, const float* sinks, bf16_t* O, int blk, int nblk) {
    const int tid = threadIdx.x, lane = tid & 63, wid = __builtin_amdgcn_readfirstlane(tid >> 6), r = lane & 31, hh = lane >> 5;
    for (int unit = blk; unit < BATCH * 64 * 2; unit += nblk) {
        const int kvh = unit & 1, nb = (unit >> 1) & 63, b = unit >> 7;
        const long row0 = (long)b * SEQ + nb * 128;
#pragma unroll
        for (int i = 0; i < 4; ++i) { const int id = tid + 512 * i, key = id >> 3, c = id & 7;
            u32x4 kw = (u32x4){0u, 0u, 0u, 0u}, vw = (u32x4){0u, 0u, 0u, 0u};
            if (nb > 0 || key >= 128) { const bf16_t* src = KV + (size_t)(row0 - 128 + key) * 256 + kvh * 64 + c * 8; kw = *(const u32x4*)src; vw = *(const u32x4*)(src + 128); }
            *(LAS u32x4*)(lds + ATT_KS + key * ATT_KP + c * 16) = kw;
            LAS bf16_t* vt = (LAS bf16_t*)(lds + ATT_VS + (c * 8) * ATT_VP + key * 2);
            vt[0 * (ATT_VP / 2)] = (bf16_t)(vw.x & 0xffffu); vt[1 * (ATT_VP / 2)] = (bf16_t)(vw.x >> 16); vt[2 * (ATT_VP / 2)] = (bf16_t)(vw.y & 0xffffu); vt[3 * (ATT_VP / 2)] = (bf16_t)(vw.y >> 16);
            vt[4 * (ATT_VP / 2)] = (bf16_t)(vw.z & 0xffffu); vt[5 * (ATT_VP / 2)] = (bf16_t)(vw.z >> 16); vt[6 * (ATT_VP / 2)] = (bf16_t)(vw.w & 0xffffu); vt[7 * (ATT_VP / 2)] = (bf16_t)(vw.w >> 16); }
        __syncthreads();
        const int h = kvh * 8 + wid;
        const float sink2 = sinks[h] * LOG2E;
        for (int qs = 0; qs < 4; ++qs) {
            const long qrow = row0 + 32 * qs + r;
            bf16x8 qf[4];
#pragma unroll
            for (int s = 0; s < 4; ++s) qf[s] = *(const bf16x8*)(Q + (size_t)qrow * D + h * 64 + 16 * s + 8 * hh);
            f32x16 st[5];
#pragma unroll
            for (int kt = 0; kt < 5; ++kt) { f32x16 a = {};
                const LAS unsigned char* kp = lds + ATT_KS + (32 * (qs + kt) + r) * ATT_KP + 16 * hh;
#pragma unroll
                for (int s = 0; s < 4; ++s) { const bf16x8 kf = *(const LAS bf16x8*)(kp + 32 * s); a = __builtin_amdgcn_mfma_f32_32x32x16_bf16(kf, qf[s], a, 0, 0, 0); }
                st[kt] = a; }
            float mx = sink2;
#pragma unroll
            for (int kt = 0; kt < 5; ++kt) { const bool dead = (nb == 0) && (qs + kt < 4);
#pragma unroll
                for (int rg = 0; rg < 16; ++rg) { const int kk = (rg & 3) + 8 * (rg >> 2) + 4 * hh;
                    bool ok = !dead; if (kt == 0) ok = ok && (kk > r); if (kt == 4) ok = ok && (kk <= r);
                    const float v = ok ? st[kt][rg] : -1e30f; st[kt][rg] = v; mx = fmaxf(mx, v); } }
            mx = fmaxf(mx, __shfl_xor(mx, 32));
            float sum = 0.f;
#pragma unroll
            for (int kt = 0; kt < 5; ++kt)
#pragma unroll
                for (int rg = 0; rg < 16; ++rg) { const float p = __builtin_amdgcn_exp2f(st[kt][rg] - mx); st[kt][rg] = p; sum += p; }
            sum += __shfl_xor(sum, 32);
            const float inv = 1.0f / (sum + __builtin_amdgcn_exp2f(sink2 - mx));
            f32x16 o0 = {}, o1 = {};
#pragma unroll
            for (int kt = 0; kt < 5; ++kt)
#pragma unroll
                for (int s2 = 0; s2 < 2; ++s2) {
                    u32x4 pw; pw.x = pk2(st[kt][8 * s2 + 0] * inv, st[kt][8 * s2 + 1] * inv); pw.y = pk2(st[kt][8 * s2 + 2] * inv, st[kt][8 * s2 + 3] * inv);
                    pw.z = pk2(st[kt][8 * s2 + 4] * inv, st[kt][8 * s2 + 5] * inv); pw.w = pk2(st[kt][8 * s2 + 6] * inv, st[kt][8 * s2 + 7] * inv);
                    const bf16x8 pa = __builtin_bit_cast(bf16x8, pw);
                    const int kbase = 32 * (qs + kt) + 16 * s2 + 4 * hh;
#pragma unroll
                    for (int dh = 0; dh < 2; ++dh) { const LAS unsigned char* vp = lds + ATT_VS + (32 * dh + r) * ATT_VP + kbase * 2;
                        const u32x2 lo = *(const LAS u32x2*)vp, hi = *(const LAS u32x2*)(vp + 16);
                        const u32x4 vv = (u32x4){lo.x, lo.y, hi.x, hi.y}; const bf16x8 vf = __builtin_bit_cast(bf16x8, vv);
                        if (dh == 0) o0 = __builtin_amdgcn_mfma_f32_32x32x16_bf16(pa, vf, o0, 0, 0, 0); else o1 = __builtin_amdgcn_mfma_f32_32x32x16_bf16(pa, vf, o1, 0, 0, 0); } }
            LAS unsigned char* ost = lds + ATT_OS + wid * (32 * 144);
#pragma unroll
            for (int rg = 0; rg < 16; ++rg) { const int q = (rg & 3) + 8 * (rg >> 2) + 4 * hh;
                *(LAS bf16_t*)(ost + q * 144 + 2 * r) = (bf16_t)(pk2(o0[rg], 0.f) & 0xffffu); *(LAS bf16_t*)(ost + q * 144 + 64 + 2 * r) = (bf16_t)(pk2(o1[rg], 0.f) & 0xffffu); }
            LDS_WAIT();
#pragma unroll
            for (int i = 0; i < 4; ++i) { const int q = 8 * i + (lane >> 3), ch = lane & 7;
                const u32x4 v = *(const LAS u32x4*)(ost + q * 144 + 16 * ch);
                *(u32x4*)(O + (size_t)(row0 + 32 * qs + q) * D + h * 64 + 8 * ch) = v; }
            LDS_WAIT();
        }
        __syncthreads();
    }
}
__device__ __forceinline__ void router_phase(LAS unsigned char* lds, const bf16_t* X, const float* SS, const bf16_t* WR16, const float* br,
                                             unsigned* TOKE, float* TOKW0, float* TOKW1, float* TOKR, int* CNT, int blk, int nblk) {
    const int tid = threadIdx.x, lane = tid & 63, wid = tid >> 6, r16 = lane & 15, kq = lane >> 4;
    LAS unsigned* se = (LAS unsigned*)lds;
    LAS float* slg = (LAS float*)(lds + 1024) + wid * 16 * 9;
    for (int tile = blk; tile < T / 128; tile += nblk) {
        const int tok0 = tile * 128 + wid * 16;
        const bf16_t* xa = X + (size_t)(tok0 + r16) * D + 8 * kq;
        const bf16_t* wb = WR16 + (size_t)r16 * D + 8 * kq;
        f32x4 acc = {0.f, 0.f, 0.f, 0.f};
#pragma unroll
        for (int sb = 0; sb < 4; ++sb) { bf16x8 af[8], bfr[8];
#pragma unroll
            for (int s = 0; s < 8; ++s) { af[s] = *(const bf16x8*)(xa + 32 * (8 * sb + s)); bfr[s] = *(const bf16x8*)(wb + 32 * (8 * sb + s)); }
#pragma unroll
            for (int s = 0; s < 8; ++s) acc = __builtin_amdgcn_mfma_f32_16x16x32_bf16(af[s], bfr[s], acc, 0, 0, 0); }
#pragma unroll
        for (int r = 0; r < 4; ++r) { const float lo = __shfl_down(acc[r], 8, 16); if (r16 < 8) slg[(4 * kq + r) * 9 + r16] = acc[r] + lo; }
        LDS_WAIT();
        if (lane < 16) { const int tok = tok0 + lane;
            const float ssum = (SS[SS1_IDX(tok, 0)] + SS[SS1_IDX(tok, 1)]) + (SS[SS1_IDX(tok, 2)] + SS[SS1_IDX(tok, 3)]);
            const float rstd = 1.0f / sqrtf(ssum * (1.0f / D) + EPS);
            float lg[8];
#pragma unroll
            for (int e = 0; e < 8; ++e) lg[e] = fmaf(slg[lane * 9 + e], rstd, br[e]);
            int i0 = 0; float v0 = lg[0];
#pragma unroll
            for (int e = 1; e < 8; ++e) if (lg[e] > v0) { v0 = lg[e]; i0 = e; }
            int i1 = -1; float v1 = -3.0e38f;
#pragma unroll
            for (int e = 0; e < 8; ++e) if (e != i0 && lg[e] > v1) { v1 = lg[e]; i1 = e; }
            const float e1 = __expf(v1 - v0), w0 = 1.0f / (1.0f + e1), w1 = e1 * w0;
            const unsigned pe = (unsigned)i0 | ((unsigned)i1 << 8); TOKE[tok] = pe; TOKW0[tok] = w0; TOKW1[tok] = w1; TOKR[tok] = rstd; se[wid * 16 + lane] = pe; }
        __syncthreads();
        if (tid < 16) { int c = 0; const unsigned e = (unsigned)(tid & 7), sh = (tid >> 3) * 8;
            for (int t = 0; t < 128; ++t) c += (((se[t] >> sh) & 0xffu) == e) ? 1 : 0;
            CNT[tile * 16 + tid] = c; }
        __syncthreads();
    }
}
__device__ __forceinline__ void gather_phase(LAS unsigned char* lds, const bf16_t* X, const unsigned* TOKE, const float* TOKW0, const float* TOKW1, const float* TOKR, const int* CNT,
                                             int* TOKLIST, unsigned* SLOTP, int blk, int nblk) {
    const int tid = threadIdx.x, lane = tid & 63, wid = tid >> 6;
    LAS int* s_tot = (LAS int*)lds;
    LAS int* s_bef = s_tot + 16;
    LAS int* s_start = s_bef + 16;
    LAS unsigned* s_e = (LAS unsigned*)(s_start + 32);
    LAS int* s_slot = (LAS int*)(s_e + 128);
    for (int tile = blk; tile < T / 128; tile += nblk) {
        if (tid < 32) s_tot[tid] = 0;
        __syncthreads();
        { int tot = 0, bef = 0;
#pragma unroll
          for (int k = 0; k < 8; ++k) { const int t = (tid >> 4) + 32 * k; const int c = CNT[t * 16 + (tid & 15)]; tot += c; bef += (t < tile) ? c : 0; }
          atomicAdd((int*)(s_tot + (tid & 15)), tot); atomicAdd((int*)(s_bef + (tid & 15)), bef); }
        if (tid >= 64 && tid < 192) s_e[tid - 64] = TOKE[tile * 128 + tid - 64];
        __syncthreads();
        if (tid == 0) { int s = 0; for (int g = 0; g < 16; ++g) { s_start[g] = s; s += (s_tot[g] + 255) & ~255; } s_start[16] = s; }
        __syncthreads();
        if (tile == 0) {
            for (int g = 0; g < 16; ++g) { const int lo = s_start[g] + s_tot[g], hi = s_start[g + 1]; for (int s = lo + tid; s < hi; s += 512) { TOKLIST[s] = -1; SLOTP[s] = 0u; } }
        }
        if (tid < 128) { const unsigned me = s_e[tid]; const unsigned e0 = me & 0xffu, e1 = (me >> 8) & 0xffu; int r0 = 0, r1 = 0;
            for (int t = 0; t < tid; ++t) { const unsigned o = s_e[t]; r0 += ((o & 0xffu) == e0) ? 1 : 0; r1 += (((o >> 8) & 0xffu) == e1) ? 1 : 0; }
            const int tok = tile * 128 + tid;
            const int sl0 = s_start[e0] + s_bef[e0] + r0, sl1 = s_start[8 + e1] + s_bef[8 + e1] + r1;
            const float rs = TOKR[tok];
            TOKLIST[sl0] = tok; SLOTP[sl0] = pack_h2(rs, rs * TOKW0[tok]); TOKLIST[sl1] = tok; SLOTP[sl1] = pack_h2(rs, rs * TOKW1[tok]); }
        __syncthreads();
    }
}
__device__ __forceinline__ void moe_table(LAS int* tstart, const int* CNT) {
    const int tid = threadIdx.x;
    LAS int* s_tot = tstart + 32;
    if (tid < 16) s_tot[tid] = 0;
    __syncthreads();
    { int tot = 0;
#pragma unroll
      for (int k = 0; k < 8; ++k) tot += CNT[((tid >> 4) + 32 * k) * 16 + (tid & 15)];
      atomicAdd((int*)(s_tot + (tid & 15)), tot); }
    __syncthreads();
    if (tid == 0) { int s = 0; for (int g = 0; g < 16; ++g) { tstart[g] = s; s += (s_tot[g] + 255) >> 8; } tstart[16] = s; }
    __syncthreads();
}
template <bool HALVES> struct OrdMoeT : pg8::OrderHalf {
    const LAS int* tstart; int g_lo; unsigned bexp, btile; const int* toklist;
    __device__ __forceinline__ void setup(const LAS int* ts, int glo, int ng, int nN_, int G_, int c_, unsigned bexp_, unsigned btile_) {
        tstart = ts; g_lo = glo; bexp = bexp_; btile = btile_; init(ts[glo + ng] - ts[glo], nN_, G_, c_); }
    __device__ __forceinline__ bool next(int i, Unit& u) const {
        int pm, pn, half = 0; if (HALVES ? !tileh(i, pm, pn, half) : !tile(i, pm, pn)) return false;
        const int mt = tstart[g_lo] + pm; int g = 0;
#pragma unroll
        for (int k = 1; k < 16; ++k) g += (tstart[k] <= mt) ? 1 : 0;
        u.pm = mt; u.pn = pn; u.rb = mt * 256 + (half == 2 ? 128 : 0); u.half = half; u.aoff = (unsigned)mt * (256u * 2048u) + (half == 2 ? 128u * 2048u : 0u); u.boff = (unsigned)(g & 7) * bexp + (unsigned)pn * btile; return true;
    }
};
__device__ __forceinline__ void final_phase(const bf16_t* X6, float* out, const float* SS, const float* gf, int gwave, int nwaves, int lane) {
    for (int row = 2 * gwave; row < T; row += 2 * nwaves) {
        u32x4 xv[2][2]; float sv[2];
#pragma unroll
        for (int r = 0; r < 2; ++r) { xv[r][0] = *(const u32x4*)(X6 + (size_t)(row + r) * D + 8 * lane); xv[r][1] = *(const u32x4*)(X6 + (size_t)(row + r) * D + 512 + 8 * lane); sv[r] = (lane < 4) ? SS[SS1_IDX(row + r, lane)] : 0.f; }
        const f32x4 g0 = *(const f32x4*)(gf + 8 * lane), g1 = *(const f32x4*)(gf + 8 * lane + 4), g2 = *(const f32x4*)(gf + 512 + 8 * lane), g3 = *(const f32x4*)(gf + 512 + 8 * lane + 4);
#pragma unroll
        for (int r = 0; r < 2; ++r) { const float rs = 1.0f / sqrtf(wave_sum(sv[r]) * (1.0f / D) + EPS);
            f32x4 a, b, c, d; unpack8(xv[r][0], a, b); unpack8(xv[r][1], c, d);
            float* o = out + (size_t)(row + r) * D;
            __builtin_nontemporal_store(a * rs * g0, (f32x4*)(o + 8 * lane)); __builtin_nontemporal_store(b * rs * g1, (f32x4*)(o + 8 * lane + 4)); __builtin_nontemporal_store(c * rs * g2, (f32x4*)(o + 512 + 8 * lane)); __builtin_nontemporal_store(d * rs * g3, (f32x4*)(o + 512 + 8 * lane + 4)); }
    }
}
constexpr size_t MiB = 1u << 20, KiB = 1u << 10;
constexpr size_t WS_BAR = 0, WS_C8G = 32 * KiB, WS_RSTD0 = 64 * KiB, WS_TOKE = 192 * KiB, WS_TOKW0 = 320 * KiB, WS_TOKW1 = 448 * KiB, WS_TOKR = 576 * KiB, WS_CNT = 704 * KiB, WS_TOKLIST = 720 * KiB, WS_SLOTW = 1008 * KiB, WS_SLOTR = 1296 * KiB, WS_WR16 = 1600 * KiB;
constexpr size_t WS_SSA = 2 * MiB, WS_SSB = 4 * MiB, WS_AGGA = 2 * MiB, WS_AGGH = 3 * MiB, WS_CARRY = 4 * MiB;
constexpr size_t WS_W = 6 * MiB;
constexpr size_t W_IN = WS_W, W_GATE = W_IN + 4 * MiB, W_OUT = W_GATE + 1 * MiB, W_FFI = W_OUT + 2 * MiB, W_FFO = W_FFI + 12 * MiB, W_PG0 = W_FFO + 6 * MiB, W_PG1 = W_PG0 + 2 * MiB,
                 W_PP0 = W_PG1 + 2 * MiB, W_PP1 = W_PP0 + MiB / 2, W_QKV = W_PP1 + MiB / 2, W_O = W_QKV + 5 * MiB / 2, W_EI = W_O + 2 * MiB, W_EO = W_EI + 32 * MiB, W_END = W_EO + 16 * MiB;
constexpr size_t SL_A = 92 * MiB, SL_B = 156 * MiB, SL_C = 220 * MiB, SL_D = 284 * MiB, SL_E = 348 * MiB, SL_F = 412 * MiB, SL_G = 476 * MiB, WS_NEED = 512 * MiB;
static_assert(W_END <= SL_A, "weights overlap slots");
static_assert(SL_C + (size_t)XG_ROWS * 2048 <= SL_E + 8 * MiB && SL_E + 8 * MiB + (size_t)XG_ROWS * 2048 <= WS_NEED, "moe buffers");
constexpr size_t WS_XG = SL_C, WS_HEXP = SL_E + 8 * MiB;
constexpr int LDS_BYTES = 163840;
constexpr int LDS_MISC = 131072;
constexpr int NPHASE = 20;

struct Args { const void* in[29]; float* out; unsigned char* ws; int ph_lo, ph_hi; };

struct OrdGates : pg8::OrderBase {
    __device__ __forceinline__ bool next(int i, Unit& u) const { if (!tile(i, u.pm, u.pn)) return false; u.aoff = (unsigned)u.pm * (256u * 2048u) + (unsigned)(u.pn >> 1) * 512u; u.boff = (unsigned)u.pn * (256u * 512u); u.rb = u.pm * 256; u.half = 0; return true; }
};

struct OrdGatesT { int c;
    __device__ __forceinline__ bool next(int i, Unit& u) const { if (i >= 4) return false; const int x = c & 7, yv = c >> 3, b = (yv >> 4) * 2 + (x >> 2), h = x & 3, half = (yv >> 3) & 1, j = yv & 7;
        u.pn = 2 * h + half; u.pm = b * 32 + 8 * i + j; u.rb = u.pm * 256; u.half = 0; u.aoff = (unsigned)u.pm * (256u * 2048u) + (unsigned)h * 512u; u.boff = (unsigned)u.pn * (256u * 512u); return true; }
};
__device__ __forceinline__ bool get_job(const Args& a, int j, TJob& J) {
    unsigned char* ws = a.ws;
    const float* g_mix = (const float*)a.in[3]; const float* g_ffn = (const float*)a.in[4]; const float* g_ple = (const float*)a.in[5];
    J.gain = nullptr; J.map = 0; J.p0 = 0; J.p1 = 0;
    if (j == 0) { J.W = (const float*)a.in[8]; J.K = 1024; J.N = 2048; J.gain = g_mix; J.dst = (bf16_t*)(ws + W_IN); J.dpitch = 1024; return true; }
    if (j == 1) { J.W = (const float*)a.in[16]; J.K = 1024; J.N = 1024; J.dst = (bf16_t*)(ws + W_OUT); J.dpitch = 1024; return true; }
    if (j == 2) { J.W = (const float*)a.in[22]; J.K = 1024; J.N = 6144; J.gain = g_ffn; J.dst = (bf16_t*)(ws + W_FFI); J.dpitch = 1024; J.map = 1; J.p0 = 3072; return true; }
    if (j == 3) { J.W = (const float*)a.in[23]; J.K = 3072; J.N = 1024; J.dst = (bf16_t*)(ws + W_FFO); J.dpitch = 3072; return true; }
    if (j == 4 || j == 5) { const int l = j - 4; J.W = (const float*)a.in[6] + (size_t)l * D * D; J.K = 1024; J.N = 1024; J.gain = g_ple + l * D; J.dst = (bf16_t*)(ws + (l ? W_PG1 : W_PG0)); J.dpitch = 1024; return true; }
    if (j == 6 || j == 7) { const int l = j - 6; J.W = (const float*)a.in[7] + (size_t)l * PLE * D; J.K = 256; J.N = 1024; J.dst = (bf16_t*)(ws + (l ? W_PP1 : W_PP0)); J.dpitch = 256; return true; }
    if (j == 8) { J.W = (const float*)a.in[18]; J.K = 1024; J.N = 256; J.gain = (const float*)a.in[17]; J.dst = (bf16_t*)(ws + W_QKV); J.dpitch = 1024; J.map = 3; J.p0 = 0; J.p1 = 128; return true; }
    if (j == 9) { J.W = (const float*)a.in[19]; J.K = 1024; J.N = 1024; J.gain = g_mix + D; J.dst = (bf16_t*)(ws + W_QKV); J.dpitch = 1024; J.map = 3; J.p0 = 256; J.p1 = 1024; return true; }
    if (j == 10) { J.W = (const float*)a.in[21]; J.K = 1024; J.N = 1024; J.dst = (bf16_t*)(ws + W_O); J.dpitch = 1024; return true; }
    if (j < 19) { const int q = j - 11, gx = q >> 2, h = q & 3;
        J.W = (const float*)a.in[gx ? 13 : 11] + (size_t)h * 65536; J.K = 256; J.N = 256; J.dst = (bf16_t*)(ws + W_GATE); J.dpitch = 256; J.map = 2; J.p0 = 2 * h; J.p1 = gx ? 128 : 0; return true; }
    if (j < 27) { const int e = j - 19; J.W = (const float*)a.in[26] + (size_t)e * D * 2048; J.K = 1024; J.N = 2048; J.gain = g_ffn + D; J.dst = (bf16_t*)(ws + W_EI); J.dpitch = 1024; J.map = 1; J.p0 = 1024; J.p1 = e * 2048; return true; }
    if (j < 35) { const int e = j - 27; J.W = (const float*)a.in[27] + (size_t)e * D * D; J.K = 1024; J.N = 1024; J.dst = (bf16_t*)(ws + W_EO); J.dpitch = 1024; J.p0 = e * 1024; return true; }
    return false;
}

__device__ __forceinline__ void convert_jobs(const Args& args, int jlo, int jhi, int w, int nw, LAS float* scr, int lane) {
    int off = 0; TJob J;
    for (int j = jlo; j < jhi && get_job(args, j, J); ++j) { const int n = (J.K / 64) * (J.N / 32); const int start = (w + nw - off % nw) % nw;
        for (int it = start; it < n; it += nw) transpose_item(J, scr, it, lane);
        off += n; }
}
constexpr int JOB_EI = 19, JOB_EO = 27, JOB_END = 35;

__global__ void __launch_bounds__(512, 2) fwd(Args args) {
    extern __shared__ __attribute__((aligned(16))) unsigned char lds_raw[];
    LAS unsigned char* lds = (LAS unsigned char*)lds_raw;
#define tid ((int)threadIdx.x)
#define lane (tid & 63)
#define wave (__builtin_amdgcn_readfirstlane(tid >> 6))
    const int G = gridDim.x, bx = blockIdx.x;
#define gtid (bx * 512 + tid)
#define gw (bx * 8 + wave)
    const int gthreads = G * 512, NGW = G * 8;
    unsigned char* ws = args.ws;
    const int lo = args.ph_lo, hi = args.ph_hi;
    cg::grid_group grid = cg::this_grid();
#ifndef PHMASK
#define PHMASK 0xFFFFFu
#endif
#define IN(k) ((((PHMASK) >> (k)) & 1u) && lo <= (k) && (k) < hi)
    XcdBarrier xbar; xbar.bar = (unsigned*)(ws + WS_BAR); xbar.x = 0; xbar.st = (volatile LAS unsigned*)(lds + LDS_MISC + 8192);
    if (hi - lo > 1) { if (tid < 4) ((LAS unsigned*)(lds + LDS_MISC + 8192))[tid] = 0u; __syncthreads(); xbar = xcd_barrier_post((unsigned*)(ws + WS_BAR), (volatile LAS unsigned*)(lds + LDS_MISC + 8192)); }
#ifndef REPMASK
#define REPMASK 0u
#endif
#define REPL(k) for (int rep_ = 0; rep_ <= (int)(((REPMASK) >> (k)) & 1u); ++rep_)
#define SEAM(k) do { if (IN(k) && IN((k) + 1)) { if (lo < 0) grid.sync(); else xcd_barrier(xbar); } } while (0)
    const float* x = (const float*)args.in[0]; const float* p = (const float*)args.in[1]; const int* pos = (const int*)args.in[2];
#define X0 ((bf16_t*)(ws + SL_A))
#define P16 ((bf16_t*)(ws + SL_G))
#define GATE ((bf16_t*)(ws + SL_D))
#define XB ((bf16_t*)(ws + SL_E))
#define XC ((bf16_t*)(ws + SL_F))
#define PP1 ((bf16_t*)(ws + SL_A))
#define HL ((bf16_t*)(ws + SL_B))
#define PC ((bf16_t*)(ws + SL_E))
#define Y ((bf16_t*)(ws + SL_E))
#define X1 ((bf16_t*)(ws + SL_C))
#define PP0 ((bf16_t*)(ws + SL_B))
#define HFF ((bf16_t*)(ws + SL_D))
#define X3 ((bf16_t*)(ws + SL_B))
#define KV ((bf16_t*)(ws + SL_G))
#define Q ((bf16_t*)(ws + SL_C))
#define ATT ((bf16_t*)(ws + SL_D))
#define HEXP ((bf16_t*)(ws + WS_HEXP))
#define SSA ((float*)(ws + WS_SSA))
#define SSB ((float*)(ws + WS_SSB))
#define RSTD0 ((float*)(ws + WS_RSTD0))
#define AGGA ((float*)(ws + WS_AGGA))
#define AGGH ((float*)(ws + WS_AGGH))
#define CARRY ((float*)(ws + WS_CARRY))
#define TOKE ((unsigned*)(ws + WS_TOKE))
#define TOKW0 ((float*)(ws + WS_TOKW0))
#define TOKW1 ((float*)(ws + WS_TOKW1))
#define TOKR ((float*)(ws + WS_TOKR))
#define C8G ((float*)(ws + WS_C8G))
#define CNT ((int*)(ws + WS_CNT))
#define TOKLIST ((int*)(ws + WS_TOKLIST))
#define SLOTP ((unsigned*)(ws + WS_SLOTW))
#define WR16 ((bf16_t*)(ws + WS_WR16))
    if (IN(0)) REPL(0) { if (rep_) xcd_barrier(xbar);
        LAS float* scr = (LAS float*)(lds + wave * 16384);
        convert_jobs(args, 0, JOB_EI, gw, NGW, scr, lane);
        if (G != 256) convert_jobs(args, JOB_EI, JOB_END, gw, NGW, scr, lane);
        if (gtid < D * 8) { const int kk = gtid >> 3, e = gtid & 7; const float w = ((const float*)args.in[24])[gtid] * ((const float*)args.in[4])[D + kk];
            const unsigned hi = pk2(w, 0.f) & 0xffffu; const float rem = w - __uint_as_float(hi << 16); WR16[(size_t)e * D + kk] = (bf16_t)hi; WR16[(size_t)(8 + e) * D + kk] = (bf16_t)(pk2(rem, 0.f) & 0xffffu); }
        if (gtid < D) { const float l = -((const float*)args.in[15])[gtid]; C8G[gtid] = -8.0f * LOG2E * (fmaxf(l, 0.f) + log1pf(expf(-fabsf(l)))); }
        for (int m = 4 * gw; m < T; m += 4 * NGW) cvt_rows<4>(x + (size_t)m * D, X0 + (size_t)m * D, RSTD0 + m, lane);
        for (int m = 4 * gw; m < 2 * T / 4; m += 4 * NGW) cvt_rows<4>(p + (size_t)m * D, P16 + (size_t)m * D, nullptr, lane);
    }
    SEAM(0);
    if (IN(1)) REPL(1) { if (rep_) xcd_barrier(xbar);
        Gemm g{(const char*)X0, (const char*)(ws + W_IN), 2048u, 2048u, 128u * 2048u, 1024, 0}; OrdStd S; S.init(T / 256, 8, G, bx); S.atile = 256u * 2048u; S.btile = 256u * 2048u;
        EpiInProj E{GATE, XB, RSTD0}; gemm_phase(lds, g, S, E);
    }
    SEAM(1);
    if (IN(2)) REPL(2) { if (rep_) xcd_barrier(xbar);
        conv_phase(XB, (const float*)args.in[9], (const float*)args.in[10], XC, gtid, gthreads);
    }
    SEAM(2);
    if (IN(3)) {
        Gemm g{(const char*)XC, (const char*)(ws + W_GATE), 2048u, 512u, 4u * 2048u, 256, 1}; OrdGatesT S; S.c = bx;
        EpiGatesF E{XC, (const float*)args.in[12], (const float*)args.in[14], C8G, GATE, Y, AGGA, AGGH, CARRY, &xbar}; gemm_phase(lds, g, S, E);
        convert_jobs(args, JOB_EI + 5, JOB_EO, gw, NGW, (LAS float*)(lds + wave * 16384), lane);
    }
    SEAM(3);
    if (IN(6)) REPL(6) { if (rep_) xcd_barrier(xbar);
#ifndef NO6A
        { Gemm g{(const char*)Y, (const char*)(ws + W_OUT), 2048u, 2048u, 128u * 2048u, 1024, 0}; OrdStd S; S.init(T / 256, 4, G, bx); S.atile = 256u * 2048u; S.btile = 256u * 2048u;
          EpiRes<false> E{X0, X1, SSA, (LAS float*)(lds + LDS_MISC + 1024)}; gemm_phase(lds, g, S, E); }
#endif
#ifndef NO6B
        { Gemm g{(const char*)P16, (const char*)(ws + W_PP0), 512u, 512u, 128u * 512u, 256, 0}; OrdStd S; S.init(T / 256, 4, G, bx); S.atile = 256u * 512u; S.btile = 256u * 512u;
          EpiBf16 E{PP0, D}; gemm_phase(lds, g, S, E); }
#endif
    }
    SEAM(6);
    if (IN(7)) REPL(7) { if (rep_) xcd_barrier(xbar);
        Gemm g{(const char*)X1, (const char*)(ws + W_FFI), 2048u, 2048u, 128u * 2048u, 1024, 0}; OrdStd S; S.init(T / 256, 24, G, bx); S.atile = 256u * 2048u; S.btile = 256u * 2048u;
        EpiSwiglu E{HFF, DFF, SSA, nullptr}; gemm_phase(lds, g, S, E);
#ifdef PROBE_NOEPI
        xcd_barrier(xbar); { EpiNull E0{(float*)(ws + WS_BAR + 16384)}; gemm_phase(lds, g, S, E0); }
#endif

    }
    SEAM(7);
    if (IN(8)) REPL(8) { if (rep_) xcd_barrier(xbar);
        Gemm g{(const char*)HFF, (const char*)(ws + W_FFO), 6144u, 6144u, 128u * 6144u, 3072, 0}; OrdStd S; S.init(T / 256, 4, G, bx); S.atile = 256u * 6144u; S.btile = 256u * 6144u;
        EpiRes<false> E{X1, X1, SSB, (LAS float*)(lds + LDS_MISC + 1024)}; gemm_phase(lds, g, S, E);
    }
    SEAM(8);
    if (IN(9)) REPL(9) { if (rep_) xcd_barrier(xbar);
        Gemm g{(const char*)X1, (const char*)(ws + W_PG0), 2048u, 2048u, 128u * 2048u, 1024, 0}; OrdStd S; S.init(T / 256, 4, G, bx); S.atile = 256u * 2048u; S.btile = 256u * 2048u;
        EpiPle<false> E{X1, PP0, X3, SSB, SSA, (LAS float*)(lds + LDS_MISC + 1024)}; gemm_phase(lds, g, S, E);
    }
    SEAM(9);
    if (IN(10)) REPL(10) { if (rep_) xcd_barrier(xbar);
        Gemm g{(const char*)X3, (const char*)(ws + W_QKV), 2048u, 2048u, 128u * 2048u, 1024, 0}; OrdStd S; S.init(T / 256, 5, G, bx); S.atile = 256u * 2048u; S.btile = 256u * 2048u;
        EpiQkv E{KV, Q, SSA, pos}; gemm_phase(lds, g, S, E);
        if (G == 256 && bx >= 128) convert_jobs(args, JOB_EI, JOB_EI + 5, (bx - 128) * 8 + wave, 128 * 8, (LAS float*)(lds + wave * 16384), lane);
    }
    SEAM(10);
    if (IN(11)) REPL(11) { if (rep_) xcd_barrier(xbar); attn_phase(lds, Q, KV, (const float*)args.in[20], ATT, bx, G); }
    SEAM(11);
    if (IN(12)) REPL(12) { if (rep_) xcd_barrier(xbar);
        Gemm g{(const char*)ATT, (const char*)(ws + W_O), 2048u, 2048u, 128u * 2048u, 1024, 0}; OrdStd S; S.init(T / 256, 4, G, bx); S.atile = 256u * 2048u; S.btile = 256u * 2048u;
        EpiRes<false> E{X3, X3, SSB, (LAS float*)(lds + LDS_MISC + 1024)}; gemm_phase(lds, g, S, E);
    }
    SEAM(12);
    if (IN(13)) REPL(13) { if (rep_) xcd_barrier(xbar); router_phase(lds, X3, SSB, WR16, (const float*)args.in[25], TOKE, TOKW0, TOKW1, TOKR, CNT, bx, G); }
    SEAM(13);
    if (IN(14)) REPL(14) { if (rep_) xcd_barrier(xbar); gather_phase(lds, X3, TOKE, TOKW0, TOKW1, TOKR, CNT, TOKLIST, SLOTP, bx, G); }
    SEAM(14);
    if (IN(15) || IN(16) || IN(17)) moe_table((LAS int*)(lds + LDS_MISC), CNT);
    if (IN(15)) REPL(15) { if (rep_) xcd_barrier(xbar);
        Gemm g{(const char*)X3, (const char*)(ws + W_EI), 2048u, 2048u, 128u * 2048u, 1024, 0}; OrdMoeT<true> S; S.setup((const LAS int*)(lds + LDS_MISC), 0, 16, 8, G, bx, 2048u * 2048u, 256u * 2048u); S.toklist = TOKLIST;
        EpiSwiglu E{HEXP, D, nullptr, SLOTP}; gemm_phase<EpiSwiglu, OrdMoeT<true>, true, true>(lds, g, S, E);
        if (G == 256) { int nidle = G - pg8::last_round_busy(S.nwg, G, true); if (nidle < 32) nidle = G; const int first = G - nidle;
            if (bx >= first) convert_jobs(args, JOB_EO, JOB_END, (bx - first) * 8 + wave, nidle * 8, (LAS float*)(lds + wave * 16384), lane); }
    }
    SEAM(15);
    if (IN(16)) REPL(16) { if (rep_) xcd_barrier(xbar);
        Gemm g{(const char*)HEXP, (const char*)(ws + W_EO), 2048u, 2048u, 128u * 2048u, 1024, 0}; OrdMoeT<true> S; S.setup((const LAS int*)(lds + LDS_MISC), 0, 8, 4, G, bx, 1024u * 2048u, 256u * 2048u); S.toklist = TOKLIST;
        EpiMoeDown E{TOKLIST, X3, nullptr}; gemm_phase<EpiMoeDown, OrdMoeT<true>, false, true>(lds, g, S, E);
        {
          int nidle = G - pg8::last_round_busy(S.nwg, G, true); if (nidle < 32) nidle = G; const int first = G - nidle;
          if (bx >= first) { Gemm g2{(const char*)(P16 + (size_t)T * PLE), (const char*)(ws + W_PP1), 512u, 512u, 128u * 512u, 256, 0}; OrdStd S2; S2.init(T / 512, 4, nidle, bx - first); S2.atile = 256u * 512u; S2.btile = 256u * 512u;
              EpiBf16 E2{PP1, D}; gemm_phase(lds, g2, S2, E2); } }
    }
    SEAM(16);
    if (IN(17)) REPL(17) { if (rep_) xcd_barrier(xbar);
        Gemm g{(const char*)HEXP, (const char*)(ws + W_EO), 2048u, 2048u, 128u * 2048u, 1024, 0}; OrdMoeT<true> S; S.setup((const LAS int*)(lds + LDS_MISC), 8, 8, 4, G, bx, 1024u * 2048u, 256u * 2048u); S.toklist = TOKLIST;
        EpiMoeDown E{TOKLIST, X3, SSA}; gemm_phase<EpiMoeDown, OrdMoeT<true>, false, true>(lds, g, S, E);
        {
          int nidle = G - pg8::last_round_busy(S.nwg, G, true); if (nidle < 32) nidle = G; const int first = G - nidle;
          if (bx >= first) { Gemm g2{(const char*)(P16 + (size_t)T * PLE + (size_t)(T / 2) * PLE), (const char*)(ws + W_PP1), 512u, 512u, 128u * 512u, 256, 0}; OrdStd S2; S2.init(T / 512, 4, nidle, bx - first); S2.atile = 256u * 512u; S2.btile = 256u * 512u;
              EpiBf16 E2{PP1 + (size_t)(T / 2) * D, D}; gemm_phase(lds, g2, S2, E2); } }
    }
    SEAM(17);
    if (IN(18)) REPL(18) { if (rep_) xcd_barrier(xbar);
        Gemm g{(const char*)X3, (const char*)(ws + W_PG1), 2048u, 2048u, 128u * 2048u, 1024, 0}; OrdStd S; S.init(T / 256, 4, G, bx); S.atile = 256u * 2048u; S.btile = 256u * 2048u;
        EpiPle<false, true> E{X3, PP1, PP1, SSA, SSB, (LAS float*)(lds + LDS_MISC + 1024)}; gemm_phase(lds, g, S, E);
    }
    SEAM(18);
    if (IN(19)) final_phase(PP1, args.out, SSB, (const float*)args.in[28], gw, NGW, lane);
#undef IN
#undef tid
#undef lane
#undef wave
#undef gtid
#undef gw
#undef SEAM
}
#ifndef SPLICE
#define SPLICE 0
#endif
#ifndef ONE_LAUNCH
#define ONE_LAUNCH 0
#endif
#if SPLICE
namespace nv {
__global__ void import_k(const bf16_t* __restrict__ src, float* __restrict__ dst, size_t n) {
    const size_t i = (size_t)blockIdx.x * blockDim.x + threadIdx.x; if (i < n) dst[i] = __uint_as_float((unsigned)src[i] << 16);
}
}
using namespace nv;
static inline void ngemm_l(hipStream_t s, const float* A, int lda, const float* B, int ldb, const float* R, int ldr, float* C, int ldc, int M, int N, int K) {
    hipLaunchKernelGGL(ngemm, dim3(N / NBN, M / NBM), dim3(256), 0, s, A, lda, B, ldb, R, ldr, C, ldc, K);
}
static inline int nb(size_t n) { return (int)((n + 255) / 256); }
#endif

extern "C" void kernel_launch(void* const* d_in, const int* in_sizes, int n_in, void* d_out, int out_size, void* d_ws, size_t ws_size, hipStream_t s) {
    static int inited = 0, grid_blocks = 0;
    if (!inited) {
        if (n_in != 29 || ws_size < WS_NEED) { fprintf(stderr, "kernel_launch: unexpected n_in %d / ws_size %zu (need %zu)\n", n_in, ws_size, (size_t)WS_NEED); inited = -1; return; }
        if (hipFuncSetAttribute((const void*)fwd, hipFuncAttributeMaxDynamicSharedMemorySize, LDS_BYTES) != hipSuccess) { fprintf(stderr, "kernel_launch: hipFuncSetAttribute failed\n"); inited = -1; return; }
        int dev = 0, cus = 0, per_cu = 0;
        if (hipGetDevice(&dev) != hipSuccess || hipDeviceGetAttribute(&cus, hipDeviceAttributeMultiprocessorCount, dev) != hipSuccess || cus < 1) { fprintf(stderr, "kernel_launch: device query failed\n"); inited = -1; return; }
        if (hipOccupancyMaxActiveBlocksPerMultiprocessor(&per_cu, (const void*)fwd, 512, LDS_BYTES) != hipSuccess || per_cu < 1) { fprintf(stderr, "kernel_launch: occupancy query reports %d workgroups per CU\n", per_cu); inited = -1; return; }
        grid_blocks = cus;
        if (cus != 256) { fprintf(stderr, "kernel_launch: built for a 256-CU device (got %d CUs)\n", cus); inited = -1; return; }
        inited = 1;
    }
    if (inited < 0) return;
    Args a{};
    for (int i = 0; i < 29; ++i) a.in[i] = d_in[i];
    a.out = (float*)d_out; a.ws = (unsigned char*)d_ws;
    const int grid = grid_blocks;
    (void)hipMemsetAsync((char*)d_ws + WS_BAR, 0, 32 * KiB, s);
#if ONE_LAUNCH
#ifdef PROBE_SPLIT
    { a.ph_lo = 0; a.ph_hi = PROBE_SPLIT + PROBE_REP; void* kargs[] = {&a};
      hipError_t e = hipLaunchCooperativeKernel((const void*)fwd, dim3(grid), dim3(512), kargs, LDS_BYTES, s);
      if (e != hipSuccess) fprintf(stderr, "cooperative launch failed: %s\n", hipGetErrorString(e)); }
    (void)hipMemsetAsync((char*)d_ws + WS_BAR, 0, 32 * KiB, s);
    { a.ph_lo = PROBE_SPLIT; a.ph_hi = NPHASE; void* kargs[] = {&a};
      hipError_t e = hipLaunchCooperativeKernel((const void*)fwd, dim3(grid), dim3(512), kargs, LDS_BYTES, s);
      if (e != hipSuccess) fprintf(stderr, "cooperative launch failed: %s\n", hipGetErrorString(e)); }
#else
    a.ph_lo = 0; a.ph_hi = NPHASE;
    void* kargs[] = {&a};
    hipError_t e = hipLaunchCooperativeKernel((const void*)fwd, dim3(grid), dim3(512), kargs, LDS_BYTES, s);
    if (e != hipSuccess) fprintf(stderr, "cooperative launch failed: %s\n", hipGetErrorString(e));
#endif
#else
    const int last = SPLICE ? SPLICE : NPHASE - 1;
    for (int ph = 0; ph <= last; ++ph) { a.ph_lo = ph; a.ph_hi = ph + 1; hipLaunchKernelGGL(fwd, dim3(grid), dim3(512), LDS_BYTES, s, a); }
#endif
#if SPLICE
    const float* x = (const float*)d_in[0]; const float* p = (const float*)d_in[1]; const int* pos = (const int*)d_in[2];
    const float* g_mix = (const float*)d_in[3]; const float* g_ffn = (const float*)d_in[4]; const float* g_ple = (const float*)d_in[5];
    const float* w_ple_gate = (const float*)d_in[6]; const float* w_ple_proj = (const float*)d_in[7];
    const float* w_lru_in = (const float*)d_in[8]; const float* conv_w = (const float*)d_in[9]; const float* conv_b = (const float*)d_in[10];
    const float* w_ga = (const float*)d_in[11]; const float* b_ga = (const float*)d_in[12]; const float* w_gx = (const float*)d_in[13]; const float* b_gx = (const float*)d_in[14];
    const float* lam = (const float*)d_in[15]; const float* w_lru_out = (const float*)d_in[16]; const float* g_kv = (const float*)d_in[17]; const float* w_kv = (const float*)d_in[18];
    const float* w_q = (const float*)d_in[19]; const float* sinks = (const float*)d_in[20]; const float* w_o = (const float*)d_in[21];
    const float* w_ff_in = (const float*)d_in[22]; const float* w_ff_out = (const float*)d_in[23]; const float* w_router = (const float*)d_in[24]; const float* b_router = (const float*)d_in[25];
    const float* w_exp_in = (const float*)d_in[26]; const float* w_exp_out = (const float*)d_in[27]; const float* g_final = (const float*)d_in[28];
    float* out = (float*)d_out; char* ws = (char*)d_ws;
    float* hf = (float*)(ws); float* xr = (float*)(ws + 96 * MiB); float* kvb = (float*)(ws + 128 * MiB); float* gts = (float*)(ws + 136 * MiB);
    float* big = (float*)(ws + 284 * MiB); float* xn = (float*)(ws + 476 * MiB);
    const int R = SEQ;
    for (int b = 0; b < BATCH; ++b) {
        const float* xb_in = x + (size_t)b * SEQ * D; const int* posb = pos + (size_t)b * SEQ; const size_t boff = (size_t)b * SEQ * D;
        float* h = big; float* xc = big + (size_t)R * 2048; float* rr = xc + (size_t)R * 1024; float* ig = rr + (size_t)R * 1024; float* y = ig + (size_t)R * 1024;
        if (SPLICE == 5) {
            hipLaunchKernelGGL(import_k, dim3(nb((size_t)R * D)), dim3(256), 0, s, (const bf16_t*)(ws + SL_B) + boff, xn, (size_t)R * D);
            ngemm_l(s, xn, D, w_lru_out, D, xb_in, D, xr, D, R, D, D);
        }
        if (SPLICE == 6 || SPLICE == 8) hipLaunchKernelGGL(import_k, dim3(nb((size_t)R * D)), dim3(256), 0, s, (const bf16_t*)(ws + SL_C) + boff, xr, (size_t)R * D);
        if (SPLICE == 9 || SPLICE == 12 || SPLICE == 17) hipLaunchKernelGGL(import_k, dim3(nb((size_t)R * D)), dim3(256), 0, s, (const bf16_t*)(ws + SL_B) + boff, xr, (size_t)R * D);
        if (SPLICE <= 6) {
            hipLaunchKernelGGL(rmsnorm_k, dim3(R / 4), dim3(256), 0, s, xr, g_ffn, xn, R);
            ngemm_l(s, xn, D, w_ff_in, 2 * DFF, nullptr, 0, big, 2 * DFF, R, 2 * DFF, D);
            hipLaunchKernelGGL(swiglu_k, dim3(nb((size_t)R * DFF)), dim3(256), 0, s, big, hf, R, DFF, (const float*)nullptr, 0);
            ngemm_l(s, hf, DFF, w_ff_out, D, xr, D, xr, D, R, D, DFF);
        }
        float* pg = big; float* pp = big + (size_t)R * 1024;
        if (SPLICE <= 8) {
            hipLaunchKernelGGL(rmsnorm_k, dim3(R / 4), dim3(256), 0, s, xr, g_ple, xn, R);
            ngemm_l(s, xn, D, w_ple_gate, D, nullptr, 0, pg, D, R, D, D);
            ngemm_l(s, p + (size_t)b * SEQ * PLE, PLE, w_ple_proj, D, nullptr, 0, pp, D, R, D, PLE);
            hipLaunchKernelGGL(ple_k, dim3(nb((size_t)R * 1024)), dim3(256), 0, s, xr, pg, pp, R);
        }
        float* q = big; float* at = big + (size_t)R * 1024;
        if (SPLICE <= 9) {
            hipLaunchKernelGGL(rmsnorm_k, dim3(R / 4), dim3(256), 0, s, xr, g_kv, xn, R);
            ngemm_l(s, xn, D, w_kv, 256, nullptr, 0, kvb, 256, R, 256, D);
            hipLaunchKernelGGL(rope_k, dim3(nb((size_t)R * 2 * 8)), dim3(256), 0, s, kvb, 256, 2, posb, R);
            hipLaunchKernelGGL(rmsnorm_k, dim3(R / 4), dim3(256), 0, s, xr, g_mix + D, xn, R);
            ngemm_l(s, xn, D, w_q, D, nullptr, 0, q, D, R, D, D);
            hipLaunchKernelGGL(rope_k, dim3(nb((size_t)R * 16 * 8)), dim3(256), 0, s, q, 1024, 16, posb, R);
            hipLaunchKernelGGL(attn_k, dim3(R * 16 / 4), dim3(256), 0, s, q, kvb, sinks, at, R);
            ngemm_l(s, at, D, w_o, D, xr, D, xr, D, R, D, D);
        }
        if (SPLICE <= 12) {
            hipLaunchKernelGGL(rmsnorm_k, dim3(R / 4), dim3(256), 0, s, xr, g_ffn + D, xn, R);
            hipLaunchKernelGGL(router_k, dim3(R / 4), dim3(256), 0, s, xn, w_router, b_router, gts, R);
            for (int e = 0; e < NE; ++e) {
                ngemm_l(s, xn, D, w_exp_in + (size_t)e * D * 2048, 2048, nullptr, 0, big, 2048, R, 2048, D);
                hipLaunchKernelGGL(swiglu_k, dim3(nb((size_t)R * 1024)), dim3(256), 0, s, big, hf, R, 1024, gts, e);
                ngemm_l(s, hf, D, w_exp_out + (size_t)e * D * D, D, xr, D, xr, D, R, D, D);
            }
        }
        if (SPLICE <= 17) {
            hipLaunchKernelGGL(rmsnorm_k, dim3(R / 4), dim3(256), 0, s, xr, g_ple + D, xn, R);
            ngemm_l(s, xn, D, w_ple_gate + (size_t)D * D, D, nullptr, 0, pg, D, R, D, D);
            ngemm_l(s, p + (size_t)(BATCH + b) * SEQ * PLE, PLE, w_ple_proj + (size_t)PLE * D, D, nullptr, 0, pp, D, R, D, PLE);
            hipLaunchKernelGGL(ple_k, dim3(nb((size_t)R * 1024)), dim3(256), 0, s, xr, pg, pp, R);
            hipLaunchKernelGGL(rmsnorm_k, dim3(R / 4), dim3(256), 0, s, xr, g_final, out + boff, R);
        }
        if (SPLICE == 18) hipLaunchKernelGGL(rmsnorm_k, dim3(R / 4), dim3(256), 0, s, out + boff, g_final, out + boff, R);
        (void)w_lru_in; (void)conv_w; (void)conv_b; (void)w_ga; (void)b_ga; (void)w_gx; (void)b_gx; (void)lam; (void)g_mix; (void)h; (void)y;
    }
#endif
}
```

```cpp
#include <hip/hip_runtime.h>
#include <hip/hip_cooperative_groups.h>
#include <cstdio>
#include <cstdint>
namespace cg = cooperative_groups;

#define LAS __attribute__((address_space(3)))
typedef unsigned short bf16_t;
typedef short bf16x8 __attribute__((ext_vector_type(8)));
typedef short s16x4 __attribute__((ext_vector_type(4)));
typedef float f32x4 __attribute__((ext_vector_type(4)));
typedef float f32x2 __attribute__((ext_vector_type(2)));
typedef float f32x16 __attribute__((ext_vector_type(16)));
typedef unsigned u32x4 __attribute__((ext_vector_type(4)));
typedef unsigned u32x2 __attribute__((ext_vector_type(2)));
typedef __bf16 bf16x2_t __attribute__((ext_vector_type(2)));

constexpr int D = 1024, BATCH = 4, SEQ = 8192, T = BATCH * SEQ, DFF = 3072, NE = 8, PLE = 256;
constexpr float EPS = 1e-6f;
constexpr float LOG2E = 1.4426950408889634f;
constexpr int XG_ROWS = 2 * T + 16 * 256;

__device__ __forceinline__ unsigned pk2(float lo, float hi) { f32x2 v = {lo, hi}; bf16x2_t b = __builtin_convertvector(v, bf16x2_t); return __builtin_bit_cast(unsigned, b); }
__device__ __forceinline__ float bflo(unsigned u) { return __uint_as_float(u << 16); }
__device__ __forceinline__ float bfhi(unsigned u) { return __uint_as_float(u & 0xffff0000u); }
__device__ __forceinline__ float amul(float a, float b) { float r; asm("v_mul_f32_e32 %0, %1, %2" : "=v"(r) : "v"(a), "v"(b)); return r; }
__device__ __forceinline__ float aadd(float a, float b) { float r; asm("v_add_f32_e32 %0, %1, %2" : "=v"(r) : "v"(a), "v"(b)); return r; }
__device__ __forceinline__ float asub(float a, float b) { float r; asm("v_sub_f32_e32 %0, %1, %2" : "=v"(r) : "v"(a), "v"(b)); return r; }
__device__ __forceinline__ float afma(float a, float b, float c) { float r; asm("v_fma_f32 %0, %1, %2, %3" : "=v"(r) : "v"(a), "v"(b), "v"(c)); return r; }
__device__ __forceinline__ void swiglu2(float g0, float u0, float g1, float u1, float n, float c, float& o0, float& o1) {
    float t0, t1, p0, p1;
    asm("v_mul_f32_e32 %0, %4, %8\n\tv_mul_f32_e32 %1, %6, %8\n\tv_exp_f32_e32 %0, %0\n\tv_exp_f32_e32 %1, %1\n\tv_mul_f32_e32 %2, %4, %5\n\t"
        "v_fma_f32 %0, %0, %9, %9\n\tv_fma_f32 %1, %1, %9, %9\n\tv_rcp_f32_e32 %0, %0\n\tv_rcp_f32_e32 %1, %1\n\tv_mul_f32_e32 %3, %6, %7\n\t"
        "v_mul_f32_e32 %0, %2, %0\n\tv_mul_f32_e32 %1, %3, %1"
        : "=&v"(t0), "=&v"(t1), "=&v"(p0), "=&v"(p1) : "v"(g0), "v"(u0), "v"(g1), "v"(u1), "v"(n), "v"(c));
    o0 = t0; o1 = t1;
}
__device__ __forceinline__ void plesig2(float a0, float a1, float n, float p0, float p1, float x0, float x1, float& o0, float& o1) {
    float t0, t1;
    asm("v_mul_f32_e32 %0, %2, %4\n\tv_mul_f32_e32 %1, %3, %4\n\tv_exp_f32_e32 %0, %0\n\tv_exp_f32_e32 %1, %1\n\ts_nop 0\n\tv_add_f32_e32 %0, 1.0, %0\n\tv_add_f32_e32 %1, 1.0, %1\n\t"
        "v_rcp_f32_e32 %0, %0\n\tv_rcp_f32_e32 %1, %1\n\ts_nop 0\n\tv_fma_f32 %0, %0, %5, %7\n\tv_fma_f32 %1, %1, %6, %8"
        : "=&v"(t0), "=&v"(t1) : "v"(a0), "v"(a1), "v"(n), "v"(p0), "v"(p1), "v"(x0), "v"(x1));
    o0 = t0; o1 = t1;
}
__device__ __forceinline__ void gelu2(float v0, float v1, float k1, float k2, float& o0, float& o1) {
    float t0, t1;
    asm("v_mul_f32_e32 %0, %2, %2\n\tv_mul_f32_e32 %1, %3, %3\n\tv_fma_f32 %0, %0, %5, %4\n\tv_fma_f32 %1, %1, %5, %4\n\tv_mul_f32_e32 %0, %0, %2\n\tv_mul_f32_e32 %1, %1, %3\n\t"
        "v_exp_f32_e32 %0, %0\n\tv_exp_f32_e32 %1, %1\n\ts_nop 0\n\tv_add_f32_e32 %0, 1.0, %0\n\tv_add_f32_e32 %1, 1.0, %1\n\tv_rcp_f32_e32 %0, %0\n\tv_rcp_f32_e32 %1, %1\n\ts_nop 0\n\t"
        "v_mul_f32_e32 %0, %2, %0\n\tv_mul_f32_e32 %1, %3, %1"
        : "=&v"(t0), "=&v"(t1) : "v"(v0), "v"(v1), "v"(k1), "v"(k2));
    o0 = t0; o1 = t1;
}
__device__ __forceinline__ float fsig(float x) { return __builtin_amdgcn_rcpf(1.0f + __builtin_amdgcn_exp2f(-LOG2E * x)); }
__device__ __forceinline__ float wave_sum(float v) {
#pragma unroll
    for (int o = 1; o < 64; o <<= 1) v += __shfl_xor(v, o);
    return v;
}
__device__ __forceinline__ u32x4 pack8(f32x4 a, f32x4 b) { u32x4 w; w.x = pk2(a[0], a[1]); w.y = pk2(a[2], a[3]); w.z = pk2(b[0], b[1]); w.w = pk2(b[2], b[3]); return w; }
__device__ __forceinline__ void unpack8(u32x4 w, f32x4& a, f32x4& b) { a[0] = bflo(w.x); a[1] = bfhi(w.x); a[2] = bflo(w.y); a[3] = bfhi(w.y); b[0] = bflo(w.z); b[1] = bfhi(w.z); b[2] = bflo(w.w); b[3] = bfhi(w.w); }

#ifndef WT_STORES
#define WT_STORES 0
#endif
__device__ __forceinline__ void st16(void* p, u32x4 v) {
#if WT_STORES
    asm volatile("global_store_dwordx4 %0, %1, off sc1\n\ts_nop 1" :: "v"(p), "v"(v) : "memory");
#else
    *(u32x4*)p = v;
#endif
}
__device__ __forceinline__ void st16f(void* p, f32x4 v) { st16(p, __builtin_bit_cast(u32x4, v)); }

typedef _Float16 f16x2_t __attribute__((ext_vector_type(2)));
__device__ __forceinline__ unsigned pack_h2(float a, float b) { f16x2_t v = {(_Float16)a, (_Float16)b}; return __builtin_bit_cast(unsigned, v); }
__device__ __forceinline__ void unpack_h2(unsigned w, float& a, float& b) { const f16x2_t v = __builtin_bit_cast(f16x2_t, w); a = (float)v.x; b = (float)v.y; }
#define SPLICE 0
#define ONE_LAUNCH 1
typedef __attribute__((address_space(1))) unsigned gu32;
#define RLX_AGENT __ATOMIC_RELAXED, __HIP_MEMORY_SCOPE_AGENT
#define XB_TMO      128
#define XB_XCNT(j)  (256  + 64 * (j))
#define XB_XSUB(j)  (1280 + 64 * (j))
#define XB_XGEN(j)  (2304 + 64 * (j))
#define XB_TOP      3328
#define XB_TOPGEN   3392
#define XCD_BAR_WORDS 3456
#define XB_SPIN_CAP (1u << 18)

__device__ __forceinline__ unsigned xb_ld(unsigned* p)              { return __hip_atomic_load(p, __ATOMIC_RELAXED, __HIP_MEMORY_SCOPE_AGENT); }
__device__ __forceinline__ unsigned xb_add(unsigned* p, unsigned v) { return __hip_atomic_fetch_add(p, v, __ATOMIC_RELAXED, __HIP_MEMORY_SCOPE_AGENT); }
__device__ __forceinline__ unsigned xb_xcc_id() { return (unsigned)__builtin_amdgcn_s_getreg((3 << 11) | 20) & 0xFu; }
#define XB_SPIN(cond, bar) do { unsigned _sp = 0; while (cond) { __builtin_amdgcn_s_sleep(1); \
    if ((++_sp & 255u) == 0u) { if (xb_ld(&(bar)[XB_TMO])) break; if (_sp > XB_SPIN_CAP) { atomicAdd(&(bar)[XB_TMO], 1u); break; } } } } while (0)

struct XcdBarrier {
    unsigned* bar; unsigned x;
    volatile LAS unsigned* st;
};

__device__ __forceinline__ XcdBarrier xcd_barrier_post(unsigned* bar, volatile LAS unsigned* st) {
    XcdBarrier b; b.bar = bar; b.x = xb_xcc_id(); b.st = st;
    if (threadIdx.x == 0) (void)xb_add(&bar[XB_XCNT(b.x)], 1u);
    return b;
}
__device__ __forceinline__ void xcd_barrier_complete(unsigned* bar, unsigned x, unsigned& nloc, unsigned& nx) {
    const unsigned G = gridDim.x * gridDim.y * gridDim.z;
    unsigned sum, cnt, mine, sp = 0u;
    for (;;) {
        sum = 0u; cnt = 0u; mine = 0u;
#pragma unroll
        for (unsigned j = 0; j < 16; ++j) { const unsigned c = xb_ld(&bar[XB_XCNT(j)]); sum += c; cnt += (c > 0u) ? 1u : 0u; mine = (j == x) ? c : mine; }
        if (sum == G) break;
        __builtin_amdgcn_s_sleep(1);
        if ((++sp & 255u) == 0u) { if (xb_ld(&bar[XB_TMO])) break; if (sp > XB_SPIN_CAP) { atomicAdd(&bar[XB_TMO], 1u); break; } }
    }
    nloc = mine > 0u ? mine : 1u; nx = cnt > 0u ? cnt : 1u;
}

__device__ __forceinline__ void xcd_barrier(const XcdBarrier& b) {
    asm volatile("s_waitcnt vmcnt(0)" ::: "memory");
    __syncthreads();
    if (threadIdx.x == 0) {
        unsigned* bar = b.bar;
        __builtin_amdgcn_s_waitcnt(0);
        unsigned nloc = b.st[0], nx = b.st[1];
        if (nloc == 0u) { xcd_barrier_complete(bar, b.x, nloc, nx); b.st[0] = nloc; b.st[1] = nx; }
        const unsigned old = xb_add(&bar[XB_XSUB(b.x)], 1u);
        const unsigned gen = old / nloc;
        if (old + 1u == (gen + 1u) * nloc) {
            __builtin_amdgcn_fence(__ATOMIC_RELEASE, "agent");
            asm volatile("s_waitcnt vmcnt(0)" ::: "memory");
            const unsigned og = xb_add(&bar[XB_TOP], 1u);
            const unsigned tg = og / nx;
            __builtin_amdgcn_fence(__ATOMIC_ACQUIRE, "agent");
            if (og + 1u == (tg + 1u) * nx) xb_add(&bar[XB_TOPGEN], 1u);
            else XB_SPIN(xb_ld(&bar[XB_TOPGEN]) == tg, bar);
            xb_add(&bar[XB_XGEN(b.x)], 1u);
            asm volatile("s_waitcnt vmcnt(0)" ::: "memory");
        } else {
            __builtin_amdgcn_fence(__ATOMIC_ACQUIRE, "agent");
            XB_SPIN(xb_ld(&bar[XB_XGEN(b.x)]) == gen, bar);
            asm volatile("s_waitcnt vmcnt(0)" ::: "memory");
        }
    }
    __syncthreads();
}

namespace pg8 {
constexpr int BM = 256, BK = 64, HALF = 128, HTB = HALF * BK * 2, STAGE_BYTES = 8 * HTB, NXCD = 8, WGM = 8;
__host__ __device__ __forceinline__ int lds_byte(int r, int c) { const int st = (r >> 4) * 2 + (c >> 5), rr = r & 15, cc = c & 31, ob = rr * 64 + cc * 2; return st * 1024 + (ob ^ (((ob >> 9) & 1) << 5)); }
__host__ __device__ __forceinline__ void stage_rc(int b, int& R, int& C) { const int st = b / 1024, sb = b % 1024, swz = sb ^ (((sb >> 9) & 1) << 5); R = (st >> 1) * 16 + swz / 64; C = (st & 1) * 32 + (swz % 64) / 2; }
__host__ __device__ __forceinline__ int perm32(int rho) { const int n = rho >> 4, i = rho & 15; return 8 * (i >> 2) + 4 * n + (i & 3); }

struct Unit { unsigned aoff, boff; int pm, pn, rb, half; };
struct Gemm { const char* A; const char* Bt; unsigned lda2, ldb2, hstepA; int K; int aperm; };

struct OrderBase {
    int nM, nN, nwg, G, c;
    __device__ __forceinline__ void init(int nM_, int nN_, int G_, int c_) { nM = nM_; nN = nN_; nwg = nM * nN; G = G_; c = c_; }
    __device__ __forceinline__ bool tile(int i, int& pm, int& pn) const {
        const long L = (long)i * G + c; if (L >= nwg) return false;
        int wgid = (int)L; { const int q = nwg / NXCD, r = nwg % NXCD, xcd = wgid % NXCD, off = wgid / NXCD; wgid = (xcd < r ? xcd * (q + 1) : r * (q + 1) + (xcd - r) * q) + off; }
        const int nig = WGM * nN, gid = wgid / nig, fm = gid * WGM, gsz = (nM - fm) < WGM ? (nM - fm) : WGM;
        pm = fm + ((wgid % nig) % gsz); pn = (wgid % nig) / gsz; return true;
    }
};
struct OrderHalf : OrderBase {
    __device__ __forceinline__ bool tileh(int i, int& pm, int& pn, int& half) const {
        const int nfull = (nwg / G) * G, rem = nwg - nfull; const bool split = rem > 0 && 2 * rem <= G;
        const long L = (long)i * G + c; int t;
        if (L < nfull || !split) { if (L >= nwg) return false; t = (int)L; half = 0; }
        else { const int x = (int)(L - nfull); if (x >= 2 * rem) return false; t = nfull + (x >> 1); half = 1 + (x & 1); }
        int wgid = t; { const int q = nwg / NXCD, r = nwg % NXCD, xcd = wgid % NXCD, off = wgid / NXCD; wgid = (xcd < r ? xcd * (q + 1) : r * (q + 1) + (xcd - r) * q) + off; }
        const int nig = WGM * nN, gid = wgid / nig, fm = gid * WGM, gsz = (nM - fm) < WGM ? (nM - fm) : WGM;
        pm = fm + ((wgid % nig) % gsz); pn = (wgid % nig) / gsz; return true;
    }
};
__device__ __forceinline__ int last_round_busy(int nwg, int G, bool halves) { const int rem = nwg % G; if (rem == 0) return 0; return (halves && 2 * rem <= G) ? 2 * rem : rem; }
struct OrdStd : OrderBase {
    unsigned atile, btile;
    __device__ __forceinline__ bool next(int i, Unit& u) const { if (!tile(i, u.pm, u.pn)) return false; u.aoff = (unsigned)u.pm * atile; u.boff = (unsigned)u.pn * btile; u.rb = u.pm * 256; u.half = 0; return true; }
};
struct OrdStdH : OrderHalf {
    unsigned atile, btile;
    __device__ __forceinline__ bool next(int i, Unit& u) const { if (!tileh(i, u.pm, u.pn, u.half)) return false; u.rb = u.pm * 256 + (u.half == 2 ? 128 : 0); u.aoff = (unsigned)u.pm * atile + (u.half == 2 ? atile / 2 : 0u); u.boff = (unsigned)u.pn * btile; return true; }
};

template <class Epi, class Sched, bool GATHER = false, bool HALFOK = false>
__device__ __forceinline__ void gemm_phase(LAS unsigned char* lds, const Gemm g, const Sched& S, const Epi& E) {
    const int tid = threadIdx.x, wid = __builtin_amdgcn_readfirstlane(tid >> 6), lane = tid & 63, wr = wid >> 2, wc = wid & 3, fr = lane & 15, fq = lane >> 4;
    int nt = g.K / BK; asm volatile("" : "+s"(nt));
    unsigned voffA[2], voffB[2]; int Rrow[2];
#pragma unroll
    for (int i = 0; i < 2; ++i) { int R, C; stage_rc(tid * 16 + i * 8192, R, C); const int Rb = Epi::PERM ? ((R & ~31) + perm32(R & 31)) : R;
        const int Ra = g.aperm ? (8 * ((R & 15) + 16 * (R >> 6)) + ((R >> 4) & 3)) : R;
        voffA[i] = GATHER ? (unsigned)C * 2u : (unsigned)Ra * g.lda2 + (unsigned)C * 2u; voffB[i] = (unsigned)Rb * g.ldb2 + (unsigned)C * 2u; Rrow[i] = R; }
    const size_t kstep = (size_t)(BK * 2);
    const size_t hstepA = g.hstepA, hstepB = (size_t)HALF * g.ldb2;
    const unsigned ldsw = (unsigned)wid * 1024u;
    const int aoff = lds_byte(wr * 64 + fr, fq * 8), boff = lds_byte(wc * 32 + fr, fq * 8);
#define PG8_SA(b, h) (((b) * 2 + (h)) * HTB)
#define PG8_SB(b, h) ((4 + (b) * 2 + (h)) * HTB)
#define PG8_STAGE(bufoff, gbase, voff) do { _Pragma("unroll") for (int _i = 0; _i < 2; ++_i) \
        __builtin_amdgcn_global_load_lds((const unsigned*)((const char*)(gbase) + (voff)[_i]), (LAS unsigned*)(lds + (bufoff) + ldsw + _i * 8192), 16, 0, 0); } while (0)
#define PG8_STAGE_A(bufoff, h, kptr, koff, usenext) do { if constexpr (GATHER) { unsigned vo_[2]; _Pragma("unroll") for (int _i = 0; _i < 2; ++_i) vo_[_i] = (usenext) ? gaN[h][_i] : gaC[h][_i]; \
        PG8_STAGE(bufoff, g.A + (koff), vo_); } else { PG8_STAGE(bufoff, (kptr) + (h) * hstepA, voffA); } } while (0)
#define PG8_LDA(dst, b, h) do { _Pragma("unroll") for (int m = 0; m < 4; ++m) _Pragma("unroll") for (int k = 0; k < 2; ++k) dst[m][k] = *(const LAS bf16x8*)(lds + PG8_SA(b, h) + aoff + m * 2048 + k * 1024); } while (0)
#define PG8_LDB(dst, b, h) do { _Pragma("unroll") for (int n = 0; n < 2; ++n) _Pragma("unroll") for (int k = 0; k < 2; ++k) dst[n][k] = *(const LAS bf16x8*)(lds + PG8_SB(b, h) + boff + n * 2048 + k * 1024); } while (0)
#define PG8_MMA(ai, bj, At, Bt) do { __builtin_amdgcn_s_setprio(1); _Pragma("unroll") for (int m = 0; m < 4; ++m) _Pragma("unroll") for (int n = 0; n < 2; ++n) _Pragma("unroll") for (int k = 0; k < 2; ++k) \
        acc[ai][bj][m][n] = __builtin_amdgcn_mfma_f32_16x16x32_bf16(Bt[n][k], At[m][k], acc[ai][bj][m][n], 0, 0, 0); __builtin_amdgcn_s_setprio(0); } while (0)
#define PG8_WAIT_V(n) asm volatile("s_waitcnt vmcnt(" #n ")" ::: "memory")
#define PG8_WAIT_L(n) asm volatile("s_waitcnt lgkmcnt(" #n ")" ::: "memory")
#define PG8_BAR __builtin_amdgcn_s_barrier()
#define PG8_SCHED __builtin_amdgcn_sched_barrier(0)
    Unit cur, nxt; int ui = 0;
    if (!S.next(0, cur)) return;
    f32x4 acc[2][2][4][2];
#pragma unroll
    for (int a = 0; a < 2; ++a)
#pragma unroll
        for (int b = 0; b < 2; ++b)
#pragma unroll
            for (int m = 0; m < 4; ++m)
#pragma unroll
                for (int n = 0; n < 2; ++n) acc[a][b][m][n] = (f32x4){0.f, 0.f, 0.f, 0.f};
    bf16x8 At[4][2], B0[2][2], B1[2][2];
    LAS unsigned* pbuf = (LAS unsigned*)(lds + 147456 + wid * 2048);
    typename Epi::Pre pre; E.prefetch(cur, wr, wc, fr, fq, pre, pbuf);
    const char* cA = g.A + cur.aoff; const char* cB = g.Bt + cur.boff;
    unsigned gaC[2][2], gaN[2][2];
    if constexpr (GATHER) {
#pragma unroll
        for (int h = 0; h < 2; ++h)
#pragma unroll
            for (int i = 0; i < 2; ++i) { const int tk = (HALFOK && cur.half && h == 1) ? 0 : S.toklist[cur.rb + h * 128 + Rrow[i]]; gaC[h][i] = (unsigned)(tk < 0 ? 0 : tk) * g.lda2 + voffA[i]; gaN[h][i] = gaC[h][i]; } }
    PG8_STAGE(PG8_SB(0, 0), cB, voffB); PG8_STAGE(PG8_SB(0, 1), cB + hstepB, voffB); PG8_STAGE_A(PG8_SA(0, 0), 0, cA, 0, false); PG8_STAGE_A(PG8_SA(0, 1), 1, cA, 0, false);
    if (wr == 1) PG8_BAR;
    PG8_WAIT_V(2); PG8_BAR;
    PG8_STAGE(PG8_SB(1, 0), cB + kstep, voffB); PG8_STAGE_A(PG8_SA(1, 0), 0, cA + kstep, kstep, false); PG8_STAGE(PG8_SB(1, 1), cB + hstepB + kstep, voffB);
    PG8_WAIT_V(6); PG8_BAR;
    for (;;) {
        const bool fullu = cur.half == 0;
        const bool has_next = S.next(ui + 1, nxt);
        const char* nA = has_next ? g.A + nxt.aoff : cA; const char* nB = has_next ? g.Bt + nxt.boff : cB;
        if constexpr (GATHER) { if (has_next) {
#pragma unroll
            for (int h = 0; h < 2; ++h)
#pragma unroll
                for (int i = 0; i < 2; ++i) { const int tk = (HALFOK && nxt.half && h == 1) ? 0 : S.toklist[nxt.rb + h * 128 + Rrow[i]]; gaN[h][i] = (unsigned)(tk < 0 ? 0 : tk) * g.lda2 + voffA[i]; } } }
#pragma unroll 1
        for (int t = 0; t < nt; t += 2) {
            const bool last = (t == nt - 2);
            const char* a1 = cA + (size_t)(t + 1) * kstep;
            const char* a2 = last ? nA : cA + (size_t)(t + 2) * kstep; const char* b2 = last ? nB : cB + (size_t)(t + 2) * kstep;
            const char* a3 = a2 + kstep; const char* b3 = b2 + kstep;
            const size_t k1 = (size_t)(t + 1) * kstep, k2 = last ? 0 : (size_t)(t + 2) * kstep, k3 = k2 + kstep;
            PG8_LDB(B0, 0, 0); PG8_LDB(B1, 0, 1); PG8_SCHED; PG8_LDA(At, 0, 0); PG8_STAGE_A(PG8_SA(1, 1), 1, a1, k1, false);
            PG8_WAIT_V(8); PG8_WAIT_L(0); PG8_BAR; PG8_MMA(0, 0, At, B0); PG8_MMA(0, 1, At, B1); PG8_BAR; PG8_SCHED;
            PG8_LDA(At, 0, 1); PG8_STAGE(PG8_SB(0, 0), b2, voffB); PG8_STAGE(PG8_SB(0, 1), b2 + hstepB, voffB); PG8_STAGE_A(PG8_SA(0, 0), 0, a2, k2, last);
            PG8_WAIT_V(8); PG8_WAIT_L(0); PG8_BAR; if (!HALFOK || fullu) { PG8_MMA(1, 0, At, B0); PG8_MMA(1, 1, At, B1); } PG8_BAR; PG8_SCHED;
            PG8_LDB(B0, 1, 0); PG8_LDB(B1, 1, 1); PG8_SCHED; PG8_LDA(At, 1, 0); PG8_STAGE_A(PG8_SA(0, 1), 1, a2, k2, last);
            PG8_WAIT_V(8); PG8_WAIT_L(0); PG8_BAR; PG8_MMA(0, 0, At, B0); PG8_MMA(0, 1, At, B1); PG8_BAR; PG8_SCHED;
            PG8_LDA(At, 1, 1); PG8_STAGE(PG8_SB(1, 0), b3, voffB); PG8_STAGE(PG8_SB(1, 1), b3 + hstepB, voffB); PG8_STAGE_A(PG8_SA(1, 0), 0, a3, k3, last);
            PG8_WAIT_V(8); PG8_WAIT_L(0); PG8_BAR; if (!HALFOK || fullu) { PG8_MMA(1, 0, At, B0); PG8_MMA(1, 1, At, B1); } PG8_BAR; PG8_SCHED;
        }
        if (wr == 0) PG8_BAR;
        if constexpr (Epi::EARLYPF) {
            typename Epi::Regs rg; E.consume(cur, wr, wc, fr, fq, pbuf, rg);
            asm volatile("s_waitcnt lgkmcnt(0)" ::: "memory");
            if (has_next) E.prefetch(nxt, wr, wc, fr, fq, pre, pbuf);
            E.body(acc, cur, wr, wc, fr, fq, rg);
        } else E(acc, cur, wr, wc, fr, fq, pre, pbuf);
        if (!has_next) break;
#pragma unroll
        for (int a = 0; a < 2; ++a)
#pragma unroll
            for (int b = 0; b < 2; ++b)
#pragma unroll
                for (int m = 0; m < 4; ++m)
#pragma unroll
                    for (int n = 0; n < 2; ++n) acc[a][b][m][n] = (f32x4){0.f, 0.f, 0.f, 0.f};
        cur = nxt; cA = nA; cB = nB; ++ui;
        if constexpr (!Epi::EARLYPF) {
            asm volatile("s_waitcnt lgkmcnt(0)" ::: "memory");
            E.prefetch(cur, wr, wc, fr, fq, pre, pbuf); }
        if constexpr (GATHER) {
#pragma unroll
            for (int h = 0; h < 2; ++h)
#pragma unroll
                for (int i = 0; i < 2; ++i) gaC[h][i] = gaN[h][i]; }
        if (wr == 1) PG8_BAR;
    }
    PG8_WAIT_V(0);
    PG8_BAR;
#undef PG8_SA
#undef PG8_SB
#undef PG8_STAGE
#undef PG8_STAGE_A
#undef PG8_LDA
#undef PG8_LDB
#undef PG8_MMA
#undef PG8_WAIT_V
#undef PG8_WAIT_L
#undef PG8_BAR
#undef PG8_SCHED
}
}
using pg8::Unit; using pg8::Gemm; using pg8::OrdStd; using pg8::gemm_phase;
typedef f32x4 Acc[2][2][4][2];
struct NoPre {};
__device__ __forceinline__ void dma4(const void* gsrc, LAS unsigned* pbuf, int k) { __builtin_amdgcn_global_load_lds((const unsigned*)gsrc, pbuf + k * 64, 4, 0, 0); }
__device__ __forceinline__ LAS unsigned* pbuf2_of(LAS unsigned* pbuf) { const int wid = threadIdx.x >> 6; return pbuf - (147456 / 4 + wid * 512) + ((131072 + 1024) / 4 + wid * 128); }
#define EPI_NOPRE typedef NoPre Pre; __device__ __forceinline__ void prefetch(const Unit&, int, int, int, int, Pre&, LAS unsigned*) const {}
#define EPI_ROW(u, ai, wr, m, fr) ((u).rb + (ai) * 128 + (wr) * 64 + (m) * 16 + (fr))
#define EPI_NA(u) ((u).half ? 1 : 2)

#define SS1_IDX(row, pn) ((size_t)(pn) * T + (size_t)(row))
struct Pre8 { float v[2][4]; };
__device__ __forceinline__ void ss_prefetch(const float* SS, const Unit& u, int wr, int fr, int fq, Pre8& p) {
#pragma unroll
    for (int ai = 0; ai < 2; ++ai)
#pragma unroll
        for (int m = 0; m < 4; ++m) p.v[ai][m] = SS[SS1_IDX(EPI_ROW(u, ai, wr, m, fr), fq)];
}
__device__ __forceinline__ void ss16_prefetch(const float* SS, const Unit& u, int wr, int fr, int fq, Pre8& p) {
#pragma unroll
    for (int ai = 0; ai < 2; ++ai)
#pragma unroll
        for (int m = 0; m < 4; ++m) { const f32x4 v = *(const f32x4*)(SS + (size_t)EPI_ROW(u, ai, wr, m, fr) * 16 + fq * 4); p.v[ai][m] = (v[0] + v[1]) + (v[2] + v[3]); }
}
__device__ __forceinline__ void ss_finish(const Pre8& p, float (&rs)[2][4]) {
#pragma unroll
    for (int ai = 0; ai < 2; ++ai)
#pragma unroll
        for (int m = 0; m < 4; ++m) { float s = p.v[ai][m]; s += __shfl_xor(s, 16); s += __shfl_xor(s, 32); rs[ai][m] = 1.0f / sqrtf(s * (1.0f / D) + EPS); }
}
__device__ __forceinline__ void ss_stage(LAS float* sst, int ai, int wr, int m, int fr, int wc, int fq, float ss) { if (fq == 0) sst[(ai * 128 + wr * 64 + m * 16 + fr) * 4 + wc] = ss; }
__device__ __forceinline__ void ss_flush(LAS float* sst, float* SS, const Unit& u, const int* toklist) {
    asm volatile("s_waitcnt lgkmcnt(0)" ::: "memory"); __syncthreads();
    const int t = threadIdx.x;
    if (t < (u.half ? 128 : 256)) { const f32x4 v = *(const LAS f32x4*)(sst + t * 4); int row = u.rb + t; if (toklist) row = toklist[row];
        if (row >= 0) SS[SS1_IDX(row, u.pn)] = (v[0] + v[1]) + (v[2] + v[3]); }
}
__device__ __forceinline__ float sumsq8(f32x4 a, f32x4 b) { float s0 = amul(a[0], a[0]), s1 = amul(b[0], b[0]);
#pragma unroll
    for (int i = 1; i < 4; ++i) { s0 = afma(a[i], a[i], s0); s1 = afma(b[i], b[i], s1); }
    return aadd(s0, s1); }
__device__ __forceinline__ f32x4 aadd4(f32x4 a, f32x4 b) { f32x4 r; r[0] = aadd(a[0], b[0]); r[1] = aadd(a[1], b[1]); r[2] = aadd(a[2], b[2]); r[3] = aadd(a[3], b[3]); return r; }
__device__ __forceinline__ f32x4 amul4(f32x4 a, float b) { f32x4 r; r[0] = amul(a[0], b); r[1] = amul(a[1], b); r[2] = amul(a[2], b); r[3] = amul(a[3], b); return r; }
__device__ __forceinline__ void put_ss(float* SS, int row, int slot, float ss, int fq) {
    ss += __shfl_xor(ss, 16); ss += __shfl_xor(ss, 32);
    if (fq == 0) SS[(size_t)row * 16 + slot] = ss;
}

struct EpiNull {
    static constexpr bool PERM = true; static constexpr bool EARLYPF = false; EPI_NOPRE
    float* sink;
    __device__ __forceinline__ void operator()(Acc& acc, const Unit& u, int wr, int wc, int fr, int fq, const Pre&, LAS unsigned* pbuf) const {
        float z = 0.f;
#pragma unroll
        for (int ai = 0; ai < 2; ++ai)
#pragma unroll
            for (int bj = 0; bj < 2; ++bj)
#pragma unroll
                for (int m = 0; m < 4; ++m)
#pragma unroll
                    for (int n = 0; n < 2; ++n) z += (acc[ai][bj][m][n][0] + acc[ai][bj][m][n][1]) + (acc[ai][bj][m][n][2] + acc[ai][bj][m][n][3]);
        if (z == 1.2345e-30f) sink[0] = z;
    }
};
struct EpiBf16 {
    static constexpr bool PERM = true; static constexpr bool EARLYPF = false; EPI_NOPRE
    bf16_t* O; int ldc;
    __device__ __forceinline__ void operator()(Acc& acc, const Unit& u, int wr, int wc, int fr, int fq, const Pre&, LAS unsigned* pbuf) const {
        const int col0 = u.pn * 256 + wc * 32 + 8 * fq;
#pragma unroll
        for (int ai = 0; ai < 2; ++ai)
#pragma unroll
            for (int m = 0; m < 4; ++m) { bf16_t* rowp = O + (size_t)EPI_ROW(u, ai, wr, m, fr) * ldc + col0;
#pragma unroll
                for (int bj = 0; bj < 2; ++bj) st16(rowp + bj * 128, pack8(acc[ai][bj][m][0], acc[ai][bj][m][1])); }
    }
};
struct EpiInProj {
    static constexpr bool PERM = true; static constexpr bool EARLYPF = false; typedef NoPre Pre;
    bf16_t* gate; bf16_t* xb; const float* rstd0;
    __device__ __forceinline__ void prefetch(const Unit& u, int wr, int wc, int fr, int fq, Pre&, LAS unsigned* pbuf) const {
#pragma unroll
        for (int ai = 0; ai < 2; ++ai)
#pragma unroll
            for (int m = 0; m < 4; ++m) dma4(rstd0 + EPI_ROW(u, ai, wr, m, fr), pbuf, ai * 4 + m);
    }
    __device__ __forceinline__ void operator()(Acc& acc, const Unit& u, int wr, int wc, int fr, int fq, const Pre&, LAS unsigned* pbuf) const {
        const bool isg = u.pn < 4;
        bf16_t* dst = isg ? gate : xb;
        const int col0 = (u.pn & 3) * 256 + wc * 32 + 8 * fq;
#pragma unroll
        for (int ai = 0; ai < 2; ++ai)
#pragma unroll
            for (int m = 0; m < 4; ++m) { const int row = EPI_ROW(u, ai, wr, m, fr); const float rs = __uint_as_float(pbuf[(ai * 4 + m) * 64 + (threadIdx.x & 63)]); bf16_t* rowp = dst + (size_t)row * D + col0;
#pragma unroll
                for (int bj = 0; bj < 2; ++bj) { f32x4 v0 = amul4(acc[ai][bj][m][0], rs), v1 = amul4(acc[ai][bj][m][1], rs);
                    if (isg) {
#pragma unroll
                        for (int i = 0; i < 4; ++i) {
                            float r0, r1; gelu2(v0[i], v1[i], -2.302208198f, -0.10294324f, r0, r1); v0[i] = r0; v1[i] = r1; }
                    }
                    st16(rowp + bj * 128, pack8(v0, v1)); } }
    }
};
struct EpiGates {
    static constexpr bool PERM = true; static constexpr bool EARLYPF = false; EPI_NOPRE
    const bf16_t* xc; const float* bga; const float* bgx; const float* c8g; bf16_t* hl; bf16_t* pc; float* aggA; float* aggH;
    __device__ __forceinline__ void operator()(Acc& acc, const Unit& u, int wr, int wc, int fr, int fq, const Pre&, LAS unsigned* pbuf) const {
        const int ch0 = (u.pn >> 1) * 256 + (u.pn & 1) * 128 + wc * 32 + 8 * fq;
        const int t0 = u.pm * 256 + 8 * (fr + 16 * wr);
        u32x4 xw[8]; u32x2 hkeep[8], pkeep[8];
        { const bf16_t* xp = xc + (size_t)t0 * D + ch0;
#pragma unroll
          for (int j = 0; j < 8; ++j) xw[j] = *(const u32x4*)(xp + j * D); }
#pragma unroll
        for (int n = 0; n < 2; ++n) { const int ch = ch0 + 4 * n;
            __builtin_amdgcn_sched_barrier(0);
            const f32x4 ba = *(const f32x4*)(bga + ch), bx = *(const f32x4*)(bgx + ch), c8 = *(const f32x4*)(c8g + ch);
            float hp[4], pp[4];
#pragma unroll
            for (int i = 0; i < 4; ++i) { hp[i] = 0.f; pp[i] = 1.f; }
#pragma unroll
            for (int j = 0; j < 8; ++j) { const int ai = j >> 2, m = j & 3; const bool first = ((t0 + j) & (SEQ - 1)) == 0;
                const unsigned xa = n ? xw[j].z : xw[j].x, xb2 = n ? xw[j].w : xw[j].y;
                const float xv[4] = {bflo(xa), bfhi(xa), bflo(xb2), bfhi(xb2)};
#pragma unroll
                for (int i = 0; i < 4; ++i) {
                    const float rr = fsig(acc[ai][0][m][n][i] + ba[i]), ii = fsig(acc[ai][1][m][n][i] + bx[i]);
                    const float a = __builtin_amdgcn_exp2f(c8[i] * rr);
                    const float mult = first ? 1.0f : __builtin_amdgcn_sqrtf(fmaf(-a, a, 1.0f));
                    const float b = mult * ii * xv[i];
                    hp[i] = fmaf(a, hp[i], b); pp[i] *= a;
                    acc[ai][0][m][n][i] = hp[i]; acc[ai][1][m][n][i] = pp[i]; }
                __builtin_amdgcn_sched_barrier(0); }
#pragma unroll
            for (int d = 1; d < 16; d <<= 1)
#pragma unroll
                for (int i = 0; i < 4; ++i) { const float Ao = __shfl_up(pp[i], d, 16), Ho = __shfl_up(hp[i], d, 16);
                    if (fr >= d) { hp[i] = fmaf(pp[i], Ho, hp[i]); pp[i] *= Ao; } }
            float Ae[4], He[4];
#pragma unroll
            for (int i = 0; i < 4; ++i) { const float Ao = __shfl_up(pp[i], 1, 16), Ho = __shfl_up(hp[i], 1, 16); Ae[i] = fr ? Ao : 1.0f; He[i] = fr ? Ho : 0.0f; }
            if (fr == 15) { const int chunk = 2 * u.pm + wr;
                st16f(aggA + (size_t)chunk * D + ch, (f32x4){pp[0], pp[1], pp[2], pp[3]}); st16f(aggH + (size_t)chunk * D + ch, (f32x4){hp[0], hp[1], hp[2], hp[3]}); }
            { bf16_t* hq = hl + (size_t)t0 * D + ch0; bf16_t* pq = pc + (size_t)t0 * D + ch0;
#pragma unroll
              for (int j = 0; j < 8; ++j) { const int ai = j >> 2, m = j & 3; f32x4 hv, pv;
#pragma unroll
                for (int i = 0; i < 4; ++i) { hv[i] = fmaf(acc[ai][1][m][n][i], He[i], acc[ai][0][m][n][i]); pv[i] = acc[ai][1][m][n][i] * Ae[i]; }
                u32x2 hw, pw; hw.x = pk2(hv[0], hv[1]); hw.y = pk2(hv[2], hv[3]); pw.x = pk2(pv[0], pv[1]); pw.y = pk2(pv[2], pv[3]);
                if (n == 0) { hkeep[j] = hw; pkeep[j] = pw; }
                else { st16(hq + j * D, (u32x4){hkeep[j].x, hkeep[j].y, hw.x, hw.y}); st16(pq + j * D, (u32x4){pkeep[j].x, pkeep[j].y, pw.x, pw.y}); } } }
        }
    }
};
struct EpiGatesF {
    static constexpr bool PERM = true; static constexpr bool EARLYPF = false; EPI_NOPRE
    const bf16_t* xc; const float* bga; const float* bgx; const float* c8g; const bf16_t* gate; bf16_t* y; float* aggA; float* aggH; float* rc; const XcdBarrier* xb;
    __device__ __forceinline__ void operator()(Acc& acc, const Unit& u, int wr, int wc, int fr, int fq, const Pre&, LAS unsigned* pbuf) const {
        const int ch0 = (u.pn >> 1) * 256 + (u.pn & 1) * 128 + wc * 32 + 8 * fq;
        const int t0 = u.pm * 256 + 8 * (fr + 16 * wr);
        const int chunk = 2 * u.pm + wr;
        { u32x4 xw[8];
          { const bf16_t* xp = xc + (size_t)t0 * D + ch0;
#pragma unroll
            for (int j = 0; j < 8; ++j) xw[j] = *(const u32x4*)(xp + j * D); }
#pragma unroll
          for (int n = 0; n < 2; ++n) { const int ch = ch0 + 4 * n;
            __builtin_amdgcn_sched_barrier(0);
            const f32x4 ba = *(const f32x4*)(bga + ch), bx = *(const f32x4*)(bgx + ch), c8 = *(const f32x4*)(c8g + ch);
            float hp[4], pp[4];
#pragma unroll
            for (int i = 0; i < 4; ++i) { hp[i] = 0.f; pp[i] = 1.f; }
#pragma unroll
            for (int j = 0; j < 8; ++j) { const int ai = j >> 2, m = j & 3; const bool first = ((t0 + j) & (SEQ - 1)) == 0;
                const unsigned xa = n ? xw[j].z : xw[j].x, xb2 = n ? xw[j].w : xw[j].y;
                const float xv[4] = {bflo(xa), bfhi(xa), bflo(xb2), bfhi(xb2)};
#pragma unroll
                for (int i = 0; i < 4; ++i) {
                    const float rr = fsig(acc[ai][0][m][n][i] + ba[i]), ii = fsig(acc[ai][1][m][n][i] + bx[i]);
                    const float a = __builtin_amdgcn_exp2f(c8[i] * rr);
                    const float mult = first ? 1.0f : __builtin_amdgcn_sqrtf(fmaf(-a, a, 1.0f));
                    const float b = mult * ii * xv[i];
                    hp[i] = fmaf(a, hp[i], b); pp[i] *= a;
                    acc[ai][0][m][n][i] = hp[i]; acc[ai][1][m][n][i] = pp[i]; }
                __builtin_amdgcn_sched_barrier(0); }
#pragma unroll
            for (int d = 1; d < 16; d <<= 1)
#pragma unroll
                for (int i = 0; i < 4; ++i) { const float Ao = __shfl_up(pp[i], d, 16), Ho = __shfl_up(hp[i], d, 16);
                    if (fr >= d) { hp[i] = fmaf(pp[i], Ho, hp[i]); pp[i] *= Ao; } }
            float Ae[4], He[4];
#pragma unroll
            for (int i = 0; i < 4; ++i) { const float Ao = __shfl_up(pp[i], 1, 16), Ho = __shfl_up(hp[i], 1, 16); Ae[i] = fr ? Ao : 1.0f; He[i] = fr ? Ho : 0.0f; }
            if (fr == 15) { st16f(aggA + (size_t)chunk * D + ch, (f32x4){pp[0], pp[1], pp[2], pp[3]}); st16f(aggH + (size_t)chunk * D + ch, (f32x4){hp[0], hp[1], hp[2], hp[3]}); }
#pragma unroll
            for (int j = 0; j < 8; ++j) { const int ai = j >> 2, m = j & 3;
#pragma unroll
                for (int i = 0; i < 4; ++i) { const float P = acc[ai][1][m][n][i]; acc[ai][0][m][n][i] = fmaf(P, He[i], acc[ai][0][m][n][i]); acc[ai][1][m][n][i] = P * Ae[i]; } }
          } }
        xcd_barrier(*xb);
        const int b = u.pm >> 5, tt = u.pm & 31, rnd = tt >> 3, c0 = b * 64 + 16 * rnd;
        f32x4 cr0 = {0.f, 0.f, 0.f, 0.f}, cr1 = {0.f, 0.f, 0.f, 0.f};
        if (rnd > 0) { const float* rp = rc + ((size_t)(b * 4 + rnd)) * D + ch0; cr0 = *(const f32x4*)rp; cr1 = *(const f32x4*)(rp + 4); }
        for (int cc = c0; cc < chunk; ++cc) { const f32x4 a0 = *(const f32x4*)(aggA + (size_t)cc * D + ch0), a1 = *(const f32x4*)(aggA + (size_t)cc * D + ch0 + 4);
            const f32x4 h0 = *(const f32x4*)(aggH + (size_t)cc * D + ch0), h1 = *(const f32x4*)(aggH + (size_t)cc * D + ch0 + 4);
#pragma unroll
            for (int i = 0; i < 4; ++i) { cr0[i] = fmaf(a0[i], cr0[i], h0[i]); cr1[i] = fmaf(a1[i], cr1[i], h1[i]); } }
        if ((tt & 7) == 7 && wr == 1 && rnd < 3 && fr == 0) {
            const f32x4 a0 = *(const f32x4*)(aggA + (size_t)chunk * D + ch0), a1 = *(const f32x4*)(aggA + (size_t)chunk * D + ch0 + 4);
            const f32x4 h0 = *(const f32x4*)(aggH + (size_t)chunk * D + ch0), h1 = *(const f32x4*)(aggH + (size_t)chunk * D + ch0 + 4);
            f32x4 e0, e1;
#pragma unroll
            for (int i = 0; i < 4; ++i) { e0[i] = fmaf(a0[i], cr0[i], h0[i]); e1[i] = fmaf(a1[i], cr1[i], h1[i]); }
            float* rp = rc + ((size_t)(b * 4 + rnd + 1)) * D + ch0; st16f(rp, e0); st16f(rp + 4, e1); }
        { u32x4 gw[8]; const bf16_t* gp = gate + (size_t)t0 * D + ch0;
#pragma unroll
          for (int j = 0; j < 8; ++j) gw[j] = *(const u32x4*)(gp + j * D);
          bf16_t* yp = y + (size_t)t0 * D + ch0;
#pragma unroll
          for (int j = 0; j < 8; ++j) { const int ai = j >> 2, m = j & 3; f32x4 g0, g1, o0, o1; unpack8(gw[j], g0, g1);
#pragma unroll
            for (int i = 0; i < 4; ++i) { o0[i] = fmaf(acc[ai][1][m][0][i], cr0[i], acc[ai][0][m][0][i]) * g0[i]; o1[i] = fmaf(acc[ai][1][m][1][i], cr1[i], acc[ai][0][m][1][i]) * g1[i]; }
            st16(yp + j * D, pack8(o0, o1)); } }
    }
};
template <bool RF32> struct EpiRes {
    static constexpr bool PERM = true; static constexpr bool EARLYPF = false; EPI_NOPRE
    const void* R; bf16_t* X; float* SS; LAS float* sst;
    __device__ __forceinline__ void operator()(Acc& acc, const Unit& u, int wr, int wc, int fr, int fq, const Pre&, LAS unsigned* pbuf) const {
        const int col0 = u.pn * 256 + wc * 32 + 8 * fq;
        if (RF32) {
#pragma unroll
            for (int ai = 0; ai < 2; ++ai) { f32x4 rv[4][2][2];
#pragma unroll
                for (int m = 0; m < 4; ++m)
#pragma unroll
                    for (int bj = 0; bj < 2; ++bj) { const float* rp = (const float*)R + (size_t)EPI_ROW(u, ai, wr, m, fr) * D + col0 + bj * 128; rv[m][bj][0] = *(const f32x4*)rp; rv[m][bj][1] = *(const f32x4*)(rp + 4); }
                __builtin_amdgcn_sched_barrier(0);
#pragma unroll
                for (int m = 0; m < 4; ++m) { const int row = EPI_ROW(u, ai, wr, m, fr); float ss = 0.f;
#pragma unroll
                    for (int bj = 0; bj < 2; ++bj) { const f32x4 v0 = aadd4(acc[ai][bj][m][0], rv[m][bj][0]), v1 = aadd4(acc[ai][bj][m][1], rv[m][bj][1]);
                        ss = aadd(ss, sumsq8(v0, v1)); st16(X + (size_t)row * D + col0 + bj * 128, pack8(v0, v1)); }
                    ss += __shfl_xor(ss, 16); ss += __shfl_xor(ss, 32); ss_stage(sst, ai, wr, m, fr, wc, fq, ss); }
                __builtin_amdgcn_sched_barrier(0); }
        } else {
#pragma unroll
            for (int ai = 0; ai < 2; ++ai) { u32x4 rv[4][2];
#pragma unroll
                for (int m = 0; m < 4; ++m)
#pragma unroll
                    for (int bj = 0; bj < 2; ++bj) rv[m][bj] = *(const u32x4*)((const bf16_t*)R + (size_t)EPI_ROW(u, ai, wr, m, fr) * D + col0 + bj * 128);
                __builtin_amdgcn_sched_barrier(0);
#pragma unroll
                for (int m = 0; m < 4; ++m) { const int row = EPI_ROW(u, ai, wr, m, fr); float ss = 0.f;
#pragma unroll
                    for (int bj = 0; bj < 2; ++bj) { f32x4 r0, r1; unpack8(rv[m][bj], r0, r1);
                        const f32x4 v0 = aadd4(acc[ai][bj][m][0], r0), v1 = aadd4(acc[ai][bj][m][1], r1);
                        ss = aadd(ss, sumsq8(v0, v1)); st16(X + (size_t)row * D + col0 + bj * 128, pack8(v0, v1)); }
                    ss += __shfl_xor(ss, 16); ss += __shfl_xor(ss, 32); ss_stage(sst, ai, wr, m, fr, wc, fq, ss); }
                __builtin_amdgcn_sched_barrier(0); }
        }
        ss_flush(sst, SS, u, nullptr);
    }
};
struct EpiSwiglu {
    static constexpr bool PERM = true; static constexpr bool EARLYPF = true; static constexpr int NVM = 12; typedef NoPre Pre;
    struct Regs { float ns[2][4], ic[2][4]; };
    bf16_t* O; int ldc; const float* SSin; const unsigned* slotp;
    __device__ __forceinline__ void prefetch(const Unit& u, int wr, int wc, int fr, int fq, Pre&, LAS unsigned* pbuf) const {
#pragma unroll
        for (int ai = 0; ai < 2; ++ai)
#pragma unroll
            for (int m = 0; m < 4; ++m) { const int row = EPI_ROW(u, ai, wr, m, fr); dma4(SSin ? (const void*)(SSin + SS1_IDX(row, fq)) : (const void*)(slotp + row), pbuf, ai * 4 + m); }
    }
    __device__ __forceinline__ void consume(const Unit& u, int wr, int wc, int fr, int fq, LAS unsigned* pbuf, Regs& rg) const {
        const int lane = threadIdx.x & 63;
#pragma unroll
        for (int ai = 0; ai < 2; ++ai)
#pragma unroll
            for (int m = 0; m < 4; ++m) { const unsigned w = pbuf[(ai * 4 + m) * 64 + lane];
                if (SSin) { float q = __uint_as_float(w); q += __shfl_xor(q, 16); q += __shfl_xor(q, 32); q = q * (1.0f / D) + EPS; rg.ic[ai][m] = q; rg.ns[ai][m] = -LOG2E * __builtin_amdgcn_rsqf(q); }
                else { float s_, sw_; unpack_h2(w, s_, sw_); rg.ns[ai][m] = -LOG2E * s_; rg.ic[ai][m] = fminf(__builtin_amdgcn_rcpf(s_ * sw_), 1e30f); } }
    }
    __device__ __forceinline__ void body(Acc& acc, const Unit& u, int wr, int wc, int fr, int fq, const Regs& rg) const {
        const int col0 = u.pn * 128 + wc * 32 + 8 * fq;
        const int na = EPI_NA(u);
#pragma unroll
        for (int ai = 0; ai < 2; ++ai) if (ai < na)
#pragma unroll
            for (int m = 0; m < 4; ++m) { const int row = EPI_ROW(u, ai, wr, m, fr); const float n_ = rg.ns[ai][m], c_ = rg.ic[ai][m];
                f32x4 o0, o1;
#pragma unroll
                for (int i = 0; i < 4; ++i) { const float g0 = acc[ai][0][m][0][i], u0 = acc[ai][1][m][0][i], g1 = acc[ai][0][m][1][i], u1 = acc[ai][1][m][1][i];
                    float r0, r1; swiglu2(g0, u0, g1, u1, n_, c_, r0, r1); o0[i] = r0; o1[i] = r1; }
                st16(O + (size_t)row * ldc + col0, pack8(o0, o1)); }
    }
};
template <bool OUTF32, bool IN16 = false> struct EpiPle {
    static constexpr bool PERM = true; static constexpr bool EARLYPF = false; typedef Pre8 Pre;
    const bf16_t* X; const bf16_t* PP; void* O; const float* SSin; float* SSout; LAS float* sst;
    __device__ __forceinline__ void prefetch(const Unit& u, int wr, int wc, int fr, int fq, Pre& p, LAS unsigned* pbuf) const { if (IN16) ss16_prefetch(SSin, u, wr, fr, fq, p); else ss_prefetch(SSin, u, wr, fr, fq, p); }
    __device__ __forceinline__ void operator()(Acc& acc, const Unit& u, int wr, int wc, int fr, int fq, const Pre& pre, LAS unsigned* pbuf) const {
        const int col0 = u.pn * 256 + wc * 32 + 8 * fq;
        float rs[2][4]; ss_finish(pre, rs);
#pragma unroll
        for (int ai = 0; ai < 2; ++ai)
#pragma unroll
            for (int mh = 0; mh < 2; ++mh) { u32x4 xv[2][2], pv[2][2];
#pragma unroll
                for (int ml = 0; ml < 2; ++ml)
#pragma unroll
                    for (int bj = 0; bj < 2; ++bj) { const size_t off = (size_t)EPI_ROW(u, ai, wr, 2 * mh + ml, fr) * D + col0 + bj * 128; xv[ml][bj] = *(const u32x4*)(X + off); pv[ml][bj] = *(const u32x4*)(PP + off); }
                __builtin_amdgcn_sched_barrier(0);
#pragma unroll
                for (int ml = 0; ml < 2; ++ml) { const int m = 2 * mh + ml; const int row = EPI_ROW(u, ai, wr, m, fr); const float s = -LOG2E * rs[ai][m]; float ss = 0.f;
#pragma unroll
                    for (int bj = 0; bj < 2; ++bj) { const size_t off = (size_t)row * D + col0 + bj * 128; f32x4 x0, x1, p0, p1;
                        unpack8(xv[ml][bj], x0, x1); unpack8(pv[ml][bj], p0, p1);
                        f32x4 v0, v1;
#pragma unroll
                        for (int i = 0; i < 4; ++i) {
                            float r0, r1; plesig2(acc[ai][bj][m][0][i], acc[ai][bj][m][1][i], s, p0[i], p1[i], x0[i], x1[i], r0, r1); v0[i] = r0; v1[i] = r1; }
                        ss = aadd(ss, sumsq8(v0, v1));
                        if (OUTF32) { st16f((float*)O + off, v0); st16f((float*)O + off + 4, v1); }
                        else st16((bf16_t*)O + off, pack8(v0, v1)); }
                    ss += __shfl_xor(ss, 16); ss += __shfl_xor(ss, 32); ss_stage(sst, ai, wr, m, fr, wc, fq, ss); }
                __builtin_amdgcn_sched_barrier(0); }
        ss_flush(sst, SSout, u, nullptr);
    }
};
struct EpiQkv {
    static constexpr bool PERM = true; static constexpr bool EARLYPF = false;
    typedef NoPre Pre;
    bf16_t* KV; bf16_t* Q; const float* SSin; const int* pos;
    __device__ __forceinline__ void prefetch(const Unit& u, int wr, int wc, int fr, int fq, Pre& p, LAS unsigned* pbuf) const {
#pragma unroll
        for (int ai = 0; ai < 2; ++ai)
#pragma unroll
            for (int m = 0; m < 4; ++m) { const int row = EPI_ROW(u, ai, wr, m, fr); dma4(SSin + SS1_IDX(row, fq), pbuf, ai * 4 + m); }
        LAS unsigned* p2 = pbuf2_of(pbuf);
#pragma unroll
        for (int h = 0; h < 2; ++h) dma4(pos + EPI_ROW(u, h, wr, fq, fr), p2, h);
    }
    __device__ __forceinline__ void operator()(Acc& acc, const Unit& u, int wr, int wc, int fr, int fq, const Pre& pre, LAS unsigned* pbuf) const {
        float rs[2][4]; int ps[2][4];
        const int lane = threadIdx.x & 63; LAS unsigned* p2 = pbuf2_of(pbuf);
#pragma unroll
        for (int ai = 0; ai < 2; ++ai)
#pragma unroll
            for (int m = 0; m < 4; ++m) { float s = __uint_as_float(pbuf[(ai * 4 + m) * 64 + lane]); s += __shfl_xor(s, 16); s += __shfl_xor(s, 32); rs[ai][m] = 1.0f / sqrtf(s * (1.0f / D) + EPS); ps[ai][m] = (int)p2[ai * 64 + m * 16 + fr]; }
        const bool isq = u.pn >= 1;
        const bool rot_lane = ((wc & 1) == 0) && (fq < 2);
        const float QS = 0.125f * LOG2E;
        const int na = EPI_NA(u);
#pragma unroll
        for (int ai = 0; ai < 2; ++ai) if (ai < na)
#pragma unroll
            for (int m = 0; m < 4; ++m) { const int row = EPI_ROW(u, ai, wr, m, fr); const float s = rs[ai][m];
                float cs[4], sn[4];
                if (rot_lane) { const float p = (float)ps[ai][m];
#pragma unroll
                    for (int i = 0; i < 4; ++i) { const int f = 4 * fq + i;
                        const float fr2pi = f == 0 ? 0.15915494309189535f : f == 1 ? 0.03086376340470123f : f == 2 ? 0.005985185712713705f : f == 3 ? 0.001160663641240061f
                                          : f == 4 ? 0.00022507907903927653f : f == 5 ? 4.364795279280289e-05f : f == 6 ? 8.464330808241401e-06f : 1.6414262627950345e-06f;
                        float rev = p * fr2pi; rev -= floorf(rev);
                        sn[i] = __builtin_amdgcn_sinf(rev); cs[i] = __builtin_amdgcn_cosf(rev); } }
#pragma unroll
                for (int bj = 0; bj < 2; ++bj) { f32x4 v0 = acc[ai][bj][m][0] * s, v1 = acc[ai][bj][m][1] * s;
                    const bool rot = rot_lane && (isq || bj == 0);
                    if (rot) {
#pragma unroll
                        for (int i = 0; i < 4; ++i) { const float t1 = v0[i], t2 = v1[i]; v0[i] = t1 * cs[i] - t2 * sn[i]; v1[i] = t2 * cs[i] + t1 * sn[i]; } }
                    if (isq) { v0 = v0 * QS; v1 = v1 * QS; st16(Q + (size_t)row * D + (u.pn - 1) * 256 + bj * 128 + wc * 32 + 8 * fq, pack8(v0, v1)); }
                    else st16(KV + (size_t)row * 256 + bj * 128 + wc * 32 + 8 * fq, pack8(v0, v1)); } }
    }
};
struct EpiMoeDown {
    static constexpr bool PERM = true; static constexpr bool EARLYPF = false; typedef NoPre Pre;
    const int* toklist; bf16_t* X; float* SS;
    __device__ __forceinline__ void prefetch(const Unit& u, int wr, int wc, int fr, int fq, Pre& p, LAS unsigned* pbuf) const {
        LAS unsigned* p2 = pbuf2_of(pbuf);
#pragma unroll
        for (int h = 0; h < 2; ++h) dma4(toklist + EPI_ROW(u, h, wr, fq, fr), p2, h);
    }
    __device__ __forceinline__ void operator()(Acc& acc, const Unit& u, int wr, int wc, int fr, int fq, const Pre&, LAS unsigned* pbuf) const {
        const int col0 = u.pn * 256 + wc * 32 + 8 * fq;
        int tk[2][4]; LAS unsigned* p2 = pbuf2_of(pbuf);
#pragma unroll
        for (int ai = 0; ai < 2; ++ai)
#pragma unroll
            for (int m = 0; m < 4; ++m) tk[ai][m] = (ai < EPI_NA(u)) ? (int)p2[ai * 64 + m * 16 + fr] : -1;
#pragma unroll
        for (int ai = 0; ai < 2; ++ai) if (ai < EPI_NA(u)) { u32x4 rv[4][2];
#pragma unroll
            for (int m = 0; m < 4; ++m) { const int tok = tk[ai][m] < 0 ? 0 : tk[ai][m];
#pragma unroll
                for (int bj = 0; bj < 2; ++bj) rv[m][bj] = *(const u32x4*)(X + (size_t)tok * D + col0 + bj * 128); }
            __builtin_amdgcn_sched_barrier(0);
#pragma unroll
            for (int m = 0; m < 4; ++m) { const int tok = tk[ai][m]; float ss = 0.f;
#pragma unroll
                for (int bj = 0; bj < 2; ++bj) { f32x4 r0, r1; unpack8(rv[m][bj], r0, r1);
                    const f32x4 v0 = aadd4(acc[ai][bj][m][0], r0), v1 = aadd4(acc[ai][bj][m][1], r1);
                    ss = aadd(ss, sumsq8(v0, v1));
                    if (tok >= 0) st16(X + (size_t)tok * D + col0 + bj * 128, pack8(v0, v1)); }
                if (SS) { ss += __shfl_xor(ss, 16); ss += __shfl_xor(ss, 32); if (fq == 0 && tok >= 0) SS[(size_t)tok * 16 + u.pn * 4 + wc] = ss; } }
            __builtin_amdgcn_sched_barrier(0); }
    }
};
#define LDS_WAIT() asm volatile("s_waitcnt lgkmcnt(0)" ::: "memory")

__device__ __forceinline__ int rope_perm(int d) { return d < 4 ? d : d < 8 ? d + 4 : d < 12 ? d - 4 : d; }
__device__ __forceinline__ int dst_row(int map, int p0, int p1, int n) {
    if (map == 0) return p0 + n;
    if (map == 1) { const int nn = n < p0 ? n : n - p0; return p1 + (nn >> 7) * 256 + (n < p0 ? 0 : 128) + (nn & 127); }
    if (map == 2) return (p0 + (n >> 7)) * 256 + p1 + (n & 127);
    return p0 + (n < p1 ? (n & ~63) + rope_perm(n & 63) : n);
}
struct TJob { const float* W; const float* gain; bf16_t* dst; int K, N, dpitch, map, p0, p1; };
__device__ __forceinline__ void transpose_item(const TJob& J, LAS float* scr, int item, int lane) {
    const int nblk = J.N / 32, kb = item / nblk, nb = item % nblk, k0 = 64 * kb, n0 = 32 * nb;
    f32x4 v[8];
#pragma unroll
    for (int i = 0; i < 8; ++i) v[i] = __builtin_nontemporal_load((const f32x4*)(J.W + (size_t)(k0 + (lane >> 3) + 8 * i) * J.N + n0 + 4 * (lane & 7)));
#pragma unroll
    for (int i = 0; i < 8; ++i) { const int kk = (lane >> 3) + 8 * i; f32x4 w = v[i]; if (J.gain) w = w * J.gain[k0 + kk];
        LAS float* d = scr + kk * 33 + 4 * (lane & 7); d[0] = w[0]; d[1] = w[1]; d[2] = w[2]; d[3] = w[3]; }
    LDS_WAIT(); asm volatile("" ::: "memory");
    const int c = lane & 7;
#pragma unroll
    for (int j = 0; j < 4; ++j) { const int n = (lane >> 3) + 8 * j; const LAS float* s = scr + (8 * c) * 33 + n;
        u32x4 o; o.x = pk2(s[0 * 33], s[1 * 33]); o.y = pk2(s[2 * 33], s[3 * 33]); o.z = pk2(s[4 * 33], s[5 * 33]); o.w = pk2(s[6 * 33], s[7 * 33]);
        st16(J.dst + (size_t)dst_row(J.map, J.p0, J.p1, n0 + n) * J.dpitch + k0 + 8 * c, o); }
    LDS_WAIT(); asm volatile("" ::: "memory");
}
template <int NR> __device__ __forceinline__ void cvt_rows(const float* xrow, bf16_t* orow, float* rstd_out, int lane) {
    f32x4 v[NR][4];
#pragma unroll
    for (int r = 0; r < NR; ++r)
#pragma unroll
        for (int j = 0; j < 4; ++j) v[r][j] = __builtin_nontemporal_load((const f32x4*)(xrow + (size_t)r * D) + lane + 64 * j);
#pragma unroll
    for (int r = 0; r < NR; ++r) { float s = 0.f; u32x2* o = (u32x2*)(orow + (size_t)r * D);
#pragma unroll
        for (int j = 0; j < 4; ++j) { const f32x4 a = v[r][j]; s += (a[0] * a[0] + a[1] * a[1]) + (a[2] * a[2] + a[3] * a[3]); u32x2 w; w.x = pk2(a[0], a[1]); w.y = pk2(a[2], a[3]); o[lane + 64 * j] = w; }
        if (rstd_out) { s = wave_sum(s); if (lane == 0) rstd_out[r] = 1.0f / sqrtf(s * (1.0f / D) + EPS); } }
}

__device__ __forceinline__ void conv_phase(const bf16_t* XB, const float* cw, const float* cb, bf16_t* XC, int gtid, int gthreads) {
    for (int it = gtid; it < (T / 16) * 128; it += gthreads) {
        const int cgp = it & 127, strip = it >> 7, c0 = cgp * 8, t0 = strip * 16;
        float w[4][8], b[8];
#pragma unroll
        for (int k = 0; k < 4; ++k) { const f32x4 a = *(const f32x4*)(cw + k * D + c0), bb = *(const f32x4*)(cw + k * D + c0 + 4);
#pragma unroll
            for (int i = 0; i < 4; ++i) { w[k][i] = a[i]; w[k][4 + i] = bb[i]; } }
        { const f32x4 a = *(const f32x4*)(cb + c0), bb = *(const f32x4*)(cb + c0 + 4);
#pragma unroll
          for (int i = 0; i < 4; ++i) { b[i] = a[i]; b[4 + i] = bb[i]; } }
        const bool seq0 = (t0 & (SEQ - 1)) == 0;
        u32x4 xw[19];
#pragma unroll
        for (int j = 0; j < 19; ++j) { if (j < 3 && seq0) xw[j] = (u32x4){0u, 0u, 0u, 0u}; else xw[j] = *(const u32x4*)(XB + (size_t)(t0 - 3 + j) * D + c0); }
#pragma unroll
        for (int j = 0; j < 16; ++j) {
            f32x4 o0, o1;
#pragma unroll
            for (int i = 0; i < 4; ++i) { o0[i] = b[i]; o1[i] = b[4 + i]; }
#pragma unroll
            for (int k = 0; k < 4; ++k) { f32x4 x0, x1; unpack8(xw[j + 3 - k], x0, x1);
#pragma unroll
                for (int i = 0; i < 4; ++i) { o0[i] = fmaf(w[k][i], x0[i], o0[i]); o1[i] = fmaf(w[k][4 + i], x1[i], o1[i]); } }
            st16(XC + (size_t)(t0 + j) * D + c0, pack8(o0, o1)); }
    }
}
__device__ __forceinline__ void carry_phase(const float* aggA, const float* aggH, float* carry, int gtid, int gthreads) {
    for (int it = gtid; it < BATCH * D; it += gthreads) {
        const int b = it >> 10, c = it & 1023; const size_t base = (size_t)b * 64 * D + c;
        float h = 0.f;
#pragma unroll 8
        for (int k = 0; k < 64; ++k) { carry[base + (size_t)k * D] = h; h = fmaf(aggA[base + (size_t)k * D], h, aggH[base + (size_t)k * D]); }
    }
}
__device__ __forceinline__ void ypass_phase(const bf16_t* HL, const bf16_t* PC, const bf16_t* GATE, const float* carry, bf16_t* Y, int gtid, int gthreads) {
    for (int it = gtid; it < (T / 16) * 128; it += gthreads) {
        const int cgp = it & 127, strip = it >> 7, c0 = cgp * 8, t0 = strip * 16, chunk = t0 >> 7;
        const f32x4 ca = *(const f32x4*)(carry + (size_t)chunk * D + c0), cb2 = *(const f32x4*)(carry + (size_t)chunk * D + c0 + 4);
#pragma unroll 8
        for (int j = 0; j < 16; ++j) { const size_t off = (size_t)(t0 + j) * D + c0;
            f32x4 h0, h1, p0, p1, g0, g1; unpack8(*(const u32x4*)(HL + off), h0, h1); unpack8(*(const u32x4*)(PC + off), p0, p1); unpack8(*(const u32x4*)(GATE + off), g0, g1);
            f32x4 o0, o1;
#pragma unroll
            for (int i = 0; i < 4; ++i) { o0[i] = fmaf(p0[i], ca[i], h0[i]) * g0[i]; o1[i] = fmaf(p1[i], cb2[i], h1[i]) * g1[i]; }
            st16(Y + off, pack8(o0, o1)); }
    }
}
constexpr int ATT_KP = 144, ATT_VP = 520, ATT_KS = 0, ATT_VS = 256 * ATT_KP, ATT_OS = 73728;
__device__ __forceinline__ void attn_phase(LAS unsigned char* lds, const bf16_t* Q, const bf16_t* KV, const float* sinks, bf16_t* O, int blk, int nblk) {
    const int tid = threadIdx.x, lane = tid & 63, wid = __builtin_amdgcn_readfirstlane(tid >> 6), r = lane & 31, hh = lane >> 5;
    for (int unit = blk; unit < BATCH * 64 * 2; unit += nblk) {
        const int kvh = unit & 1, nb = (unit >> 1) & 63, b = unit >> 7;
        const long row0 = (long)b * SEQ + nb * 128;
#pragma unroll
        for (int i = 0; i < 4; ++i) { const int id = tid + 512 * i, key = id >> 3, c = id & 7;
            u32x4 kw = (u32x4){0u, 0u, 0u, 0u}, vw = (u32x4){0u, 0u, 0u, 0u};
            if (nb > 0 || key >= 128) { const bf16_t* src = KV + (size_t)(row0 - 128 + key) * 256 + kvh * 64 + c * 8; kw = *(const u32x4*)src; vw = *(const u32x4*)(src + 128); }
            *(LAS u32x4*)(lds + ATT_KS + key * ATT_KP + c * 16) = kw;
            LAS bf16_t* vt = (LAS bf16_t*)(lds + ATT_VS + (c * 8) * ATT_VP + key * 2);
            vt[0 * (ATT_VP / 2)] = (bf16_t)(vw.x & 0xffffu); vt[1 * (ATT_VP / 2)] = (bf16_t)(vw.x >> 16); vt[2 * (ATT_VP / 2)] = (bf16_t)(vw.y & 0xffffu); vt[3 * (ATT_VP / 2)] = (bf16_t)(vw.y >> 16);
            vt[4 * (ATT_VP / 2)] = (bf16_t)(vw.z & 0xffffu); vt[5 * (ATT_VP / 2)] = (bf16_t)(vw.z >> 16); vt[6 * (ATT_VP / 2)] = (bf16_t)(vw.w & 0xffffu); vt[7 * (ATT_VP / 2)] = (bf16_t)(vw.w >> 16); }
        __syncthreads();
        const int h = kvh * 8 + wid;
        const float sink2 = sinks[h] * LOG2E;
        for (int qs = 0; qs < 4; ++qs) {
            const long qrow = row0 + 32 * qs + r;
            bf16x8 qf[4];
#pragma unroll
            for (int s = 0; s < 4; ++s) qf[s] = *(const bf16x8*)(Q + (size_t)qrow * D + h * 64 + 16 * s + 8 * hh);
            f32x16 st[5];
#pragma unroll
            for (int kt = 0; kt < 5; ++kt) { f32x16 a = {};
                const LAS unsigned char* kp = lds + ATT_KS + (32 * (qs + kt) + r) * ATT_KP + 16 * hh;
#pragma unroll
                for (int s = 0; s < 4; ++s) { const bf16x8 kf = *(const LAS bf16x8*)(kp + 32 * s); a = __builtin_amdgcn_mfma_f32_32x32x16_bf16(kf, qf[s], a, 0, 0, 0); }
                st[kt] = a; }
            float mx = sink2;
#pragma unroll
            for (int kt = 0; kt < 5; ++kt) { const bool dead = (nb == 0) && (qs + kt < 4);
#pragma unroll
                for (int rg = 0; rg < 16; ++rg) { const int kk = (rg & 3) + 8 * (rg >> 2) + 4 * hh;
                    bool ok = !dead; if (kt == 0) ok = ok && (kk > r); if (kt == 4) ok = ok && (kk <= r);
                    const float v = ok ? st[kt][rg] : -1e30f; st[kt][rg] = v; mx = fmaxf(mx, v); } }
            mx = fmaxf(mx, __shfl_xor(mx, 32));
            float sum = 0.f;
#pragma unroll
            for (int kt = 0; kt < 5; ++kt)
#pragma unroll
                for (int rg = 0; rg < 16; ++rg) { const float p = __builtin_amdgcn_exp2f(st[kt][rg] - mx); st[kt][rg] = p; sum += p; }
            sum += __shfl_xor(sum, 32);
            const float inv = 1.0f / (sum + __builtin_amdgcn_exp2f(sink2 - mx));
            f32x16 o0 = {}, o1 = {};
#pragma unroll
            for (int kt = 0; kt < 5; ++kt)
#pragma unroll
                for (int s2 = 0; s2 < 2; ++s2) {
                    u32x4 pw; pw.x = pk2(st[kt][8 * s2 + 0] * inv, st[kt][8 * s2 + 1] * inv); pw.y = pk2(st[kt][8 * s2 + 2] * inv, st[kt][8 * s2 + 3] * inv);
                    pw.z = pk2(st[kt][8 * s2 + 4] * inv, st[kt][8 * s2 + 5] * inv); pw.w = pk2(st[kt][8 * s2 + 6] * inv, st[kt][8 * s2 + 7] * inv);
                    const bf16x8 pa = __builtin_bit_cast(bf16x8, pw);
                    const int kbase = 32 * (qs + kt) + 16 * s2 + 4 * hh;
#pragma unroll
                    for (int dh = 0; dh < 2; ++dh) { const LAS unsigned char* vp = lds + ATT_VS + (32 * dh + r) * ATT_VP + kbase * 2;
                        const u32x2 lo = *(const LAS u32x2*)vp, hi = *(const LAS u32x2*)(vp + 16);
                        const u32x4 vv = (u32x4){lo.x, lo.y, hi.x, hi.y}; const bf16x8 vf = __builtin_bit_cast(bf16x8, vv);
                        if (dh == 0) o0 = __builtin_amdgcn_mfma_f32_32x32x16_bf16(pa, vf, o0, 0, 0, 0); else o1 = __builtin_amdgcn_mfma_f32_32x32x16_bf16(pa, vf, o1, 0, 0, 0); } }
            LAS unsigned char* ost = lds + ATT_OS + wid * (32 * 144);
#pragma unroll
            for (int rg = 0; rg < 16; ++rg) { const int q = (rg & 3) + 8 * (rg >> 2) + 4 * hh;
                *(LAS bf16_t*)(ost + q * 144 + 2 * r) = (bf16_t)(pk2(o0[rg], 0.f) & 0xffffu); *(LAS bf16_t*)(ost + q * 144 + 64 + 2 * r) = (bf16_t)(pk2(o1[rg], 0.f) & 0xffffu); }
            LDS_WAIT();
#pragma unroll
            for (int i = 0; i < 4; ++i) { const int q = 8 * i + (lane >> 3), ch = lane & 7;
                const u32x4 v = *(const LAS u32x4*)(ost + q * 144 + 16 * ch);
                *(u32x4*)(O + (size_t)(row0 + 32 * qs + q) * D + h * 64 + 8 * ch) = v; }
            LDS_WAIT();
        }
        __syncthreads();
    }
}
__device__ __forceinline__ void router_phase(LAS unsigned char* lds, const bf16_t* X, const float* SS, const bf16_t* WR16, const float* br,
                                             unsigned* TOKE, float* TOKW0, float* TOKW1, float* TOKR, int* CNT, int blk, int nblk) {
    const int tid = threadIdx.x, lane = tid & 63, wid = tid >> 6, r16 = lane & 15, kq = lane >> 4;
    LAS unsigned* se = (LAS unsigned*)lds;
    LAS float* slg = (LAS float*)(lds + 1024) + wid * 16 * 9;
    for (int tile = blk; tile < T / 128; tile += nblk) {
        const int tok0 = tile * 128 + wid * 16;
        const bf16_t* xa = X + (size_t)(tok0 + r16) * D + 8 * kq;
        const bf16_t* wb = WR16 + (size_t)r16 * D + 8 * kq;
        f32x4 acc = {0.f, 0.f, 0.f, 0.f};
#pragma unroll
        for (int sb = 0; sb < 4; ++sb) { bf16x8 af[8], bfr[8];
#pragma unroll
            for (int s = 0; s < 8; ++s) { af[s] = *(const bf16x8*)(xa + 32 * (8 * sb + s)); bfr[s] = *(const bf16x8*)(wb + 32 * (8 * sb + s)); }
#pragma unroll
            for (int s = 0; s < 8; ++s) acc = __builtin_amdgcn_mfma_f32_16x16x32_bf16(af[s], bfr[s], acc, 0, 0, 0); }
#pragma unroll
        for (int r = 0; r < 4; ++r) { const float lo = __shfl_down(acc[r], 8, 16); if (r16 < 8) slg[(4 * kq + r) * 9 + r16] = acc[r] + lo; }
        LDS_WAIT();
        if (lane < 16) { const int tok = tok0 + lane;
            const float ssum = (SS[SS1_IDX(tok, 0)] + SS[SS1_IDX(tok, 1)]) + (SS[SS1_IDX(tok, 2)] + SS[SS1_IDX(tok, 3)]);
            const float rstd = 1.0f / sqrtf(ssum * (1.0f / D) + EPS);
            float lg[8];
#pragma unroll
            for (int e = 0; e < 8; ++e) lg[e] = fmaf(slg[lane * 9 + e], rstd, br[e]);
            int i0 = 0; float v0 = lg[0];
#pragma unroll
            for (int e = 1; e < 8; ++e) if (lg[e] > v0) { v0 = lg[e]; i0 = e; }
            int i1 = -1; float v1 = -3.0e38f;
#pragma unroll
            for (int e = 0; e < 8; ++e) if (e != i0 && lg[e] > v1) { v1 = lg[e]; i1 = e; }
            const float e1 = __expf(v1 - v0), w0 = 1.0f / (1.0f + e1), w1 = e1 * w0;
            const unsigned pe = (unsigned)i0 | ((unsigned)i1 << 8); TOKE[tok] = pe; TOKW0[tok] = w0; TOKW1[tok] = w1; TOKR[tok] = rstd; se[wid * 16 + lane] = pe; }
        __syncthreads();
        if (tid < 16) { int c = 0; const unsigned e = (unsigned)(tid & 7), sh = (tid >> 3) * 8;
            for (int t = 0; t < 128; ++t) c += (((se[t] >> sh) & 0xffu) == e) ? 1 : 0;
            CNT[tile * 16 + tid] = c; }
        __syncthreads();
    }
}
__device__ __forceinline__ void gather_phase(LAS unsigned char* lds, const bf16_t* X, const unsigned* TOKE, const float* TOKW0, const float* TOKW1, const float* TOKR, const int* CNT,
                                             int* TOKLIST, unsigned* SLOTP, int blk, int nblk) {
    const int tid = threadIdx.x, lane = tid & 63, wid = tid >> 6;
    LAS int* s_tot = (LAS int*)lds;
    LAS int* s_bef = s_tot + 16;
    LAS int* s_start = s_bef + 16;
    LAS unsigned* s_e = (LAS unsigned*)(s_start + 32);
    LAS int* s_slot = (LAS int*)(s_e + 128);
    for (int tile = blk; tile < T / 128; tile += nblk) {
        if (tid < 32) s_tot[tid] = 0;
        __syncthreads();
        { int tot = 0, bef = 0;
#pragma unroll
          for (int k = 0; k < 8; ++k) { const int t = (tid >> 4) + 32 * k; const int c = CNT[t * 16 + (tid & 15)]; tot += c; bef += (t < tile) ? c : 0; }
          atomicAdd((int*)(s_tot + (tid & 15)), tot); atomicAdd((int*)(s_bef + (tid & 15)), bef); }
        if (tid >= 64 && tid < 192) s_e[tid - 64] = TOKE[tile * 128 + tid - 64];
        __syncthreads();
        if (tid == 0) { int s = 0; for (int g = 0; g < 16; ++g) { s_start[g] = s; s += (s_tot[g] + 255) & ~255; } s_start[16] = s; }
        __syncthreads();
        if (tile == 0) {
            for (int g = 0; g < 16; ++g) { const int lo = s_start[g] + s_tot[g], hi = s_start[g + 1]; for (int s = lo + tid; s < hi; s += 512) { TOKLIST[s] = -1; SLOTP[s] = 0u; } }
        }
        if (tid < 128) { const unsigned me = s_e[tid]; const unsigned e0 = me & 0xffu, e1 = (me >> 8) & 0xffu; int r0 = 0, r1 = 0;
            for (int t = 0; t < tid; ++t) { const unsigned o = s_e[t]; r0 += ((o & 0xffu) == e0) ? 1 : 0; r1 += (((o >> 8) & 0xffu) == e1) ? 1 : 0; }
            const int tok = tile * 128 + tid;
            const int sl0 = s_start[e0] + s_bef[e0] + r0, sl1 = s_start[8 + e1] + s_bef[8 + e1] + r1;
            const float rs = TOKR[tok];
            TOKLIST[sl0] = tok; SLOTP[sl0] = pack_h2(rs, rs * TOKW0[tok]); TOKLIST[sl1] = tok; SLOTP[sl1] = pack_h2(rs, rs * TOKW1[tok]); }
        __syncthreads();
    }
}
__device__ __forceinline__ void moe_table(LAS int* tstart, const int* CNT) {
    const int tid = threadIdx.x;
    LAS int* s_tot = tstart + 32;
    if (tid < 16) s_tot[tid] = 0;
    __syncthreads();
    { int tot = 0;
#pragma unroll
      for (int k = 0; k < 8; ++k) tot += CNT[((tid >> 4) + 32 * k) * 16 + (tid & 15)];
      atomicAdd((int*)(s_tot + (tid & 15)), tot); }
    __syncthreads();
    if (tid == 0) { int s = 0; for (int g = 0; g < 16; ++g) { tstart[g] = s; s += (s_tot[g] + 255) >> 8; } tstart[16] = s; }
    __syncthreads();
}
template <bool HALVES> struct OrdMoeT : pg8::OrderHalf {
    const LAS int* tstart; int g_lo; unsigned bexp, btile; const int* toklist;
    __device__ __forceinline__ void setup(const LAS int* ts, int glo, int ng, int nN_, int G_, int c_, unsigned bexp_, unsigned btile_) {
        tstart = ts; g_lo = glo; bexp = bexp_; btile = btile_; init(ts[glo + ng] - ts[glo], nN_, G_, c_); }
    __device__ __forceinline__ bool next(int i, Unit& u) const {
        int pm, pn, half = 0; if (HALVES ? !tileh(i, pm, pn, half) : !tile(i, pm, pn)) return false;
        const int mt = tstart[g_lo] + pm; int g = 0;
#pragma unroll
        for (int k = 1; k < 16; ++k) g += (tstart[k] <= mt) ? 1 : 0;
        u.pm = mt; u.pn = pn; u.rb = mt * 256 + (half == 2 ? 128 : 0); u.half = half; u.aoff = (unsigned)mt * (256u * 2048u) + (half == 2 ? 128u * 2048u : 0u); u.boff = (unsigned)(g & 7) * bexp + (unsigned)pn * btile; return true;
    }
};
__device__ __forceinline__ void final_phase(const bf16_t* __restrict__ X6, float* __restrict__ out, const float* __restrict__ SS, const float* __restrict__ gf, int gwave, int nwaves, int lane) {
    f32x4 g[4];
#pragma unroll
    for (int j = 0; j < 4; ++j) g[j] = *(const f32x4*)(gf + 256 * j + 4 * lane);
    for (int row = 2 * gwave; row < T; row += 2 * nwaves) {
        u32x2 xv[2][4]; float sv[2];
#pragma unroll
        for (int r = 0; r < 2; ++r) {
#pragma unroll
            for (int j = 0; j < 4; ++j) xv[r][j] = *(const u32x2*)(X6 + (size_t)(row + r) * D + 256 * j + 4 * lane);
            sv[r] = (lane < 4) ? SS[SS1_IDX(row + r, lane)] : 0.f; }
#pragma unroll
        for (int r = 0; r < 2; ++r) { const float rs = 1.0f / sqrtf(wave_sum(sv[r]) * (1.0f / D) + EPS);
            float* o = out + (size_t)(row + r) * D + 4 * lane;
#pragma unroll
            for (int j = 0; j < 4; ++j) { const f32x4 v = {bflo(xv[r][j].x), bfhi(xv[r][j].x), bflo(xv[r][j].y), bfhi(xv[r][j].y)};
                __builtin_nontemporal_store(v * rs * g[j], (f32x4*)(o + 256 * j)); } }
    }
}
constexpr size_t MiB = 1u << 20, KiB = 1u << 10;
constexpr size_t WS_BAR = 0, WS_C8G = 32 * KiB, WS_RSTD0 = 64 * KiB, WS_TOKE = 192 * KiB, WS_TOKW0 = 320 * KiB, WS_TOKW1 = 448 * KiB, WS_TOKR = 576 * KiB, WS_CNT = 704 * KiB, WS_TOKLIST = 720 * KiB, WS_SLOTW = 1008 * KiB, WS_SLOTR = 1296 * KiB, WS_WR16 = 1600 * KiB;
constexpr size_t WS_SSA = 2 * MiB, WS_SSB = 4 * MiB, WS_AGGA = 2 * MiB, WS_AGGH = 3 * MiB, WS_CARRY = 4 * MiB;
constexpr size_t WS_W = 6 * MiB;
constexpr size_t W_IN = WS_W, W_GATE = W_IN + 4 * MiB, W_OUT = W_GATE + 1 * MiB, W_FFI = W_OUT + 2 * MiB, W_FFO = W_FFI + 12 * MiB, W_PG0 = W_FFO + 6 * MiB, W_PG1 = W_PG0 + 2 * MiB,
                 W_PP0 = W_PG1 + 2 * MiB, W_PP1 = W_PP0 + MiB / 2, W_QKV = W_PP1 + MiB / 2, W_O = W_QKV + 5 * MiB / 2, W_EI = W_O + 2 * MiB, W_EO = W_EI + 32 * MiB, W_END = W_EO + 16 * MiB;
constexpr size_t SL_A = 92 * MiB, SL_B = 156 * MiB, SL_C = 220 * MiB, SL_D = 284 * MiB, SL_E = 348 * MiB, SL_F = 412 * MiB, SL_G = 476 * MiB, WS_NEED = 512 * MiB;
static_assert(W_END <= SL_A, "weights overlap slots");
static_assert(SL_C + (size_t)XG_ROWS * 2048 <= SL_E + 8 * MiB && SL_E + 8 * MiB + (size_t)XG_ROWS * 2048 <= WS_NEED, "moe buffers");
constexpr size_t WS_XG = SL_C, WS_HEXP = SL_E + 8 * MiB;
constexpr int LDS_BYTES = 163840;
constexpr int LDS_MISC = 131072;
constexpr int NPHASE = 20;

struct Args { const void* in[29]; float* out; unsigned char* ws; int ph_lo, ph_hi; };

struct OrdGates : pg8::OrderBase {
    __device__ __forceinline__ bool next(int i, Unit& u) const { if (!tile(i, u.pm, u.pn)) return false; u.aoff = (unsigned)u.pm * (256u * 2048u) + (unsigned)(u.pn >> 1) * 512u; u.boff = (unsigned)u.pn * (256u * 512u); u.rb = u.pm * 256; u.half = 0; return true; }
};

struct OrdGatesT { int c;
    __device__ __forceinline__ bool next(int i, Unit& u) const { if (i >= 4) return false; const int x = c & 7, yv = c >> 3, b = (yv >> 4) * 2 + (x >> 2), h = x & 3, half = (yv >> 3) & 1, j = yv & 7;
        u.pn = 2 * h + half; u.pm = b * 32 + 8 * i + j; u.rb = u.pm * 256; u.half = 0; u.aoff = (unsigned)u.pm * (256u * 2048u) + (unsigned)h * 512u; u.boff = (unsigned)u.pn * (256u * 512u); return true; }
};
__device__ __forceinline__ bool get_job(const Args& a, int j, TJob& J) {
    unsigned char* ws = a.ws;
    const float* g_mix = (const float*)a.in[3]; const float* g_ffn = (const float*)a.in[4]; const float* g_ple = (const float*)a.in[5];
    J.gain = nullptr; J.map = 0; J.p0 = 0; J.p1 = 0;
    if (j == 0) { J.W = (const float*)a.in[8]; J.K = 1024; J.N = 2048; J.gain = g_mix; J.dst = (bf16_t*)(ws + W_IN); J.dpitch = 1024; return true; }
    if (j == 1) { J.W = (const float*)a.in[16]; J.K = 1024; J.N = 1024; J.dst = (bf16_t*)(ws + W_OUT); J.dpitch = 1024; return true; }
    if (j == 2) { J.W = (const float*)a.in[22]; J.K = 1024; J.N = 6144; J.gain = g_ffn; J.dst = (bf16_t*)(ws + W_FFI); J.dpitch = 1024; J.map = 1; J.p0 = 3072; return true; }
    if (j == 3) { J.W = (const float*)a.in[23]; J.K = 3072; J.N = 1024; J.dst = (bf16_t*)(ws + W_FFO); J.dpitch = 3072; return true; }
    if (j == 4 || j == 5) { const int l = j - 4; J.W = (const float*)a.in[6] + (size_t)l * D * D; J.K = 1024; J.N = 1024; J.gain = g_ple + l * D; J.dst = (bf16_t*)(ws + (l ? W_PG1 : W_PG0)); J.dpitch = 1024; return true; }
    if (j == 6 || j == 7) { const int l = j - 6; J.W = (const float*)a.in[7] + (size_t)l * PLE * D; J.K = 256; J.N = 1024; J.dst = (bf16_t*)(ws + (l ? W_PP1 : W_PP0)); J.dpitch = 256; return true; }
    if (j == 8) { J.W = (const float*)a.in[18]; J.K = 1024; J.N = 256; J.gain = (const float*)a.in[17]; J.dst = (bf16_t*)(ws + W_QKV); J.dpitch = 1024; J.map = 3; J.p0 = 0; J.p1 = 128; return true; }
    if (j == 9) { J.W = (const float*)a.in[19]; J.K = 1024; J.N = 1024; J.gain = g_mix + D; J.dst = (bf16_t*)(ws + W_QKV); J.dpitch = 1024; J.map = 3; J.p0 = 256; J.p1 = 1024; return true; }
    if (j == 10) { J.W = (const float*)a.in[21]; J.K = 1024; J.N = 1024; J.dst = (bf16_t*)(ws + W_O); J.dpitch = 1024; return true; }
    if (j < 19) { const int q = j - 11, gx = q >> 2, h = q & 3;
        J.W = (const float*)a.in[gx ? 13 : 11] + (size_t)h * 65536; J.K = 256; J.N = 256; J.dst = (bf16_t*)(ws + W_GATE); J.dpitch = 256; J.map = 2; J.p0 = 2 * h; J.p1 = gx ? 128 : 0; return true; }
    if (j < 27) { const int e = j - 19; J.W = (const float*)a.in[26] + (size_t)e * D * 2048; J.K = 1024; J.N = 2048; J.gain = g_ffn + D; J.dst = (bf16_t*)(ws + W_EI); J.dpitch = 1024; J.map = 1; J.p0 = 1024; J.p1 = e * 2048; return true; }
    if (j < 35) { const int e = j - 27; J.W = (const float*)a.in[27] + (size_t)e * D * D; J.K = 1024; J.N = 1024; J.dst = (bf16_t*)(ws + W_EO); J.dpitch = 1024; J.p0 = e * 1024; return true; }
    return false;
}

__device__ __forceinline__ void convert_jobs(const Args& args, int jlo, int jhi, int w, int nw, LAS float* scr, int lane) {
    int off = 0; TJob J;
    for (int j = jlo; j < jhi && get_job(args, j, J); ++j) { const int n = (J.K / 64) * (J.N / 32); const int start = (w + nw - off % nw) % nw;
        for (int it = start; it < n; it += nw) transpose_item(J, scr, it, lane);
        off += n; }
}
constexpr int JOB_EI = 19, JOB_EO = 27, JOB_END = 35;

__global__ void __launch_bounds__(512, 2) fwd(Args args) {
    extern __shared__ __attribute__((aligned(16))) unsigned char lds_raw[];
    LAS unsigned char* lds = (LAS unsigned char*)lds_raw;
#define tid ((int)threadIdx.x)
#define lane (tid & 63)
#define wave (__builtin_amdgcn_readfirstlane(tid >> 6))
    const int G = gridDim.x, bx = blockIdx.x;
#define gtid (bx * 512 + tid)
#define gw (bx * 8 + wave)
    const int gthreads = G * 512, NGW = G * 8;
    unsigned char* ws = args.ws;
    const int lo = args.ph_lo, hi = args.ph_hi;
    cg::grid_group grid = cg::this_grid();
#ifndef PHMASK
#define PHMASK 0xFFFFFu
#endif
#define IN(k) ((((PHMASK) >> (k)) & 1u) && lo <= (k) && (k) < hi)
    XcdBarrier xbar; xbar.bar = (unsigned*)(ws + WS_BAR); xbar.x = 0; xbar.st = (volatile LAS unsigned*)(lds + LDS_MISC + 8192);
    if (hi - lo > 1) { if (tid < 4) ((LAS unsigned*)(lds + LDS_MISC + 8192))[tid] = 0u; __syncthreads(); xbar = xcd_barrier_post((unsigned*)(ws + WS_BAR), (volatile LAS unsigned*)(lds + LDS_MISC + 8192)); }
#ifndef REPMASK
#define REPMASK 0u
#endif
#define REPL(k) for (int rep_ = 0; rep_ <= (int)(((REPMASK) >> (k)) & 1u); ++rep_)
#define SEAM(k) do { if (IN(k) && IN((k) + 1)) { if (lo < 0) grid.sync(); else xcd_barrier(xbar); } } while (0)
    const float* x = (const float*)args.in[0]; const float* p = (const float*)args.in[1]; const int* pos = (const int*)args.in[2];
#define X0 ((bf16_t*)(ws + SL_A))
#define P16 ((bf16_t*)(ws + SL_G))
#define GATE ((bf16_t*)(ws + SL_D))
#define XB ((bf16_t*)(ws + SL_E))
#define XC ((bf16_t*)(ws + SL_F))
#define PP1 ((bf16_t*)(ws + SL_A))
#define HL ((bf16_t*)(ws + SL_B))
#define PC ((bf16_t*)(ws + SL_E))
#define Y ((bf16_t*)(ws + SL_E))
#define X1 ((bf16_t*)(ws + SL_C))
#define PP0 ((bf16_t*)(ws + SL_B))
#define HFF ((bf16_t*)(ws + SL_D))
#define X3 ((bf16_t*)(ws + SL_B))
#define KV ((bf16_t*)(ws + SL_G))
#define Q ((bf16_t*)(ws + SL_C))
#define ATT ((bf16_t*)(ws + SL_D))
#define HEXP ((bf16_t*)(ws + WS_HEXP))
#define SSA ((float*)(ws + WS_SSA))
#define SSB ((float*)(ws + WS_SSB))
#define RSTD0 ((float*)(ws + WS_RSTD0))
#define AGGA ((float*)(ws + WS_AGGA))
#define AGGH ((float*)(ws + WS_AGGH))
#define CARRY ((float*)(ws + WS_CARRY))
#define TOKE ((unsigned*)(ws + WS_TOKE))
#define TOKW0 ((float*)(ws + WS_TOKW0))
#define TOKW1 ((float*)(ws + WS_TOKW1))
#define TOKR ((float*)(ws + WS_TOKR))
#define C8G ((float*)(ws + WS_C8G))
#define CNT ((int*)(ws + WS_CNT))
#define TOKLIST ((int*)(ws + WS_TOKLIST))
#define SLOTP ((unsigned*)(ws + WS_SLOTW))
#define WR16 ((bf16_t*)(ws + WS_WR16))
    if (IN(0)) REPL(0) { if (rep_) xcd_barrier(xbar);
        LAS float* scr = (LAS float*)(lds + wave * 16384);
        convert_jobs(args, 0, JOB_EI, gw, NGW, scr, lane);
        if (G != 256) convert_jobs(args, JOB_EI, JOB_END, gw, NGW, scr, lane);
        if (gtid < D * 8) { const int kk = gtid >> 3, e = gtid & 7; const float w = ((const float*)args.in[24])[gtid] * ((const float*)args.in[4])[D + kk];
            const unsigned hi = pk2(w, 0.f) & 0xffffu; const float rem = w - __uint_as_float(hi << 16); WR16[(size_t)e * D + kk] = (bf16_t)hi; WR16[(size_t)(8 + e) * D + kk] = (bf16_t)(pk2(rem, 0.f) & 0xffffu); }
        if (gtid < D) { const float l = -((const float*)args.in[15])[gtid]; C8G[gtid] = -8.0f * LOG2E * (fmaxf(l, 0.f) + log1pf(expf(-fabsf(l)))); }
        for (int m = 4 * gw; m < T; m += 4 * NGW) cvt_rows<4>(x + (size_t)m * D, X0 + (size_t)m * D, RSTD0 + m, lane);
        for (int m = 4 * gw; m < 2 * T / 4; m += 4 * NGW) cvt_rows<4>(p + (size_t)m * D, P16 + (size_t)m * D, nullptr, lane);
    }
    SEAM(0);
    if (IN(1)) REPL(1) { if (rep_) xcd_barrier(xbar);
        Gemm g{(const char*)X0, (const char*)(ws + W_IN), 2048u, 2048u, 128u * 2048u, 1024, 0}; OrdStd S; S.init(T / 256, 8, G, bx); S.atile = 256u * 2048u; S.btile = 256u * 2048u;
        EpiInProj E{GATE, XB, RSTD0}; gemm_phase(lds, g, S, E);
    }
    SEAM(1);
    if (IN(2)) REPL(2) { if (rep_) xcd_barrier(xbar);
        conv_phase(XB, (const float*)args.in[9], (const float*)args.in[10], XC, gtid, gthreads);
    }
    SEAM(2);
    if (IN(3)) {
        Gemm g{(const char*)XC, (const char*)(ws + W_GATE), 2048u, 512u, 4u * 2048u, 256, 1}; OrdGatesT S; S.c = bx;
        EpiGatesF E{XC, (const float*)args.in[12], (const float*)args.in[14], C8G, GATE, Y, AGGA, AGGH, CARRY, &xbar}; gemm_phase(lds, g, S, E);
        convert_jobs(args, JOB_EI + 5, JOB_EO, gw, NGW, (LAS float*)(lds + wave * 16384), lane);
    }
    SEAM(3);
    if (IN(6)) REPL(6) { if (rep_) xcd_barrier(xbar);
#ifndef NO6A
        { Gemm g{(const char*)Y, (const char*)(ws + W_OUT), 2048u, 2048u, 128u * 2048u, 1024, 0}; OrdStd S; S.init(T / 256, 4, G, bx); S.atile = 256u * 2048u; S.btile = 256u * 2048u;
          EpiRes<false> E{X0, X1, SSA, (LAS float*)(lds + LDS_MISC + 1024)}; gemm_phase(lds, g, S, E); }
#endif
#ifndef NO6B
        { Gemm g{(const char*)P16, (const char*)(ws + W_PP0), 512u, 512u, 128u * 512u, 256, 0}; OrdStd S; S.init(T / 256, 4, G, bx); S.atile = 256u * 512u; S.btile = 256u * 512u;
          EpiBf16 E{PP0, D}; gemm_phase(lds, g, S, E); }
#endif
    }
    SEAM(6);
    if (IN(7)) REPL(7) { if (rep_) xcd_barrier(xbar);
        Gemm g{(const char*)X1, (const char*)(ws + W_FFI), 2048u, 2048u, 128u * 2048u, 1024, 0}; OrdStd S; S.init(T / 256, 24, G, bx); S.atile = 256u * 2048u; S.btile = 256u * 2048u;
        EpiSwiglu E{HFF, DFF, SSA, nullptr}; gemm_phase(lds, g, S, E);
#ifdef PROBE_NOEPI
        xcd_barrier(xbar); { EpiNull E0{(float*)(ws + WS_BAR + 16384)}; gemm_phase(lds, g, S, E0); }
#endif

    }
    SEAM(7);
    if (IN(8)) REPL(8) { if (rep_) xcd_barrier(xbar);
        Gemm g{(const char*)HFF, (const char*)(ws + W_FFO), 6144u, 6144u, 128u * 6144u, 3072, 0}; OrdStd S; S.init(T / 256, 4, G, bx); S.atile = 256u * 6144u; S.btile = 256u * 6144u;
        EpiRes<false> E{X1, X1, SSB, (LAS float*)(lds + LDS_MISC + 1024)}; gemm_phase(lds, g, S, E);
    }
    SEAM(8);
    if (IN(9)) REPL(9) { if (rep_) xcd_barrier(xbar);
        Gemm g{(const char*)X1, (const char*)(ws + W_PG0), 2048u, 2048u, 128u * 2048u, 1024, 0}; OrdStd S; S.init(T / 256, 4, G, bx); S.atile = 256u * 2048u; S.btile = 256u * 2048u;
        EpiPle<false> E{X1, PP0, X3, SSB, SSA, (LAS float*)(lds + LDS_MISC + 1024)}; gemm_phase(lds, g, S, E);
    }
    SEAM(9);
    if (IN(10)) REPL(10) { if (rep_) xcd_barrier(xbar);
        Gemm g{(const char*)X3, (const char*)(ws + W_QKV), 2048u, 2048u, 128u * 2048u, 1024, 0}; OrdStd S; S.init(T / 256, 5, G, bx); S.atile = 256u * 2048u; S.btile = 256u * 2048u;
        EpiQkv E{KV, Q, SSA, pos}; gemm_phase(lds, g, S, E);
        if (G == 256 && bx >= 128) convert_jobs(args, JOB_EI, JOB_EI + 5, (bx - 128) * 8 + wave, 128 * 8, (LAS float*)(lds + wave * 16384), lane);
    }
    SEAM(10);
    if (IN(11)) REPL(11) { if (rep_) xcd_barrier(xbar); attn_phase(lds, Q, KV, (const float*)args.in[20], ATT, bx, G); }
    SEAM(11);
    if (IN(12)) REPL(12) { if (rep_) xcd_barrier(xbar);
        Gemm g{(const char*)ATT, (const char*)(ws + W_O), 2048u, 2048u, 128u * 2048u, 1024, 0}; OrdStd S; S.init(T / 256, 4, G, bx); S.atile = 256u * 2048u; S.btile = 256u * 2048u;
        EpiRes<false> E{X3, X3, SSB, (LAS float*)(lds + LDS_MISC + 1024)}; gemm_phase(lds, g, S, E);
    }
    SEAM(12);
    if (IN(13)) REPL(13) { if (rep_) xcd_barrier(xbar); router_phase(lds, X3, SSB, WR16, (const float*)args.in[25], TOKE, TOKW0, TOKW1, TOKR, CNT, bx, G); }
    SEAM(13);
    if (IN(14)) REPL(14) { if (rep_) xcd_barrier(xbar); gather_phase(lds, X3, TOKE, TOKW0, TOKW1, TOKR, CNT, TOKLIST, SLOTP, bx, G); }
    SEAM(14);
    if (IN(15) || IN(16) || IN(17)) moe_table((LAS int*)(lds + LDS_MISC), CNT);
    if (IN(15)) REPL(15) { if (rep_) xcd_barrier(xbar);
        Gemm g{(const char*)X3, (const char*)(ws + W_EI), 2048u, 2048u, 128u * 2048u, 1024, 0}; OrdMoeT<true> S; S.setup((const LAS int*)(lds + LDS_MISC), 0, 16, 8, G, bx, 2048u * 2048u, 256u * 2048u); S.toklist = TOKLIST;
        EpiSwiglu E{HEXP, D, nullptr, SLOTP}; gemm_phase<EpiSwiglu, OrdMoeT<true>, true, true>(lds, g, S, E);
        if (G == 256) { int nidle = G - pg8::last_round_busy(S.nwg, G, true); if (nidle < 32) nidle = G; const int first = G - nidle;
            if (bx >= first) convert_jobs(args, JOB_EO, JOB_END, (bx - first) * 8 + wave, nidle * 8, (LAS float*)(lds + wave * 16384), lane); }
    }
    SEAM(15);
    if (IN(16)) REPL(16) { if (rep_) xcd_barrier(xbar);
        Gemm g{(const char*)HEXP, (const char*)(ws + W_EO), 2048u, 2048u, 128u * 2048u, 1024, 0}; OrdMoeT<true> S; S.setup((const LAS int*)(lds + LDS_MISC), 0, 8, 4, G, bx, 1024u * 2048u, 256u * 2048u); S.toklist = TOKLIST;
        EpiMoeDown E{TOKLIST, X3, nullptr}; gemm_phase<EpiMoeDown, OrdMoeT<true>, false, true>(lds, g, S, E);
        {
          int nidle = G - pg8::last_round_busy(S.nwg, G, true); if (nidle < 32) nidle = G; const int first = G - nidle;
          if (bx >= first) { Gemm g2{(const char*)(P16 + (size_t)T * PLE), (const char*)(ws + W_PP1), 512u, 512u, 128u * 512u, 256, 0}; OrdStd S2; S2.init(T / 512, 4, nidle, bx - first); S2.atile = 256u * 512u; S2.btile = 256u * 512u;
              EpiBf16 E2{PP1, D}; gemm_phase(lds, g2, S2, E2); } }
    }
    SEAM(16);
    if (IN(17)) REPL(17) { if (rep_) xcd_barrier(xbar);
        Gemm g{(const char*)HEXP, (const char*)(ws + W_EO), 2048u, 2048u, 128u * 2048u, 1024, 0}; OrdMoeT<true> S; S.setup((const LAS int*)(lds + LDS_MISC), 8, 8, 4, G, bx, 1024u * 2048u, 256u * 2048u); S.toklist = TOKLIST;
        EpiMoeDown E{TOKLIST, X3, SSA}; gemm_phase<EpiMoeDown, OrdMoeT<true>, false, true>(lds, g, S, E);
        {
          int nidle = G - pg8::last_round_busy(S.nwg, G, true); if (nidle < 32) nidle = G; const int first = G - nidle;
          if (bx >= first) { Gemm g2{(const char*)(P16 + (size_t)T * PLE + (size_t)(T / 2) * PLE), (const char*)(ws + W_PP1), 512u, 512u, 128u * 512u, 256, 0}; OrdStd S2; S2.init(T / 512, 4, nidle, bx - first); S2.atile = 256u * 512u; S2.btile = 256u * 512u;
              EpiBf16 E2{PP1 + (size_t)(T / 2) * D, D}; gemm_phase(lds, g2, S2, E2); } }
    }
    SEAM(17);
    if (IN(18)) REPL(18) { if (rep_) xcd_barrier(xbar);
        Gemm g{(const char*)X3, (const char*)(ws + W_PG1), 2048u, 2048u, 128u * 2048u, 1024, 0}; OrdStd S; S.init(T / 256, 4, G, bx); S.atile = 256u * 2048u; S.btile = 256u * 2048u;
        EpiPle<false, true> E{X3, PP1, PP1, SSA, SSB, (LAS float*)(lds + LDS_MISC + 1024)}; gemm_phase(lds, g, S, E);
    }
    SEAM(18);
    if (IN(19)) final_phase(PP1, args.out, SSB, (const float*)args.in[28], gw, NGW, lane);
#undef IN
#undef tid
#undef lane
#undef wave
#undef gtid
#undef gw
#undef SEAM
}
#ifndef SPLICE
#define SPLICE 0
#endif
#ifndef ONE_LAUNCH
#define ONE_LAUNCH 0
#endif
#if SPLICE
namespace nv {
__global__ void import_k(const bf16_t* __restrict__ src, float* __restrict__ dst, size_t n) {
    const size_t i = (size_t)blockIdx.x * blockDim.x + threadIdx.x; if (i < n) dst[i] = __uint_as_float((unsigned)src[i] << 16);
}
}
using namespace nv;
static inline void ngemm_l(hipStream_t s, const float* A, int lda, const float* B, int ldb, const float* R, int ldr, float* C, int ldc, int M, int N, int K) {
    hipLaunchKernelGGL(ngemm, dim3(N / NBN, M / NBM), dim3(256), 0, s, A, lda, B, ldb, R, ldr, C, ldc, K);
}
static inline int nb(size_t n) { return (int)((n + 255) / 256); }
#endif

extern "C" void kernel_launch(void* const* d_in, const int* in_sizes, int n_in, void* d_out, int out_size, void* d_ws, size_t ws_size, hipStream_t s) {
    static int inited = 0, grid_blocks = 0;
    if (!inited) {
        if (n_in != 29 || ws_size < WS_NEED) { fprintf(stderr, "kernel_launch: unexpected n_in %d / ws_size %zu (need %zu)\n", n_in, ws_size, (size_t)WS_NEED); inited = -1; return; }
        if (hipFuncSetAttribute((const void*)fwd, hipFuncAttributeMaxDynamicSharedMemorySize, LDS_BYTES) != hipSuccess) { fprintf(stderr, "kernel_launch: hipFuncSetAttribute failed\n"); inited = -1; return; }
        int dev = 0, cus = 0, per_cu = 0;
        if (hipGetDevice(&dev) != hipSuccess || hipDeviceGetAttribute(&cus, hipDeviceAttributeMultiprocessorCount, dev) != hipSuccess || cus < 1) { fprintf(stderr, "kernel_launch: device query failed\n"); inited = -1; return; }
        if (hipOccupancyMaxActiveBlocksPerMultiprocessor(&per_cu, (const void*)fwd, 512, LDS_BYTES) != hipSuccess || per_cu < 1) { fprintf(stderr, "kernel_launch: occupancy query reports %d workgroups per CU\n", per_cu); inited = -1; return; }
        grid_blocks = cus;
        if (cus != 256) { fprintf(stderr, "kernel_launch: built for a 256-CU device (got %d CUs)\n", cus); inited = -1; return; }
        inited = 1;
    }
    if (inited < 0) return;
    Args a{};
    for (int i = 0; i < 29; ++i) a.in[i] = d_in[i];
    a.out = (float*)d_out; a.ws = (unsigned char*)d_ws;
    const int grid = grid_blocks;
    (void)hipMemsetAsync((char*)d_ws + WS_BAR, 0, 32 * KiB, s);
#if ONE_LAUNCH
#ifdef PROBE_SPLIT
    { a.ph_lo = 0; a.ph_hi = PROBE_SPLIT + PROBE_REP; void* kargs[] = {&a};
      hipError_t e = hipLaunchCooperativeKernel((const void*)fwd, dim3(grid), dim3(512), kargs, LDS_BYTES, s);
      if (e != hipSuccess) fprintf(stderr, "cooperative launch failed: %s\n", hipGetErrorString(e)); }
    (void)hipMemsetAsync((char*)d_ws + WS_BAR, 0, 32 * KiB, s);
    { a.ph_lo = PROBE_SPLIT; a.ph_hi = NPHASE; void* kargs[] = {&a};
      hipError_t e = hipLaunchCooperativeKernel((const void*)fwd, dim3(grid), dim3(512), kargs, LDS_BYTES, s);
      if (e != hipSuccess) fprintf(stderr, "cooperative launch failed: %s\n", hipGetErrorString(e)); }
#else
    a.ph_lo = 0; a.ph_hi = NPHASE;
    void* kargs[] = {&a};
    hipError_t e = hipLaunchCooperativeKernel((const void*)fwd, dim3(grid), dim3(512), kargs, LDS_BYTES, s);
    if (e != hipSuccess) fprintf(stderr, "cooperative launch failed: %s\n", hipGetErrorString(e));
#endif
#else
    const int last = SPLICE ? SPLICE : NPHASE - 1;
    for (int ph = 0; ph <= last; ++ph) { a.ph_lo = ph; a.ph_hi = ph + 1; hipLaunchKernelGGL(fwd, dim3(grid), dim3(512), LDS_BYTES, s, a); }
#endif
#if SPLICE
    const float* x = (const float*)d_in[0]; const float* p = (const float*)d_in[1]; const int* pos = (const int*)d_in[2];
    const float* g_mix = (const float*)d_in[3]; const float* g_ffn = (const float*)d_in[4]; const float* g_ple = (const float*)d_in[5];
    const float* w_ple_gate = (const float*)d_in[6]; const float* w_ple_proj = (const float*)d_in[7];
    const float* w_lru_in = (const float*)d_in[8]; const float* conv_w = (const float*)d_in[9]; const float* conv_b = (const float*)d_in[10];
    const float* w_ga = (const float*)d_in[11]; const float* b_ga = (const float*)d_in[12]; const float* w_gx = (const float*)d_in[13]; const float* b_gx = (const float*)d_in[14];
    const float* lam = (const float*)d_in[15]; const float* w_lru_out = (const float*)d_in[16]; const float* g_kv = (const float*)d_in[17]; const float* w_kv = (const float*)d_in[18];
    const float* w_q = (const float*)d_in[19]; const float* sinks = (const float*)d_in[20]; const float* w_o = (const float*)d_in[21];
    const float* w_ff_in = (const float*)d_in[22]; const float* w_ff_out = (const float*)d_in[23]; const float* w_router = (const float*)d_in[24]; const float* b_router = (const float*)d_in[25];
    const float* w_exp_in = (const float*)d_in[26]; const float* w_exp_out = (const float*)d_in[27]; const float* g_final = (const float*)d_in[28];
    float* out = (float*)d_out; char* ws = (char*)d_ws;
    float* hf = (float*)(ws); float* xr = (float*)(ws + 96 * MiB); float* kvb = (float*)(ws + 128 * MiB); float* gts = (float*)(ws + 136 * MiB);
    float* big = (float*)(ws + 284 * MiB); float* xn = (float*)(ws + 476 * MiB);
    const int R = SEQ;
    for (int b = 0; b < BATCH; ++b) {
        const float* xb_in = x + (size_t)b * SEQ * D; const int* posb = pos + (size_t)b * SEQ; const size_t boff = (size_t)b * SEQ * D;
        float* h = big; float* xc = big + (size_t)R * 2048; float* rr = xc + (size_t)R * 1024; float* ig = rr + (size_t)R * 1024; float* y = ig + (size_t)R * 1024;
        if (SPLICE == 5) {
            hipLaunchKernelGGL(import_k, dim3(nb((size_t)R * D)), dim3(256), 0, s, (const bf16_t*)(ws + SL_B) + boff, xn, (size_t)R * D);
            ngemm_l(s, xn, D, w_lru_out, D, xb_in, D, xr, D, R, D, D);
        }
        if (SPLICE == 6 || SPLICE == 8) hipLaunchKernelGGL(import_k, dim3(nb((size_t)R * D)), dim3(256), 0, s, (const bf16_t*)(ws + SL_C) + boff, xr, (size_t)R * D);
        if (SPLICE == 9 || SPLICE == 12 || SPLICE == 17) hipLaunchKernelGGL(import_k, dim3(nb((size_t)R * D)), dim3(256), 0, s, (const bf16_t*)(ws + SL_B) + boff, xr, (size_t)R * D);
        if (SPLICE <= 6) {
            hipLaunchKernelGGL(rmsnorm_k, dim3(R / 4), dim3(256), 0, s, xr, g_ffn, xn, R);
            ngemm_l(s, xn, D, w_ff_in, 2 * DFF, nullptr, 0, big, 2 * DFF, R, 2 * DFF, D);
            hipLaunchKernelGGL(swiglu_k, dim3(nb((size_t)R * DFF)), dim3(256), 0, s, big, hf, R, DFF, (const float*)nullptr, 0);
            ngemm_l(s, hf, DFF, w_ff_out, D, xr, D, xr, D, R, D, DFF);
        }
        float* pg = big; float* pp = big + (size_t)R * 1024;
        if (SPLICE <= 8) {
            hipLaunchKernelGGL(rmsnorm_k, dim3(R / 4), dim3(256), 0, s, xr, g_ple, xn, R);
            ngemm_l(s, xn, D, w_ple_gate, D, nullptr, 0, pg, D, R, D, D);
            ngemm_l(s, p + (size_t)b * SEQ * PLE, PLE, w_ple_proj, D, nullptr, 0, pp, D, R, D, PLE);
            hipLaunchKernelGGL(ple_k, dim3(nb((size_t)R * 1024)), dim3(256), 0, s, xr, pg, pp, R);
        }
        float* q = big; float* at = big + (size_t)R * 1024;
        if (SPLICE <= 9) {
            hipLaunchKernelGGL(rmsnorm_k, dim3(R / 4), dim3(256), 0, s, xr, g_kv, xn, R);
            ngemm_l(s, xn, D, w_kv, 256, nullptr, 0, kvb, 256, R, 256, D);
            hipLaunchKernelGGL(rope_k, dim3(nb((size_t)R * 2 * 8)), dim3(256), 0, s, kvb, 256, 2, posb, R);
            hipLaunchKernelGGL(rmsnorm_k, dim3(R / 4), dim3(256), 0, s, xr, g_mix + D, xn, R);
            ngemm_l(s, xn, D, w_q, D, nullptr, 0, q, D, R, D, D);
            hipLaunchKernelGGL(rope_k, dim3(nb((size_t)R * 16 * 8)), dim3(256), 0, s, q, 1024, 16, posb, R);
            hipLaunchKernelGGL(attn_k, dim3(R * 16 / 4), dim3(256), 0, s, q, kvb, sinks, at, R);
            ngemm_l(s, at, D, w_o, D, xr, D, xr, D, R, D, D);
        }
        if (SPLICE <= 12) {
            hipLaunchKernelGGL(rmsnorm_k, dim3(R / 4), dim3(256), 0, s, xr, g_ffn + D, xn, R);
            hipLaunchKernelGGL(router_k, dim3(R / 4), dim3(256), 0, s, xn, w_router, b_router, gts, R);
            for (int e = 0; e < NE; ++e) {
                ngemm_l(s, xn, D, w_exp_in + (size_t)e * D * 2048, 2048, nullptr, 0, big, 2048, R, 2048, D);
                hipLaunchKernelGGL(swiglu_k, dim3(nb((size_t)R * 1024)), dim3(256), 0, s, big, hf, R, 1024, gts, e);
                ngemm_l(s, hf, D, w_exp_out + (size_t)e * D * D, D, xr, D, xr, D, R, D, D);
            }
        }
        if (SPLICE <= 17) {
            hipLaunchKernelGGL(rmsnorm_k, dim3(R / 4), dim3(256), 0, s, xr, g_ple + D, xn, R);
            ngemm_l(s, xn, D, w_ple_gate + (size_t)D * D, D, nullptr, 0, pg, D, R, D, D);
            ngemm_l(s, p + (size_t)(BATCH + b) * SEQ * PLE, PLE, w_ple_proj + (size_t)PLE * D, D, nullptr, 0, pp, D, R, D, PLE);
            hipLaunchKernelGGL(ple_k, dim3(nb((size_t)R * 1024)), dim3(256), 0, s, xr, pg, pp, R);
            hipLaunchKernelGGL(rmsnorm_k, dim3(R / 4), dim3(256), 0, s, xr, g_final, out + boff, R);
        }
        if (SPLICE == 18) hipLaunchKernelGGL(rmsnorm_k, dim3(R / 4), dim3(256), 0, s, out + boff, g_final, out + boff, R);
        (void)w_lru_in; (void)conv_w; (void)conv_b; (void)w_ga; (void)b_ga; (void)w_gx; (void)b_gx; (void)lam; (void)g_mix; (void)h; (void)y;
    }
#endif
}
```

```cpp
#include <hip/hip_runtime.h>
#include <hip/hip_cooperative_groups.h>
#include <cstdio>
#include <cstdint>
namespace cg = cooperative_groups;

#define LAS __attribute__((address_space(3)))
typedef unsigned short bf16_t;
typedef short bf16x8 __attribute__((ext_vector_type(8)));
typedef short s16x4 __attribute__((ext_vector_type(4)));
typedef float f32x4 __attribute__((ext_vector_type(4)));
typedef float f32x2 __attribute__((ext_vector_type(2)));
typedef float f32x16 __attribute__((ext_vector_type(16)));
typedef unsigned u32x4 __attribute__((ext_vector_type(4)));
typedef unsigned u32x2 __attribute__((ext_vector_type(2)));
typedef __bf16 bf16x2_t __attribute__((ext_vector_type(2)));

constexpr int D = 1024, BATCH = 4, SEQ = 8192, T = BATCH * SEQ, DFF = 3072, NE = 8, PLE = 256;
constexpr float EPS = 1e-6f;
constexpr float LOG2E = 1.4426950408889634f;
constexpr int XG_ROWS = 2 * T + 16 * 256;

__device__ __forceinline__ unsigned pk2(float lo, float hi) { f32x2 v = {lo, hi}; bf16x2_t b = __builtin_convertvector(v, bf16x2_t); return __builtin_bit_cast(unsigned, b); }
__device__ __forceinline__ float bflo(unsigned u) { return __uint_as_float(u << 16); }
__device__ __forceinline__ float bfhi(unsigned u) { return __uint_as_float(u & 0xffff0000u); }
__device__ __forceinline__ float amul(float a, float b) { float r; asm("v_mul_f32_e32 %0, %1, %2" : "=v"(r) : "v"(a), "v"(b)); return r; }
__device__ __forceinline__ float aadd(float a, float b) { float r; asm("v_add_f32_e32 %0, %1, %2" : "=v"(r) : "v"(a), "v"(b)); return r; }
__device__ __forceinline__ float asub(float a, float b) { float r; asm("v_sub_f32_e32 %0, %1, %2" : "=v"(r) : "v"(a), "v"(b)); return r; }
__device__ __forceinline__ float afma(float a, float b, float c) { float r; asm("v_fma_f32 %0, %1, %2, %3" : "=v"(r) : "v"(a), "v"(b), "v"(c)); return r; }
__device__ __forceinline__ void swiglu2(float g0, float u0, float g1, float u1, float n, float c, float& o0, float& o1) {
    float t0, t1, p0, p1;
    asm("v_mul_f32_e32 %0, %4, %8\n\tv_mul_f32_e32 %1, %6, %8\n\tv_exp_f32_e32 %0, %0\n\tv_exp_f32_e32 %1, %1\n\tv_mul_f32_e32 %2, %4, %5\n\t"
        "v_fma_f32 %0, %0, %9, %9\n\tv_fma_f32 %1, %1, %9, %9\n\tv_rcp_f32_e32 %0, %0\n\tv_rcp_f32_e32 %1, %1\n\tv_mul_f32_e32 %3, %6, %7\n\t"
        "v_mul_f32_e32 %0, %2, %0\n\tv_mul_f32_e32 %1, %3, %1"
        : "=&v"(t0), "=&v"(t1), "=&v"(p0), "=&v"(p1) : "v"(g0), "v"(u0), "v"(g1), "v"(u1), "v"(n), "v"(c));
    o0 = t0; o1 = t1;
}
__device__ __forceinline__ void plesig2(float a0, float a1, float n, float p0, float p1, float x0, float x1, float& o0, float& o1) {
    float t0, t1;
    asm("v_mul_f32_e32 %0, %2, %4\n\tv_mul_f32_e32 %1, %3, %4\n\tv_exp_f32_e32 %0, %0\n\tv_exp_f32_e32 %1, %1\n\ts_nop 0\n\tv_add_f32_e32 %0, 1.0, %0\n\tv_add_f32_e32 %1, 1.0, %1\n\t"
        "v_rcp_f32_e32 %0, %0\n\tv_rcp_f32_e32 %1, %1\n\ts_nop 0\n\tv_fma_f32 %0, %0, %5, %7\n\tv_fma_f32 %1, %1, %6, %8"
        : "=&v"(t0), "=&v"(t1) : "v"(a0), "v"(a1), "v"(n), "v"(p0), "v"(p1), "v"(x0), "v"(x1));
    o0 = t0; o1 = t1;
}
__device__ __forceinline__ void gelu2(float v0, float v1, float k1, float k2, float& o0, float& o1) {
    float t0, t1;
    asm("v_mul_f32_e32 %0, %2, %2\n\tv_mul_f32_e32 %1, %3, %3\n\tv_fma_f32 %0, %0, %5, %4\n\tv_fma_f32 %1, %1, %5, %4\n\tv_mul_f32_e32 %0, %0, %2\n\tv_mul_f32_e32 %1, %1, %3\n\t"
        "v_exp_f32_e32 %0, %0\n\tv_exp_f32_e32 %1, %1\n\ts_nop 0\n\tv_add_f32_e32 %0, 1.0, %0\n\tv_add_f32_e32 %1, 1.0, %1\n\tv_rcp_f32_e32 %0, %0\n\tv_rcp_f32_e32 %1, %1\n\ts_nop 0\n\t"
        "v_mul_f32_e32 %0, %2, %0\n\tv_mul_f32_e32 %1, %3, %1"
        : "=&v"(t0), "=&v"(t1) : "v"(v0), "v"(v1), "v"(k1), "v"(k2));
    o0 = t0; o1 = t1;
}
__device__ __forceinline__ float fsig(float x) { return __builtin_amdgcn_rcpf(1.0f + __builtin_amdgcn_exp2f(-LOG2E * x)); }
__device__ __forceinline__ float wave_sum(float v) {
#pragma unroll
    for (int o = 1; o < 64; o <<= 1) v += __shfl_xor(v, o);
    return v;
}
__device__ __forceinline__ u32x4 pack8(f32x4 a, f32x4 b) { u32x4 w; w.x = pk2(a[0], a[1]); w.y = pk2(a[2], a[3]); w.z = pk2(b[0], b[1]); w.w = pk2(b[2], b[3]); return w; }
__device__ __forceinline__ void unpack8(u32x4 w, f32x4& a, f32x4& b) { a[0] = bflo(w.x); a[1] = bfhi(w.x); a[2] = bflo(w.y); a[3] = bfhi(w.y); b[0] = bflo(w.z); b[1] = bfhi(w.z); b[2] = bflo(w.w); b[3] = bfhi(w.w); }

#ifndef WT_STORES
#define WT_STORES 0
#endif
__device__ __forceinline__ void st16(void* p, u32x4 v) {
#if WT_STORES
    asm volatile("global_store_dwordx4 %0, %1, off sc1\n\ts_nop 1" :: "v"(p), "v"(v) : "memory");
#else
    *(u32x4*)p = v;
#endif
}
__device__ __forceinline__ void st16f(void* p, f32x4 v) { st16(p, __builtin_bit_cast(u32x4, v)); }

typedef _Float16 f16x2_t __attribute__((ext_vector_type(2)));
__device__ __forceinline__ unsigned pack_h2(float a, float b) { f16x2_t v = {(_Float16)a, (_Float16)b}; return __builtin_bit_cast(unsigned, v); }
__device__ __forceinline__ void unpack_h2(unsigned w, float& a, float& b) { const f16x2_t v = __builtin_bit_cast(f16x2_t, w); a = (float)v.x; b = (float)v.y; }
#define SPLICE 0
#define ONE_LAUNCH 1
typedef __attribute__((address_space(1))) unsigned gu32;
#define RLX_AGENT __ATOMIC_RELAXED, __HIP_MEMORY_SCOPE_AGENT
#define XB_TMO      128
#define XB_XCNT(j)  (256  + 64 * (j))
#define XB_XSUB(j)  (1280 + 64 * (j))
#define XB_XGEN(j)  (2304 + 64 * (j))
#define XB_TOP      3328
#define XB_TOPGEN   3392
#define XCD_BAR_WORDS 3456
#define XB_SPIN_CAP (1u << 18)
#ifndef SELF_RESET
#define SELF_RESET 1
#endif
#if SELF_RESET
#define XB_EXIT XCD_BAR_WORDS
__device__ unsigned g_xbar[XCD_BAR_WORDS + 64];
#endif

__device__ __forceinline__ unsigned xb_ld(unsigned* p)              { return __hip_atomic_load(p, __ATOMIC_RELAXED, __HIP_MEMORY_SCOPE_AGENT); }
__device__ __forceinline__ unsigned xb_add(unsigned* p, unsigned v) { return __hip_atomic_fetch_add(p, v, __ATOMIC_RELAXED, __HIP_MEMORY_SCOPE_AGENT); }
__device__ __forceinline__ unsigned xb_xcc_id() { return (unsigned)__builtin_amdgcn_s_getreg((3 << 11) | 20) & 0xFu; }
#define XB_SPIN(cond, bar) do { unsigned _sp = 0; while (cond) { __builtin_amdgcn_s_sleep(1); \
    if ((++_sp & 255u) == 0u) { if (xb_ld(&(bar)[XB_TMO])) break; if (_sp > XB_SPIN_CAP) { atomicAdd(&(bar)[XB_TMO], 1u); break; } } } } while (0)

struct XcdBarrier {
    unsigned* bar; unsigned x;
    volatile LAS unsigned* st;
};

__device__ __forceinline__ XcdBarrier xcd_barrier_post(unsigned* bar, volatile LAS unsigned* st) {
    XcdBarrier b; b.bar = bar; b.x = xb_xcc_id(); b.st = st;
    if (threadIdx.x == 0) (void)xb_add(&bar[XB_XCNT(b.x)], 1u);
    return b;
}
__device__ __forceinline__ void xcd_barrier_complete(unsigned* bar, unsigned x, unsigned& nloc, unsigned& nx) {
    const unsigned G = gridDim.x * gridDim.y * gridDim.z;
    unsigned sum, cnt, mine, sp = 0u;
    for (;;) {
        sum = 0u; cnt = 0u; mine = 0u;
#pragma unroll
        for (unsigned j = 0; j < 16; ++j) { const unsigned c = xb_ld(&bar[XB_XCNT(j)]); sum += c; cnt += (c > 0u) ? 1u : 0u; mine = (j == x) ? c : mine; }
        if (sum == G) break;
        __builtin_amdgcn_s_sleep(1);
        if ((++sp & 255u) == 0u) { if (xb_ld(&bar[XB_TMO])) break; if (sp > XB_SPIN_CAP) { atomicAdd(&bar[XB_TMO], 1u); break; } }
    }
    nloc = mine > 0u ? mine : 1u; nx = cnt > 0u ? cnt : 1u;
}

__device__ __forceinline__ void xcd_barrier(const XcdBarrier& b) {
    asm volatile("s_waitcnt vmcnt(0)" ::: "memory");
    __syncthreads();
    if (threadIdx.x == 0) {
        unsigned* bar = b.bar;
        __builtin_amdgcn_s_waitcnt(0);
        unsigned nloc = b.st[0], nx = b.st[1];
        if (nloc == 0u) { xcd_barrier_complete(bar, b.x, nloc, nx); b.st[0] = nloc; b.st[1] = nx; }
        const unsigned old = xb_add(&bar[XB_XSUB(b.x)], 1u);
        const unsigned gen = old / nloc;
        if (old + 1u == (gen + 1u) * nloc) {
            __builtin_amdgcn_fence(__ATOMIC_RELEASE, "agent");
            asm volatile("s_waitcnt vmcnt(0)" ::: "memory");
            const unsigned og = xb_add(&bar[XB_TOP], 1u);
            const unsigned tg = og / nx;
            __builtin_amdgcn_fence(__ATOMIC_ACQUIRE, "agent");
            if (og + 1u == (tg + 1u) * nx) xb_add(&bar[XB_TOPGEN], 1u);
            else XB_SPIN(xb_ld(&bar[XB_TOPGEN]) == tg, bar);
            xb_add(&bar[XB_XGEN(b.x)], 1u);
            asm volatile("s_waitcnt vmcnt(0)" ::: "memory");
        } else {
            __builtin_amdgcn_fence(__ATOMIC_ACQUIRE, "agent");
            XB_SPIN(xb_ld(&bar[XB_XGEN(b.x)]) == gen, bar);
            asm volatile("s_waitcnt vmcnt(0)" ::: "memory");
        }
    }
    __syncthreads();
}

namespace pg8 {
constexpr int BM = 256, BK = 64, HALF = 128, HTB = HALF * BK * 2, STAGE_BYTES = 8 * HTB, NXCD = 8, WGM = 8;
__host__ __device__ __forceinline__ int lds_byte(int r, int c) { const int st = (r >> 4) * 2 + (c >> 5), rr = r & 15, cc = c & 31, ob = rr * 64 + cc * 2; return st * 1024 + (ob ^ (((ob >> 9) & 1) << 5)); }
__host__ __device__ __forceinline__ void stage_rc(int b, int& R, int& C) { const int st = b / 1024, sb = b % 1024, swz = sb ^ (((sb >> 9) & 1) << 5); R = (st >> 1) * 16 + swz / 64; C = (st & 1) * 32 + (swz % 64) / 2; }
__host__ __device__ __forceinline__ int perm32(int rho) { const int n = rho >> 4, i = rho & 15; return 8 * (i >> 2) + 4 * n + (i & 3); }

struct Unit { unsigned aoff, boff; int pm, pn, rb, half; };
struct Gemm { const char* A; const char* Bt; unsigned lda2, ldb2, hstepA; int K; int aperm; };

struct OrderBase {
    int nM, nN, nwg, G, c;
    __device__ __forceinline__ void init(int nM_, int nN_, int G_, int c_) { nM = nM_; nN = nN_; nwg = nM * nN; G = G_; c = c_; }
    __device__ __forceinline__ bool tile(int i, int& pm, int& pn) const {
        const long L = (long)i * G + c; if (L >= nwg) return false;
        int wgid = (int)L; { const int q = nwg / NXCD, r = nwg % NXCD, xcd = wgid % NXCD, off = wgid / NXCD; wgid = (xcd < r ? xcd * (q + 1) : r * (q + 1) + (xcd - r) * q) + off; }
        const int nig = WGM * nN, gid = wgid / nig, fm = gid * WGM, gsz = (nM - fm) < WGM ? (nM - fm) : WGM;
        pm = fm + ((wgid % nig) % gsz); pn = (wgid % nig) / gsz; return true;
    }
};
struct OrderHalf : OrderBase {
    __device__ __forceinline__ bool tileh(int i, int& pm, int& pn, int& half) const {
        const int nfull = (nwg / G) * G, rem = nwg - nfull; const bool split = rem > 0 && 2 * rem <= G;
        const long L = (long)i * G + c; int t;
        if (L < nfull || !split) { if (L >= nwg) return false; t = (int)L; half = 0; }
        else { const int x = (int)(L - nfull); if (x >= 2 * rem) return false; t = nfull + (x >> 1); half = 1 + (x & 1); }
        int wgid = t; { const int q = nwg / NXCD, r = nwg % NXCD, xcd = wgid % NXCD, off = wgid / NXCD; wgid = (xcd < r ? xcd * (q + 1) : r * (q + 1) + (xcd - r) * q) + off; }
        const int nig = WGM * nN, gid = wgid / nig, fm = gid * WGM, gsz = (nM - fm) < WGM ? (nM - fm) : WGM;
        pm = fm + ((wgid % nig) % gsz); pn = (wgid % nig) / gsz; return true;
    }
};
__device__ __forceinline__ int last_round_busy(int nwg, int G, bool halves) { const int rem = nwg % G; if (rem == 0) return 0; return (halves && 2 * rem <= G) ? 2 * rem : rem; }
struct OrdStd : OrderBase {
    unsigned atile, btile;
    __device__ __forceinline__ bool next(int i, Unit& u) const { if (!tile(i, u.pm, u.pn)) return false; u.aoff = (unsigned)u.pm * atile; u.boff = (unsigned)u.pn * btile; u.rb = u.pm * 256; u.half = 0; return true; }
};
struct OrdStdH : OrderHalf {
    unsigned atile, btile;
    __device__ __forceinline__ bool next(int i, Unit& u) const { if (!tileh(i, u.pm, u.pn, u.half)) return false; u.rb = u.pm * 256 + (u.half == 2 ? 128 : 0); u.aoff = (unsigned)u.pm * atile + (u.half == 2 ? atile / 2 : 0u); u.boff = (unsigned)u.pn * btile; return true; }
};

template <class Epi, class Sched, bool GATHER = false, bool HALFOK = false>
__device__ __forceinline__ void gemm_phase(LAS unsigned char* lds, const Gemm g, const Sched& S, const Epi& E) {
    const int tid = threadIdx.x, wid = __builtin_amdgcn_readfirstlane(tid >> 6), lane = tid & 63, wr = wid >> 2, wc = wid & 3, fr = lane & 15, fq = lane >> 4;
    int nt = g.K / BK; asm volatile("" : "+s"(nt));
    unsigned voffA[2], voffB[2]; int Rrow[2];
#pragma unroll
    for (int i = 0; i < 2; ++i) { int R, C; stage_rc(tid * 16 + i * 8192, R, C); const int Rb = Epi::PERM ? ((R & ~31) + perm32(R & 31)) : R;
        const int Ra = g.aperm ? (8 * ((R & 15) + 16 * (R >> 6)) + ((R >> 4) & 3)) : R;
        voffA[i] = GATHER ? (unsigned)C * 2u : (unsigned)Ra * g.lda2 + (unsigned)C * 2u; voffB[i] = (unsigned)Rb * g.ldb2 + (unsigned)C * 2u; Rrow[i] = R; }
    const size_t kstep = (size_t)(BK * 2);
    const size_t hstepA = g.hstepA, hstepB = (size_t)HALF * g.ldb2;
    const unsigned ldsw = (unsigned)wid * 1024u;
    const int aoff = lds_byte(wr * 64 + fr, fq * 8), boff = lds_byte(wc * 32 + fr, fq * 8);
#define PG8_SA(b, h) (((b) * 2 + (h)) * HTB)
#define PG8_SB(b, h) ((4 + (b) * 2 + (h)) * HTB)
#define PG8_STAGE(bufoff, gbase, voff) do { _Pragma("unroll") for (int _i = 0; _i < 2; ++_i) \
        __builtin_amdgcn_global_load_lds((const unsigned*)((const char*)(gbase) + (voff)[_i]), (LAS unsigned*)(lds + (bufoff) + ldsw + _i * 8192), 16, 0, 0); } while (0)
#define PG8_STAGE_A(bufoff, h, kptr, koff, usenext) do { if constexpr (GATHER) { unsigned vo_[2]; _Pragma("unroll") for (int _i = 0; _i < 2; ++_i) vo_[_i] = (usenext) ? gaN[h][_i] : gaC[h][_i]; \
        PG8_STAGE(bufoff, g.A + (koff), vo_); } else { PG8_STAGE(bufoff, (kptr) + (h) * hstepA, voffA); } } while (0)
#define PG8_LDA(dst, b, h) do { _Pragma("unroll") for (int m = 0; m < 4; ++m) _Pragma("unroll") for (int k = 0; k < 2; ++k) dst[m][k] = *(const LAS bf16x8*)(lds + PG8_SA(b, h) + aoff + m * 2048 + k * 1024); } while (0)
#define PG8_LDB(dst, b, h) do { _Pragma("unroll") for (int n = 0; n < 2; ++n) _Pragma("unroll") for (int k = 0; k < 2; ++k) dst[n][k] = *(const LAS bf16x8*)(lds + PG8_SB(b, h) + boff + n * 2048 + k * 1024); } while (0)
#define PG8_MMA(ai, bj, At, Bt) do { __builtin_amdgcn_s_setprio(1); _Pragma("unroll") for (int m = 0; m < 4; ++m) _Pragma("unroll") for (int n = 0; n < 2; ++n) _Pragma("unroll") for (int k = 0; k < 2; ++k) \
        acc[ai][bj][m][n] = __builtin_amdgcn_mfma_f32_16x16x32_bf16(Bt[n][k], At[m][k], acc[ai][bj][m][n], 0, 0, 0); __builtin_amdgcn_s_setprio(0); } while (0)
#define PG8_WAIT_V(n) asm volatile("s_waitcnt vmcnt(" #n ")" ::: "memory")
#define PG8_WAIT_L(n) asm volatile("s_waitcnt lgkmcnt(" #n ")" ::: "memory")
#define PG8_BAR __builtin_amdgcn_s_barrier()
#define PG8_SCHED __builtin_amdgcn_sched_barrier(0)
    Unit cur, nxt; int ui = 0;
    if (!S.next(0, cur)) return;
    f32x4 acc[2][2][4][2];
#pragma unroll
    for (int a = 0; a < 2; ++a)
#pragma unroll
        for (int b = 0; b < 2; ++b)
#pragma unroll
            for (int m = 0; m < 4; ++m)
#pragma unroll
                for (int n = 0; n < 2; ++n) acc[a][b][m][n] = (f32x4){0.f, 0.f, 0.f, 0.f};
    bf16x8 At[4][2], B0[2][2], B1[2][2];
    LAS unsigned* pbuf = (LAS unsigned*)(lds + 147456 + wid * 2048);
    typename Epi::Pre pre; E.prefetch(cur, wr, wc, fr, fq, pre, pbuf);
    const char* cA = g.A + cur.aoff; const char* cB = g.Bt + cur.boff;
    unsigned gaC[2][2], gaN[2][2];
    if constexpr (GATHER) {
#pragma unroll
        for (int h = 0; h < 2; ++h)
#pragma unroll
            for (int i = 0; i < 2; ++i) { const int tk = (HALFOK && cur.half && h == 1) ? 0 : S.toklist[cur.rb + h * 128 + Rrow[i]]; gaC[h][i] = (unsigned)(tk < 0 ? 0 : tk) * g.lda2 + voffA[i]; gaN[h][i] = gaC[h][i]; } }
    PG8_STAGE(PG8_SB(0, 0), cB, voffB); PG8_STAGE(PG8_SB(0, 1), cB + hstepB, voffB); PG8_STAGE_A(PG8_SA(0, 0), 0, cA, 0, false); PG8_STAGE_A(PG8_SA(0, 1), 1, cA, 0, false);
    if (wr == 1) PG8_BAR;
    PG8_WAIT_V(2); PG8_BAR;
    PG8_STAGE(PG8_SB(1, 0), cB + kstep, voffB); PG8_STAGE_A(PG8_SA(1, 0), 0, cA + kstep, kstep, false); PG8_STAGE(PG8_SB(1, 1), cB + hstepB + kstep, voffB);
    PG8_WAIT_V(6); PG8_BAR;
    for (;;) {
        const bool fullu = cur.half == 0;
        const bool has_next = S.next(ui + 1, nxt);
        const char* nA = has_next ? g.A + nxt.aoff : cA; const char* nB = has_next ? g.Bt + nxt.boff : cB;
        if constexpr (GATHER) { if (has_next) {
#pragma unroll
            for (int h = 0; h < 2; ++h)
#pragma unroll
                for (int i = 0; i < 2; ++i) { const int tk = (HALFOK && nxt.half && h == 1) ? 0 : S.toklist[nxt.rb + h * 128 + Rrow[i]]; gaN[h][i] = (unsigned)(tk < 0 ? 0 : tk) * g.lda2 + voffA[i]; } } }
#pragma unroll 1
        for (int t = 0; t < nt; t += 2) {
            const bool last = (t == nt - 2);
            const char* a1 = cA + (size_t)(t + 1) * kstep;
            const char* a2 = last ? nA : cA + (size_t)(t + 2) * kstep; const char* b2 = last ? nB : cB + (size_t)(t + 2) * kstep;
            const char* a3 = a2 + kstep; const char* b3 = b2 + kstep;
            const size_t k1 = (size_t)(t + 1) * kstep, k2 = last ? 0 : (size_t)(t + 2) * kstep, k3 = k2 + kstep;
            PG8_LDB(B0, 0, 0); PG8_LDB(B1, 0, 1); PG8_SCHED; PG8_LDA(At, 0, 0); PG8_STAGE_A(PG8_SA(1, 1), 1, a1, k1, false);
            PG8_WAIT_V(8); PG8_WAIT_L(0); PG8_BAR; PG8_MMA(0, 0, At, B0); PG8_MMA(0, 1, At, B1); PG8_BAR; PG8_SCHED;
            PG8_LDA(At, 0, 1); PG8_STAGE(PG8_SB(0, 0), b2, voffB); PG8_STAGE(PG8_SB(0, 1), b2 + hstepB, voffB); PG8_STAGE_A(PG8_SA(0, 0), 0, a2, k2, last);
            PG8_WAIT_V(8); PG8_WAIT_L(0); PG8_BAR; if (!HALFOK || fullu) { PG8_MMA(1, 0, At, B0); PG8_MMA(1, 1, At, B1); } PG8_BAR; PG8_SCHED;
            PG8_LDB(B0, 1, 0); PG8_LDB(B1, 1, 1); PG8_SCHED; PG8_LDA(At, 1, 0); PG8_STAGE_A(PG8_SA(0, 1), 1, a2, k2, last);
            PG8_WAIT_V(8); PG8_WAIT_L(0); PG8_BAR; PG8_MMA(0, 0, At, B0); PG8_MMA(0, 1, At, B1); PG8_BAR; PG8_SCHED;
            PG8_LDA(At, 1, 1); PG8_STAGE(PG8_SB(1, 0), b3, voffB); PG8_STAGE(PG8_SB(1, 1), b3 + hstepB, voffB); PG8_STAGE_A(PG8_SA(1, 0), 0, a3, k3, last);
            PG8_WAIT_V(8); PG8_WAIT_L(0); PG8_BAR; if (!HALFOK || fullu) { PG8_MMA(1, 0, At, B0); PG8_MMA(1, 1, At, B1); } PG8_BAR; PG8_SCHED;
        }
        if (wr == 0) PG8_BAR;
        if constexpr (Epi::EARLYPF) {
            typename Epi::Regs rg; E.consume(cur, wr, wc, fr, fq, pbuf, rg);
            asm volatile("s_waitcnt lgkmcnt(0)" ::: "memory");
            if (has_next) E.prefetch(nxt, wr, wc, fr, fq, pre, pbuf);
            E.body(acc, cur, wr, wc, fr, fq, rg);
        } else E(acc, cur, wr, wc, fr, fq, pre, pbuf);
        if (!has_next) break;
#pragma unroll
        for (int a = 0; a < 2; ++a)
#pragma unroll
            for (int b = 0; b < 2; ++b)
#pragma unroll
                for (int m = 0; m < 4; ++m)
#pragma unroll
                    for (int n = 0; n < 2; ++n) acc[a][b][m][n] = (f32x4){0.f, 0.f, 0.f, 0.f};
        cur = nxt; cA = nA; cB = nB; ++ui;
        if constexpr (!Epi::EARLYPF) {
            asm volatile("s_waitcnt lgkmcnt(0)" ::: "memory");
            E.prefetch(cur, wr, wc, fr, fq, pre, pbuf); }
        if constexpr (GATHER) {
#pragma unroll
            for (int h = 0; h < 2; ++h)
#pragma unroll
                for (int i = 0; i < 2; ++i) gaC[h][i] = gaN[h][i]; }
        if (wr == 1) PG8_BAR;
    }
    PG8_WAIT_V(0);
    PG8_BAR;
#undef PG8_SA
#undef PG8_SB
#undef PG8_STAGE
#undef PG8_STAGE_A
#undef PG8_LDA
#undef PG8_LDB
#undef PG8_MMA
#undef PG8_WAIT_V
#undef PG8_WAIT_L
#undef PG8_BAR
#undef PG8_SCHED
}
}
using pg8::Unit; using pg8::Gemm; using pg8::OrdStd; using pg8::gemm_phase;
typedef f32x4 Acc[2][2][4][2];
struct NoPre {};
__device__ __forceinline__ void dma4(const void* gsrc, LAS unsigned* pbuf, int k) { __builtin_amdgcn_global_load_lds((const unsigned*)gsrc, pbuf + k * 64, 4, 0, 0); }
__device__ __forceinline__ LAS unsigned* pbuf2_of(LAS unsigned* pbuf) { const int wid = threadIdx.x >> 6; return pbuf - (147456 / 4 + wid * 512) + ((131072 + 1024) / 4 + wid * 128); }
#define EPI_NOPRE typedef NoPre Pre; __device__ __forceinline__ void prefetch(const Unit&, int, int, int, int, Pre&, LAS unsigned*) const {}
#define EPI_ROW(u, ai, wr, m, fr) ((u).rb + (ai) * 128 + (wr) * 64 + (m) * 16 + (fr))
#define EPI_NA(u) ((u).half ? 1 : 2)

#define SS1_IDX(row, pn) ((size_t)(pn) * T + (size_t)(row))
struct Pre8 { float v[2][4]; };
__device__ __forceinline__ void ss_prefetch(const float* SS, const Unit& u, int wr, int fr, int fq, Pre8& p) {
#pragma unroll
    for (int ai = 0; ai < 2; ++ai)
#pragma unroll
        for (int m = 0; m < 4; ++m) p.v[ai][m] = SS[SS1_IDX(EPI_ROW(u, ai, wr, m, fr), fq)];
}
__device__ __forceinline__ void ss16_prefetch(const float* SS, const Unit& u, int wr, int fr, int fq, Pre8& p) {
#pragma unroll
    for (int ai = 0; ai < 2; ++ai)
#pragma unroll
        for (int m = 0; m < 4; ++m) { const f32x4 v = *(const f32x4*)(SS + (size_t)EPI_ROW(u, ai, wr, m, fr) * 16 + fq * 4); p.v[ai][m] = (v[0] + v[1]) + (v[2] + v[3]); }
}
__device__ __forceinline__ void ss_finish(const Pre8& p, float (&rs)[2][4]) {
#pragma unroll
    for (int ai = 0; ai < 2; ++ai)
#pragma unroll
        for (int m = 0; m < 4; ++m) { float s = p.v[ai][m]; s += __shfl_xor(s, 16); s += __shfl_xor(s, 32); rs[ai][m] = 1.0f / sqrtf(s * (1.0f / D) + EPS); }
}
__device__ __forceinline__ void ss_stage(LAS float* sst, int ai, int wr, int m, int fr, int wc, int fq, float ss) { if (fq == 0) sst[(ai * 128 + wr * 64 + m * 16 + fr) * 4 + wc] = ss; }
__device__ __forceinline__ void ss_flush(LAS float* sst, float* SS, const Unit& u, const int* toklist) {
    asm volatile("s_waitcnt lgkmcnt(0)" ::: "memory"); __syncthreads();
    const int t = threadIdx.x;
    if (t < (u.half ? 128 : 256)) { const f32x4 v = *(const LAS f32x4*)(sst + t * 4); int row = u.rb + t; if (toklist) row = toklist[row];
        if (row >= 0) SS[SS1_IDX(row, u.pn)] = (v[0] + v[1]) + (v[2] + v[3]); }
}
__device__ __forceinline__ float sumsq8(f32x4 a, f32x4 b) { float s0 = amul(a[0], a[0]), s1 = amul(b[0], b[0]);
#pragma unroll
    for (int i = 1; i < 4; ++i) { s0 = afma(a[i], a[i], s0); s1 = afma(b[i], b[i], s1); }
    return aadd(s0, s1); }
__device__ __forceinline__ f32x4 aadd4(f32x4 a, f32x4 b) { f32x4 r; r[0] = aadd(a[0], b[0]); r[1] = aadd(a[1], b[1]); r[2] = aadd(a[2], b[2]); r[3] = aadd(a[3], b[3]); return r; }
__device__ __forceinline__ f32x4 amul4(f32x4 a, float b) { f32x4 r; r[0] = amul(a[0], b); r[1] = amul(a[1], b); r[2] = amul(a[2], b); r[3] = amul(a[3], b); return r; }
__device__ __forceinline__ void put_ss(float* SS, int row, int slot, float ss, int fq) {
    ss += __shfl_xor(ss, 16); ss += __shfl_xor(ss, 32);
    if (fq == 0) SS[(size_t)row * 16 + slot] = ss;
}

struct EpiNull {
    static constexpr bool PERM = true; static constexpr bool EARLYPF = false; EPI_NOPRE
    float* sink;
    __device__ __forceinline__ void operator()(Acc& acc, const Unit& u, int wr, int wc, int fr, int fq, const Pre&, LAS unsigned* pbuf) const {
        float z = 0.f;
#pragma unroll
        for (int ai = 0; ai < 2; ++ai)
#pragma unroll
            for (int bj = 0; bj < 2; ++bj)
#pragma unroll
                for (int m = 0; m < 4; ++m)
#pragma unroll
                    for (int n = 0; n < 2; ++n) z += (acc[ai][bj][m][n][0] + acc[ai][bj][m][n][1]) + (acc[ai][bj][m][n][2] + acc[ai][bj][m][n][3]);
        if (z == 1.2345e-30f) sink[0] = z;
    }
};
struct EpiBf16 {
    static constexpr bool PERM = true; static constexpr bool EARLYPF = false; EPI_NOPRE
    bf16_t* O; int ldc;
    __device__ __forceinline__ void operator()(Acc& acc, const Unit& u, int wr, int wc, int fr, int fq, const Pre&, LAS unsigned* pbuf) const {
        const int col0 = u.pn * 256 + wc * 32 + 8 * fq;
#pragma unroll
        for (int ai = 0; ai < 2; ++ai)
#pragma unroll
            for (int m = 0; m < 4; ++m) { bf16_t* rowp = O + (size_t)EPI_ROW(u, ai, wr, m, fr) * ldc + col0;
#pragma unroll
                for (int bj = 0; bj < 2; ++bj) st16(rowp + bj * 128, pack8(acc[ai][bj][m][0], acc[ai][bj][m][1])); }
    }
};
struct EpiInProj {
    static constexpr bool PERM = true; static constexpr bool EARLYPF = false; typedef NoPre Pre;
    bf16_t* gate; bf16_t* xb; const float* rstd0;
    __device__ __forceinline__ void prefetch(const Unit& u, int wr, int wc, int fr, int fq, Pre&, LAS unsigned* pbuf) const {
#pragma unroll
        for (int ai = 0; ai < 2; ++ai)
#pragma unroll
            for (int m = 0; m < 4; ++m) dma4(rstd0 + EPI_ROW(u, ai, wr, m, fr), pbuf, ai * 4 + m);
    }
    __device__ __forceinline__ void operator()(Acc& acc, const Unit& u, int wr, int wc, int fr, int fq, const Pre&, LAS unsigned* pbuf) const {
        const bool isg = u.pn < 4;
        bf16_t* dst = isg ? gate : xb;
        const int col0 = (u.pn & 3) * 256 + wc * 32 + 8 * fq;
#pragma unroll
        for (int ai = 0; ai < 2; ++ai)
#pragma unroll
            for (int m = 0; m < 4; ++m) { const int row = EPI_ROW(u, ai, wr, m, fr); const float rs = __uint_as_float(pbuf[(ai * 4 + m) * 64 + (threadIdx.x & 63)]); bf16_t* rowp = dst + (size_t)row * D + col0;
#pragma unroll
                for (int bj = 0; bj < 2; ++bj) { f32x4 v0 = amul4(acc[ai][bj][m][0], rs), v1 = amul4(acc[ai][bj][m][1], rs);
                    if (isg) {
#pragma unroll
                        for (int i = 0; i < 4; ++i) {
                            float r0, r1; gelu2(v0[i], v1[i], -2.302208198f, -0.10294324f, r0, r1); v0[i] = r0; v1[i] = r1; }
                    }
                    st16(rowp + bj * 128, pack8(v0, v1)); } }
    }
};
struct EpiGates {
    static constexpr bool PERM = true; static constexpr bool EARLYPF = false; EPI_NOPRE
    const bf16_t* xc; const float* bga; const float* bgx; const float* c8g; bf16_t* hl; bf16_t* pc; float* aggA; float* aggH;
    __device__ __forceinline__ void operator()(Acc& acc, const Unit& u, int wr, int wc, int fr, int fq, const Pre&, LAS unsigned* pbuf) const {
        const int ch0 = (u.pn >> 1) * 256 + (u.pn & 1) * 128 + wc * 32 + 8 * fq;
        const int t0 = u.pm * 256 + 8 * (fr + 16 * wr);
        u32x4 xw[8]; u32x2 hkeep[8], pkeep[8];
        { const bf16_t* xp = xc + (size_t)t0 * D + ch0;
#pragma unroll
          for (int j = 0; j < 8; ++j) xw[j] = *(const u32x4*)(xp + j * D); }
#pragma unroll
        for (int n = 0; n < 2; ++n) { const int ch = ch0 + 4 * n;
            __builtin_amdgcn_sched_barrier(0);
            const f32x4 ba = *(const f32x4*)(bga + ch), bx = *(const f32x4*)(bgx + ch), c8 = *(const f32x4*)(c8g + ch);
            float hp[4], pp[4];
#pragma unroll
            for (int i = 0; i < 4; ++i) { hp[i] = 0.f; pp[i] = 1.f; }
#pragma unroll
            for (int j = 0; j < 8; ++j) { const int ai = j >> 2, m = j & 3; const bool first = ((t0 + j) & (SEQ - 1)) == 0;
                const unsigned xa = n ? xw[j].z : xw[j].x, xb2 = n ? xw[j].w : xw[j].y;
                const float xv[4] = {bflo(xa), bfhi(xa), bflo(xb2), bfhi(xb2)};
#pragma unroll
                for (int i = 0; i < 4; ++i) {
                    const float rr = fsig(acc[ai][0][m][n][i] + ba[i]), ii = fsig(acc[ai][1][m][n][i] + bx[i]);
                    const float a = __builtin_amdgcn_exp2f(c8[i] * rr);
                    const float mult = first ? 1.0f : __builtin_amdgcn_sqrtf(fmaf(-a, a, 1.0f));
                    const float b = mult * ii * xv[i];
                    hp[i] = fmaf(a, hp[i], b); pp[i] *= a;
                    acc[ai][0][m][n][i] = hp[i]; acc[ai][1][m][n][i] = pp[i]; }
                __builtin_amdgcn_sched_barrier(0); }
#pragma unroll
            for (int d = 1; d < 16; d <<= 1)
#pragma unroll
                for (int i = 0; i < 4; ++i) { const float Ao = __shfl_up(pp[i], d, 16), Ho = __shfl_up(hp[i], d, 16);
                    if (fr >= d) { hp[i] = fmaf(pp[i], Ho, hp[i]); pp[i] *= Ao; } }
            float Ae[4], He[4];
#pragma unroll
            for (int i = 0; i < 4; ++i) { const float Ao = __shfl_up(pp[i], 1, 16), Ho = __shfl_up(hp[i], 1, 16); Ae[i] = fr ? Ao : 1.0f; He[i] = fr ? Ho : 0.0f; }
            if (fr == 15) { const int chunk = 2 * u.pm + wr;
                st16f(aggA + (size_t)chunk * D + ch, (f32x4){pp[0], pp[1], pp[2], pp[3]}); st16f(aggH + (size_t)chunk * D + ch, (f32x4){hp[0], hp[1], hp[2], hp[3]}); }
            { bf16_t* hq = hl + (size_t)t0 * D + ch0; bf16_t* pq = pc + (size_t)t0 * D + ch0;
#pragma unroll
              for (int j = 0; j < 8; ++j) { const int ai = j >> 2, m = j & 3; f32x4 hv, pv;
#pragma unroll
                for (int i = 0; i < 4; ++i) { hv[i] = fmaf(acc[ai][1][m][n][i], He[i], acc[ai][0][m][n][i]); pv[i] = acc[ai][1][m][n][i] * Ae[i]; }
                u32x2 hw, pw; hw.x = pk2(hv[0], hv[1]); hw.y = pk2(hv[2], hv[3]); pw.x = pk2(pv[0], pv[1]); pw.y = pk2(pv[2], pv[3]);
                if (n == 0) { hkeep[j] = hw; pkeep[j] = pw; }
                else { st16(hq + j * D, (u32x4){hkeep[j].x, hkeep[j].y, hw.x, hw.y}); st16(pq + j * D, (u32x4){pkeep[j].x, pkeep[j].y, pw.x, pw.y}); } } }
        }
    }
};
struct EpiGatesF {
    static constexpr bool PERM = true; static constexpr bool EARLYPF = false; EPI_NOPRE
    const bf16_t* xc; const float* bga; const float* bgx; const float* c8g; const bf16_t* gate; bf16_t* y; float* aggA; float* aggH; float* rc; const XcdBarrier* xb;
    __device__ __forceinline__ void operator()(Acc& acc, const Unit& u, int wr, int wc, int fr, int fq, const Pre&, LAS unsigned* pbuf) const {
        const int ch0 = (u.pn >> 1) * 256 + (u.pn & 1) * 128 + wc * 32 + 8 * fq;
        const int t0 = u.pm * 256 + 8 * (fr + 16 * wr);
        const int chunk = 2 * u.pm + wr;
        { u32x4 xw[8];
          { const bf16_t* xp = xc + (size_t)t0 * D + ch0;
#pragma unroll
            for (int j = 0; j < 8; ++j) xw[j] = *(const u32x4*)(xp + j * D); }
#pragma unroll
          for (int n = 0; n < 2; ++n) { const int ch = ch0 + 4 * n;
            __builtin_amdgcn_sched_barrier(0);
            const f32x4 ba = *(const f32x4*)(bga + ch), bx = *(const f32x4*)(bgx + ch), c8 = *(const f32x4*)(c8g + ch);
            float hp[4], pp[4];
#pragma unroll
            for (int i = 0; i < 4; ++i) { hp[i] = 0.f; pp[i] = 1.f; }
#pragma unroll
            for (int j = 0; j < 8; ++j) { const int ai = j >> 2, m = j & 3; const bool first = ((t0 + j) & (SEQ - 1)) == 0;
                const unsigned xa = n ? xw[j].z : xw[j].x, xb2 = n ? xw[j].w : xw[j].y;
                const float xv[4] = {bflo(xa), bfhi(xa), bflo(xb2), bfhi(xb2)};
#pragma unroll
                for (int i = 0; i < 4; ++i) {
                    const float rr = fsig(acc[ai][0][m][n][i] + ba[i]), ii = fsig(acc[ai][1][m][n][i] + bx[i]);
                    const float a = __builtin_amdgcn_exp2f(c8[i] * rr);
                    const float mult = first ? 1.0f : __builtin_amdgcn_sqrtf(fmaf(-a, a, 1.0f));
                    const float b = mult * ii * xv[i];
                    hp[i] = fmaf(a, hp[i], b); pp[i] *= a;
                    acc[ai][0][m][n][i] = hp[i]; acc[ai][1][m][n][i] = pp[i]; }
                __builtin_amdgcn_sched_barrier(0); }
#pragma unroll
            for (int d = 1; d < 16; d <<= 1)
#pragma unroll
                for (int i = 0; i < 4; ++i) { const float Ao = __shfl_up(pp[i], d, 16), Ho = __shfl_up(hp[i], d, 16);
                    if (fr >= d) { hp[i] = fmaf(pp[i], Ho, hp[i]); pp[i] *= Ao; } }
            float Ae[4], He[4];
#pragma unroll
            for (int i = 0; i < 4; ++i) { const float Ao = __shfl_up(pp[i], 1, 16), Ho = __shfl_up(hp[i], 1, 16); Ae[i] = fr ? Ao : 1.0f; He[i] = fr ? Ho : 0.0f; }
            if (fr == 15) { st16f(aggA + (size_t)chunk * D + ch, (f32x4){pp[0], pp[1], pp[2], pp[3]}); st16f(aggH + (size_t)chunk * D + ch, (f32x4){hp[0], hp[1], hp[2], hp[3]}); }
#pragma unroll
            for (int j = 0; j < 8; ++j) { const int ai = j >> 2, m = j & 3;
#pragma unroll
                for (int i = 0; i < 4; ++i) { const float P = acc[ai][1][m][n][i]; acc[ai][0][m][n][i] = fmaf(P, He[i], acc[ai][0][m][n][i]); acc[ai][1][m][n][i] = P * Ae[i]; } }
          } }
        xcd_barrier(*xb);
        const int b = u.pm >> 5, tt = u.pm & 31, rnd = tt >> 3, c0 = b * 64 + 16 * rnd;
        f32x4 cr0 = {0.f, 0.f, 0.f, 0.f}, cr1 = {0.f, 0.f, 0.f, 0.f};
        if (rnd > 0) { const float* rp = rc + ((size_t)(b * 4 + rnd)) * D + ch0; cr0 = *(const f32x4*)rp; cr1 = *(const f32x4*)(rp + 4); }
        for (int cc = c0; cc < chunk; ++cc) { const f32x4 a0 = *(const f32x4*)(aggA + (size_t)cc * D + ch0), a1 = *(const f32x4*)(aggA + (size_t)cc * D + ch0 + 4);
            const f32x4 h0 = *(const f32x4*)(aggH + (size_t)cc * D + ch0), h1 = *(const f32x4*)(aggH + (size_t)cc * D + ch0 + 4);
#pragma unroll
            for (int i = 0; i < 4; ++i) { cr0[i] = fmaf(a0[i], cr0[i], h0[i]); cr1[i] = fmaf(a1[i], cr1[i], h1[i]); } }
        if ((tt & 7) == 7 && wr == 1 && rnd < 3 && fr == 0) {
            const f32x4 a0 = *(const f32x4*)(aggA + (size_t)chunk * D + ch0), a1 = *(const f32x4*)(aggA + (size_t)chunk * D + ch0 + 4);
            const f32x4 h0 = *(const f32x4*)(aggH + (size_t)chunk * D + ch0), h1 = *(const f32x4*)(aggH + (size_t)chunk * D + ch0 + 4);
            f32x4 e0, e1;
#pragma unroll
            for (int i = 0; i < 4; ++i) { e0[i] = fmaf(a0[i], cr0[i], h0[i]); e1[i] = fmaf(a1[i], cr1[i], h1[i]); }
            float* rp = rc + ((size_t)(b * 4 + rnd + 1)) * D + ch0; st16f(rp, e0); st16f(rp + 4, e1); }
        { u32x4 gw[8]; const bf16_t* gp = gate + (size_t)t0 * D + ch0;
#pragma unroll
          for (int j = 0; j < 8; ++j) gw[j] = *(const u32x4*)(gp + j * D);
          bf16_t* yp = y + (size_t)t0 * D + ch0;
#pragma unroll
          for (int j = 0; j < 8; ++j) { const int ai = j >> 2, m = j & 3; f32x4 g0, g1, o0, o1; unpack8(gw[j], g0, g1);
#pragma unroll
            for (int i = 0; i < 4; ++i) { o0[i] = fmaf(acc[ai][1][m][0][i], cr0[i], acc[ai][0][m][0][i]) * g0[i]; o1[i] = fmaf(acc[ai][1][m][1][i], cr1[i], acc[ai][0][m][1][i]) * g1[i]; }
            st16(yp + j * D, pack8(o0, o1)); } }
    }
};
template <bool RF32> struct EpiRes {
    static constexpr bool PERM = true; static constexpr bool EARLYPF = false; EPI_NOPRE
    const void* R; bf16_t* X; float* SS; LAS float* sst;
    __device__ __forceinline__ void operator()(Acc& acc, const Unit& u, int wr, int wc, int fr, int fq, const Pre&, LAS unsigned* pbuf) const {
        const int col0 = u.pn * 256 + wc * 32 + 8 * fq;
        if (RF32) {
#pragma unroll
            for (int ai = 0; ai < 2; ++ai) { f32x4 rv[4][2][2];
#pragma unroll
                for (int m = 0; m < 4; ++m)
#pragma unroll
                    for (int bj = 0; bj < 2; ++bj) { const float* rp = (const float*)R + (size_t)EPI_ROW(u, ai, wr, m, fr) * D + col0 + bj * 128; rv[m][bj][0] = *(const f32x4*)rp; rv[m][bj][1] = *(const f32x4*)(rp + 4); }
                __builtin_amdgcn_sched_barrier(0);
#pragma unroll
                for (int m = 0; m < 4; ++m) { const int row = EPI_ROW(u, ai, wr, m, fr); float ss = 0.f;
#pragma unroll
                    for (int bj = 0; bj < 2; ++bj) { const f32x4 v0 = aadd4(acc[ai][bj][m][0], rv[m][bj][0]), v1 = aadd4(acc[ai][bj][m][1], rv[m][bj][1]);
                        ss = aadd(ss, sumsq8(v0, v1)); st16(X + (size_t)row * D + col0 + bj * 128, pack8(v0, v1)); }
                    ss += __shfl_xor(ss, 16); ss += __shfl_xor(ss, 32); ss_stage(sst, ai, wr, m, fr, wc, fq, ss); }
                __builtin_amdgcn_sched_barrier(0); }
        } else {
#pragma unroll
            for (int ai = 0; ai < 2; ++ai) { u32x4 rv[4][2];
#pragma unroll
                for (int m = 0; m < 4; ++m)
#pragma unroll
                    for (int bj = 0; bj < 2; ++bj) rv[m][bj] = *(const u32x4*)((const bf16_t*)R + (size_t)EPI_ROW(u, ai, wr, m, fr) * D + col0 + bj * 128);
                __builtin_amdgcn_sched_barrier(0);
#pragma unroll
                for (int m = 0; m < 4; ++m) { const int row = EPI_ROW(u, ai, wr, m, fr); float ss = 0.f;
#pragma unroll
                    for (int bj = 0; bj < 2; ++bj) { f32x4 r0, r1; unpack8(rv[m][bj], r0, r1);
                        const f32x4 v0 = aadd4(acc[ai][bj][m][0], r0), v1 = aadd4(acc[ai][bj][m][1], r1);
                        ss = aadd(ss, sumsq8(v0, v1)); st16(X + (size_t)row * D + col0 + bj * 128, pack8(v0, v1)); }
                    ss += __shfl_xor(ss, 16); ss += __shfl_xor(ss, 32); ss_stage(sst, ai, wr, m, fr, wc, fq, ss); }
                __builtin_amdgcn_sched_barrier(0); }
        }
        ss_flush(sst, SS, u, nullptr);
    }
};
struct EpiSwiglu {
    static constexpr bool PERM = true; static constexpr bool EARLYPF = true; static constexpr int NVM = 12; typedef NoPre Pre;
    struct Regs { float ns[2][4], ic[2][4]; };
    bf16_t* O; int ldc; const float* SSin; const unsigned* slotp;
    __device__ __forceinline__ void prefetch(const Unit& u, int wr, int wc, int fr, int fq, Pre&, LAS unsigned* pbuf) const {
#pragma unroll
        for (int ai = 0; ai < 2; ++ai)
#pragma unroll
            for (int m = 0; m < 4; ++m) { const int row = EPI_ROW(u, ai, wr, m, fr); dma4(SSin ? (const void*)(SSin + SS1_IDX(row, fq)) : (const void*)(slotp + row), pbuf, ai * 4 + m); }
    }
    __device__ __forceinline__ void consume(const Unit& u, int wr, int wc, int fr, int fq, LAS unsigned* pbuf, Regs& rg) const {
        const int lane = threadIdx.x & 63;
#pragma unroll
        for (int ai = 0; ai < 2; ++ai)
#pragma unroll
            for (int m = 0; m < 4; ++m) { const unsigned w = pbuf[(ai * 4 + m) * 64 + lane];
                if (SSin) { float q = __uint_as_float(w); q += __shfl_xor(q, 16); q += __shfl_xor(q, 32); q = q * (1.0f / D) + EPS; rg.ic[ai][m] = q; rg.ns[ai][m] = -LOG2E * __builtin_amdgcn_rsqf(q); }
                else { float s_, sw_; unpack_h2(w, s_, sw_); rg.ns[ai][m] = -LOG2E * s_; rg.ic[ai][m] = fminf(__builtin_amdgcn_rcpf(s_ * sw_), 1e30f); } }
    }
    __device__ __forceinline__ void body(Acc& acc, const Unit& u, int wr, int wc, int fr, int fq, const Regs& rg) const {
        const int col0 = u.pn * 128 + wc * 32 + 8 * fq;
        const int na = EPI_NA(u);
#pragma unroll
        for (int ai = 0; ai < 2; ++ai) if (ai < na)
#pragma unroll
            for (int m = 0; m < 4; ++m) { const int row = EPI_ROW(u, ai, wr, m, fr); const float n_ = rg.ns[ai][m], c_ = rg.ic[ai][m];
                f32x4 o0, o1;
#pragma unroll
                for (int i = 0; i < 4; ++i) { const float g0 = acc[ai][0][m][0][i], u0 = acc[ai][1][m][0][i], g1 = acc[ai][0][m][1][i], u1 = acc[ai][1][m][1][i];
                    float r0, r1; swiglu2(g0, u0, g1, u1, n_, c_, r0, r1); o0[i] = r0; o1[i] = r1; }
                st16(O + (size_t)row * ldc + col0, pack8(o0, o1)); }
    }
};
template <bool OUTF32, bool IN16 = false> struct EpiPle {
    static constexpr bool PERM = true; static constexpr bool EARLYPF = false; typedef Pre8 Pre;
    const bf16_t* X; const bf16_t* PP; void* O; const float* SSin; float* SSout; LAS float* sst;
    __device__ __forceinline__ void prefetch(const Unit& u, int wr, int wc, int fr, int fq, Pre& p, LAS unsigned* pbuf) const { if (IN16) ss16_prefetch(SSin, u, wr, fr, fq, p); else ss_prefetch(SSin, u, wr, fr, fq, p); }
    __device__ __forceinline__ void operator()(Acc& acc, const Unit& u, int wr, int wc, int fr, int fq, const Pre& pre, LAS unsigned* pbuf) const {
        const int col0 = u.pn * 256 + wc * 32 + 8 * fq;
        float rs[2][4]; ss_finish(pre, rs);
#pragma unroll
        for (int ai = 0; ai < 2; ++ai)
#pragma unroll
            for (int mh = 0; mh < 2; ++mh) { u32x4 xv[2][2], pv[2][2];
#pragma unroll
                for (int ml = 0; ml < 2; ++ml)
#pragma unroll
                    for (int bj = 0; bj < 2; ++bj) { const size_t off = (size_t)EPI_ROW(u, ai, wr, 2 * mh + ml, fr) * D + col0 + bj * 128; xv[ml][bj] = *(const u32x4*)(X + off); pv[ml][bj] = *(const u32x4*)(PP + off); }
                __builtin_amdgcn_sched_barrier(0);
#pragma unroll
                for (int ml = 0; ml < 2; ++ml) { const int m = 2 * mh + ml; const int row = EPI_ROW(u, ai, wr, m, fr); const float s = -LOG2E * rs[ai][m]; float ss = 0.f;
#pragma unroll
                    for (int bj = 0; bj < 2; ++bj) { const size_t off = (size_t)row * D + col0 + bj * 128; f32x4 x0, x1, p0, p1;
                        unpack8(xv[ml][bj], x0, x1); unpack8(pv[ml][bj], p0, p1);
                        f32x4 v0, v1;
#pragma unroll
                        for (int i = 0; i < 4; ++i) {
                            float r0, r1; plesig2(acc[ai][bj][m][0][i], acc[ai][bj][m][1][i], s, p0[i], p1[i], x0[i], x1[i], r0, r1); v0[i] = r0; v1[i] = r1; }
                        ss = aadd(ss, sumsq8(v0, v1));
                        if (OUTF32) { st16f((float*)O + off, v0); st16f((float*)O + off + 4, v1); }
                        else st16((bf16_t*)O + off, pack8(v0, v1)); }
                    ss += __shfl_xor(ss, 16); ss += __shfl_xor(ss, 32); ss_stage(sst, ai, wr, m, fr, wc, fq, ss); }
                __builtin_amdgcn_sched_barrier(0); }
        ss_flush(sst, SSout, u, nullptr);
    }
};
struct EpiQkv {
    static constexpr bool PERM = true; static constexpr bool EARLYPF = false;
    typedef NoPre Pre;
    bf16_t* KV; bf16_t* Q; const float* SSin; const int* pos;
    __device__ __forceinline__ void prefetch(const Unit& u, int wr, int wc, int fr, int fq, Pre& p, LAS unsigned* pbuf) const {
#pragma unroll
        for (int ai = 0; ai < 2; ++ai)
#pragma unroll
            for (int m = 0; m < 4; ++m) { const int row = EPI_ROW(u, ai, wr, m, fr); dma4(SSin + SS1_IDX(row, fq), pbuf, ai * 4 + m); }
        LAS unsigned* p2 = pbuf2_of(pbuf);
#pragma unroll
        for (int h = 0; h < 2; ++h) dma4(pos + EPI_ROW(u, h, wr, fq, fr), p2, h);
    }
    __device__ __forceinline__ void operator()(Acc& acc, const Unit& u, int wr, int wc, int fr, int fq, const Pre& pre, LAS unsigned* pbuf) const {
        float rs[2][4]; int ps[2][4];
        const int lane = threadIdx.x & 63; LAS unsigned* p2 = pbuf2_of(pbuf);
#pragma unroll
        for (int ai = 0; ai < 2; ++ai)
#pragma unroll
            for (int m = 0; m < 4; ++m) { float s = __uint_as_float(pbuf[(ai * 4 + m) * 64 + lane]); s += __shfl_xor(s, 16); s += __shfl_xor(s, 32); rs[ai][m] = 1.0f / sqrtf(s * (1.0f / D) + EPS); ps[ai][m] = (int)p2[ai * 64 + m * 16 + fr]; }
        const bool isq = u.pn >= 1;
        const bool rot_lane = ((wc & 1) == 0) && (fq < 2);
        const float QS = 0.125f * LOG2E;
        const int na = EPI_NA(u);
#pragma unroll
        for (int ai = 0; ai < 2; ++ai) if (ai < na)
#pragma unroll
            for (int m = 0; m < 4; ++m) { const int row = EPI_ROW(u, ai, wr, m, fr); const float s = rs[ai][m];
                float cs[4], sn[4];
                if (rot_lane) { const float p = (float)ps[ai][m];
#pragma unroll
                    for (int i = 0; i < 4; ++i) { const int f = 4 * fq + i;
                        const float fr2pi = f == 0 ? 0.15915494309189535f : f == 1 ? 0.03086376340470123f : f == 2 ? 0.005985185712713705f : f == 3 ? 0.001160663641240061f
                                          : f == 4 ? 0.00022507907903927653f : f == 5 ? 4.364795279280289e-05f : f == 6 ? 8.464330808241401e-06f : 1.6414262627950345e-06f;
                        float rev = p * fr2pi; rev -= floorf(rev);
                        sn[i] = __builtin_amdgcn_sinf(rev); cs[i] = __builtin_amdgcn_cosf(rev); } }
#pragma unroll
                for (int bj = 0; bj < 2; ++bj) { f32x4 v0 = acc[ai][bj][m][0] * s, v1 = acc[ai][bj][m][1] * s;
                    const bool rot = rot_lane && (isq || bj == 0);
                    if (rot) {
#pragma unroll
                        for (int i = 0; i < 4; ++i) { const float t1 = v0[i], t2 = v1[i]; v0[i] = t1 * cs[i] - t2 * sn[i]; v1[i] = t2 * cs[i] + t1 * sn[i]; } }
                    if (isq) { v0 = v0 * QS; v1 = v1 * QS; st16(Q + (size_t)row * D + (u.pn - 1) * 256 + bj * 128 + wc * 32 + 8 * fq, pack8(v0, v1)); }
                    else st16(KV + (size_t)row * 256 + bj * 128 + wc * 32 + 8 * fq, pack8(v0, v1)); } }
    }
};
struct EpiMoeDown {
    static constexpr bool PERM = true; static constexpr bool EARLYPF = false; typedef NoPre Pre;
    const int* toklist; bf16_t* X; float* SS;
    __device__ __forceinline__ void prefetch(const Unit& u, int wr, int wc, int fr, int fq, Pre& p, LAS unsigned* pbuf) const {
        LAS unsigned* p2 = pbuf2_of(pbuf);
#pragma unroll
        for (int h = 0; h < 2; ++h) dma4(toklist + EPI_ROW(u, h, wr, fq, fr), p2, h);
    }
    __device__ __forceinline__ void operator()(Acc& acc, const Unit& u, int wr, int wc, int fr, int fq, const Pre&, LAS unsigned* pbuf) const {
        const int col0 = u.pn * 256 + wc * 32 + 8 * fq;
        int tk[2][4]; LAS unsigned* p2 = pbuf2_of(pbuf);
#pragma unroll
        for (int ai = 0; ai < 2; ++ai)
#pragma unroll
            for (int m = 0; m < 4; ++m) tk[ai][m] = (ai < EPI_NA(u)) ? (int)p2[ai * 64 + m * 16 + fr] : -1;
#pragma unroll
        for (int ai = 0; ai < 2; ++ai) if (ai < EPI_NA(u)) { u32x4 rv[4][2];
#pragma unroll
            for (int m = 0; m < 4; ++m) { const int tok = tk[ai][m] < 0 ? 0 : tk[ai][m];
#pragma unroll
                for (int bj = 0; bj < 2; ++bj) rv[m][bj] = *(const u32x4*)(X + (size_t)tok * D + col0 + bj * 128); }
            __builtin_amdgcn_sched_barrier(0);
#pragma unroll
            for (int m = 0; m < 4; ++m) { const int tok = tk[ai][m]; float ss = 0.f;
#pragma unroll
                for (int bj = 0; bj < 2; ++bj) { f32x4 r0, r1; unpack8(rv[m][bj], r0, r1);
                    const f32x4 v0 = aadd4(acc[ai][bj][m][0], r0), v1 = aadd4(acc[ai][bj][m][1], r1);
                    ss = aadd(ss, sumsq8(v0, v1));
                    if (tok >= 0) st16(X + (size_t)tok * D + col0 + bj * 128, pack8(v0, v1)); }
                if (SS) { ss += __shfl_xor(ss, 16); ss += __shfl_xor(ss, 32); if (fq == 0 && tok >= 0) SS[(size_t)tok * 16 + u.pn * 4 + wc] = ss; } }
            __builtin_amdgcn_sched_barrier(0); }
    }
};
#define LDS_WAIT() asm volatile("s_waitcnt lgkmcnt(0)" ::: "memory")

__device__ __forceinline__ int rope_perm(int d) { return d < 4 ? d : d < 8 ? d + 4 : d < 12 ? d - 4 : d; }
__device__ __forceinline__ int dst_row(int map, int p0, int p1, int n) {
    if (map == 0) return p0 + n;
    if (map == 1) { const int nn = n < p0 ? n : n - p0; return p1 + (nn >> 7) * 256 + (n < p0 ? 0 : 128) + (nn & 127); }
    if (map == 2) return (p0 + (n >> 7)) * 256 + p1 + (n & 127);
    return p0 + (n < p1 ? (n & ~63) + rope_perm(n & 63) : n);
}
struct TJob { const float* W; const float* gain; bf16_t* dst; int K, N, dpitch, map, p0, p1; };
__device__ __forceinline__ void transpose_item(const TJob& J, LAS float* scr, int item, int lane) {
    const int nblk = J.N / 32, kb = item / nblk, nb = item % nblk, k0 = 64 * kb, n0 = 32 * nb;
    f32x4 v[8];
#pragma unroll
    for (int i = 0; i < 8; ++i) v[i] = __builtin_nontemporal_load((const f32x4*)(J.W + (size_t)(k0 + (lane >> 3) + 8 * i) * J.N + n0 + 4 * (lane & 7)));
#pragma unroll
    for (int i = 0; i < 8; ++i) { const int kk = (lane >> 3) + 8 * i; f32x4 w = v[i]; if (J.gain) w = w * J.gain[k0 + kk];
        LAS float* d = scr + kk * 33 + 4 * (lane & 7); d[0] = w[0]; d[1] = w[1]; d[2] = w[2]; d[3] = w[3]; }
    LDS_WAIT(); asm volatile("" ::: "memory");
    const int c = lane & 7;
#pragma unroll
    for (int j = 0; j < 4; ++j) { const int n = (lane >> 3) + 8 * j; const LAS float* s = scr + (8 * c) * 33 + n;
        u32x4 o; o.x = pk2(s[0 * 33], s[1 * 33]); o.y = pk2(s[2 * 33], s[3 * 33]); o.z = pk2(s[4 * 33], s[5 * 33]); o.w = pk2(s[6 * 33], s[7 * 33]);
        st16(J.dst + (size_t)dst_row(J.map, J.p0, J.p1, n0 + n) * J.dpitch + k0 + 8 * c, o); }
    LDS_WAIT(); asm volatile("" ::: "memory");
}
template <int NR> __device__ __forceinline__ void cvt_rows(const float* xrow, bf16_t* orow, float* rstd_out, int lane) {
    f32x4 v[NR][4];
#pragma unroll
    for (int r = 0; r < NR; ++r)
#pragma unroll
        for (int j = 0; j < 4; ++j) v[r][j] = __builtin_nontemporal_load((const f32x4*)(xrow + (size_t)r * D) + lane + 64 * j);
#pragma unroll
    for (int r = 0; r < NR; ++r) { float s = 0.f; u32x2* o = (u32x2*)(orow + (size_t)r * D);
#pragma unroll
        for (int j = 0; j < 4; ++j) { const f32x4 a = v[r][j]; s += (a[0] * a[0] + a[1] * a[1]) + (a[2] * a[2] + a[3] * a[3]); u32x2 w; w.x = pk2(a[0], a[1]); w.y = pk2(a[2], a[3]); o[lane + 64 * j] = w; }
        if (rstd_out) { s = wave_sum(s); if (lane == 0) rstd_out[r] = 1.0f / sqrtf(s * (1.0f / D) + EPS); } }
}

__device__ __forceinline__ void conv_phase(const bf16_t* XB, const float* cw, const float* cb, bf16_t* XC, int gtid, int gthreads) {
    for (int it = gtid; it < (T / 16) * 128; it += gthreads) {
        const int cgp = it & 127, strip = it >> 7, c0 = cgp * 8, t0 = strip * 16;
        float w[4][8], b[8];
#pragma unroll
        for (int k = 0; k < 4; ++k) { const f32x4 a = *(const f32x4*)(cw + k * D + c0), bb = *(const f32x4*)(cw + k * D + c0 + 4);
#pragma unroll
            for (int i = 0; i < 4; ++i) { w[k][i] = a[i]; w[k][4 + i] = bb[i]; } }
        { const f32x4 a = *(const f32x4*)(cb + c0), bb = *(const f32x4*)(cb + c0 + 4);
#pragma unroll
          for (int i = 0; i < 4; ++i) { b[i] = a[i]; b[4 + i] = bb[i]; } }
        const bool seq0 = (t0 & (SEQ - 1)) == 0;
        u32x4 xw[19];
#pragma unroll
        for (int j = 0; j < 19; ++j) { if (j < 3 && seq0) xw[j] = (u32x4){0u, 0u, 0u, 0u}; else xw[j] = *(const u32x4*)(XB + (size_t)(t0 - 3 + j) * D + c0); }
#pragma unroll
        for (int j = 0; j < 16; ++j) {
            f32x4 o0, o1;
#pragma unroll
            for (int i = 0; i < 4; ++i) { o0[i] = b[i]; o1[i] = b[4 + i]; }
#pragma unroll
            for (int k = 0; k < 4; ++k) { f32x4 x0, x1; unpack8(xw[j + 3 - k], x0, x1);
#pragma unroll
                for (int i = 0; i < 4; ++i) { o0[i] = fmaf(w[k][i], x0[i], o0[i]); o1[i] = fmaf(w[k][4 + i], x1[i], o1[i]); } }
            st16(XC + (size_t)(t0 + j) * D + c0, pack8(o0, o1)); }
    }
}
__device__ __forceinline__ void carry_phase(const float* aggA, const float* aggH, float* carry, int gtid, int gthreads) {
    for (int it = gtid; it < BATCH * D; it += gthreads) {
        const int b = it >> 10, c = it & 1023; const size_t base = (size_t)b * 64 * D + c;
        float h = 0.f;
#pragma unroll 8
        for (int k = 0; k < 64; ++k) { carry[base + (size_t)k * D] = h; h = fmaf(aggA[base + (size_t)k * D], h, aggH[base + (size_t)k * D]); }
    }
}
__device__ __forceinline__ void ypass_phase(const bf16_t* HL, const bf16_t* PC, const bf16_t* GATE, const float* carry, bf16_t* Y, int gtid, int gthreads) {
    for (int it = gtid; it < (T / 16) * 128; it += gthreads) {
        const int cgp = it & 127, strip = it >> 7, c0 = cgp * 8, t0 = strip * 16, chunk = t0 >> 7;
        const f32x4 ca = *(const f32x4*)(carry + (size_t)chunk * D + c0), cb2 = *(const f32x4*)(carry + (size_t)chunk * D + c0 + 4);
#pragma unroll 8
        for (int j = 0; j < 16; ++j) { const size_t off = (size_t)(t0 + j) * D + c0;
            f32x4 h0, h1, p0, p1, g0, g1; unpack8(*(const u32x4*)(HL + off), h0, h1); unpack8(*(const u32x4*)(PC + off), p0, p1); unpack8(*(const u32x4*)(GATE + off), g0, g1);
            f32x4 o0, o1;
#pragma unroll
            for (int i = 0; i < 4; ++i) { o0[i] = fmaf(p0[i], ca[i], h0[i]) * g0[i]; o1[i] = fmaf(p1[i], cb2[i], h1[i]) * g1[i]; }
            st16(Y + off, pack8(o0, o1)); }
    }
}
constexpr int ATT_KP = 144, ATT_VP = 520, ATT_KS = 0, ATT_VS = 256 * ATT_KP, ATT_OS = 73728;
__device__ __forceinline__ void attn_phase(LAS unsigned char* lds, const bf16_t* Q, const bf16_t* KV, const float* sinks, bf16_t* O, int blk, int nblk) {
    const int tid = threadIdx.x, lane = tid & 63, wid = __builtin_amdgcn_readfirstlane(tid >> 6), r = lane & 31, hh = lane >> 5;
    for (int unit = blk; unit < BATCH * 64 * 2; unit += nblk) {
        const int kvh = unit & 1, nb = (unit >> 1) & 63, b = unit >> 7;
        const long row0 = (long)b * SEQ + nb * 128;
#pragma unroll
        for (int i = 0; i < 4; ++i) { const int id = tid + 512 * i, key = id >> 3, c = id & 7;
            u32x4 kw = (u32x4){0u, 0u, 0u, 0u}, vw = (u32x4){0u, 0u, 0u, 0u};
            if (nb > 0 || key >= 128) { const bf16_t* src = KV + (size_t)(row0 - 128 + key) * 256 + kvh * 64 + c * 8; kw = *(const u32x4*)src; vw = *(const u32x4*)(src + 128); }
            *(LAS u32x4*)(lds + ATT_KS + key * ATT_KP + c * 16) = kw;
            LAS bf16_t* vt = (LAS bf16_t*)(lds + ATT_VS + (c * 8) * ATT_VP + key * 2);
            vt[0 * (ATT_VP / 2)] = (bf16_t)(vw.x & 0xffffu); vt[1 * (ATT_VP / 2)] = (bf16_t)(vw.x >> 16); vt[2 * (ATT_VP / 2)] = (bf16_t)(vw.y & 0xffffu); vt[3 * (ATT_VP / 2)] = (bf16_t)(vw.y >> 16);
            vt[4 * (ATT_VP / 2)] = (bf16_t)(vw.z & 0xffffu); vt[5 * (ATT_VP / 2)] = (bf16_t)(vw.z >> 16); vt[6 * (ATT_VP / 2)] = (bf16_t)(vw.w & 0xffffu); vt[7 * (ATT_VP / 2)] = (bf16_t)(vw.w >> 16); }
        __syncthreads();
        const int h = kvh * 8 + wid;
        const float sink2 = sinks[h] * LOG2E;
        for (int qs = 0; qs < 4; ++qs) {
            const long qrow = row0 + 32 * qs + r;
            bf16x8 qf[4];
#pragma unroll
            for (int s = 0; s < 4; ++s) qf[s] = *(const bf16x8*)(Q + (size_t)qrow * D + h * 64 + 16 * s + 8 * hh);
            f32x16 st[5];
#pragma unroll
            for (int kt = 0; kt < 5; ++kt) { f32x16 a = {};
                const LAS unsigned char* kp = lds + ATT_KS + (32 * (qs + kt) + r) * ATT_KP + 16 * hh;
#pragma unroll
                for (int s = 0; s < 4; ++s) { const bf16x8 kf = *(const LAS bf16x8*)(kp + 32 * s); a = __builtin_amdgcn_mfma_f32_32x32x16_bf16(kf, qf[s], a, 0, 0, 0); }
                st[kt] = a; }
            float mx = sink2;
#pragma unroll
            for (int kt = 0; kt < 5; ++kt) { const bool dead = (nb == 0) && (qs + kt < 4);
#pragma unroll
                for (int rg = 0; rg < 16; ++rg) { const int kk = (rg & 3) + 8 * (rg >> 2) + 4 * hh;
                    bool ok = !dead; if (kt == 0) ok = ok && (kk > r); if (kt == 4) ok = ok && (kk <= r);
                    const float v = ok ? st[kt][rg] : -1e30f; st[kt][rg] = v; mx = fmaxf(mx, v); } }
            mx = fmaxf(mx, __shfl_xor(mx, 32));
            float sum = 0.f;
#pragma unroll
            for (int kt = 0; kt < 5; ++kt)
#pragma unroll
                for (int rg = 0; rg < 16; ++rg) { const float p = __builtin_amdgcn_exp2f(st[kt][rg] - mx); st[kt][rg] = p; sum += p; }
            sum += __shfl_xor(sum, 32);
            const float inv = 1.0f / (sum + __builtin_amdgcn_exp2f(sink2 - mx));
            f32x16 o0 = {}, o1 = {};
#pragma unroll
            for (int kt = 0; kt < 5; ++kt)
#pragma unroll
                for (int s2 = 0; s2 < 2; ++s2) {
                    u32x4 pw; pw.x = pk2(st[kt][8 * s2 + 0] * inv, st[kt][8 * s2 + 1] * inv); pw.y = pk2(st[kt][8 * s2 + 2] * inv, st[kt][8 * s2 + 3] * inv);
                    pw.z = pk2(st[kt][8 * s2 + 4] * inv, st[kt][8 * s2 + 5] * inv); pw.w = pk2(st[kt][8 * s2 + 6] * inv, st[kt][8 * s2 + 7] * inv);
                    const bf16x8 pa = __builtin_bit_cast(bf16x8, pw);
                    const int kbase = 32 * (qs + kt) + 16 * s2 + 4 * hh;
#pragma unroll
                    for (int dh = 0; dh < 2; ++dh) { const LAS unsigned char* vp = lds + ATT_VS + (32 * dh + r) * ATT_VP + kbase * 2;
                        const u32x2 lo = *(const LAS u32x2*)vp, hi = *(const LAS u32x2*)(vp + 16);
                        const u32x4 vv = (u32x4){lo.x, lo.y, hi.x, hi.y}; const bf16x8 vf = __builtin_bit_cast(bf16x8, vv);
                        if (dh == 0) o0 = __builtin_amdgcn_mfma_f32_32x32x16_bf16(pa, vf, o0, 0, 0, 0); else o1 = __builtin_amdgcn_mfma_f32_32x32x16_bf16(pa, vf, o1, 0, 0, 0); } }
            LAS unsigned char* ost = lds + ATT_OS + wid * (32 * 144);
#pragma unroll
            for (int rg = 0; rg < 16; ++rg) { const int q = (rg & 3) + 8 * (rg >> 2) + 4 * hh;
                *(LAS bf16_t*)(ost + q * 144 + 2 * r) = (bf16_t)(pk2(o0[rg], 0.f) & 0xffffu); *(LAS bf16_t*)(ost + q * 144 + 64 + 2 * r) = (bf16_t)(pk2(o1[rg], 0.f) & 0xffffu); }
            LDS_WAIT();
#pragma unroll
            for (int i = 0; i < 4; ++i) { const int q = 8 * i + (lane >> 3), ch = lane & 7;
                const u32x4 v = *(const LAS u32x4*)(ost + q * 144 + 16 * ch);
                *(u32x4*)(O + (size_t)(row0 + 32 * qs + q) * D + h * 64 + 8 * ch) = v; }
            LDS_WAIT();
        }
        __syncthreads();
    }
}
__device__ __forceinline__ void router_phase(LAS unsigned char* lds, const bf16_t* X, const float* SS, const bf16_t* WR16, const float* br,
                                             unsigned* TOKE, float* TOKW0, float* TOKW1, float* TOKR, int* CNT, int blk, int nblk) {
    const int tid = threadIdx.x, lane = tid & 63, wid = tid >> 6, r16 = lane & 15, kq = lane >> 4;
    LAS unsigned* se = (LAS unsigned*)lds;
    LAS float* slg = (LAS float*)(lds + 1024) + wid * 16 * 9;
    for (int tile = blk; tile < T / 128; tile += nblk) {
        const int tok0 = tile * 128 + wid * 16;
        const bf16_t* xa = X + (size_t)(tok0 + r16) * D + 8 * kq;
        const bf16_t* wb = WR16 + (size_t)r16 * D + 8 * kq;
        f32x4 acc = {0.f, 0.f, 0.f, 0.f};
#pragma unroll
        for (int sb = 0; sb < 4; ++sb) { bf16x8 af[8], bfr[8];
#pragma unroll
            for (int s = 0; s < 8; ++s) { af[s] = *(const bf16x8*)(xa + 32 * (8 * sb + s)); bfr[s] = *(const bf16x8*)(wb + 32 * (8 * sb + s)); }
#pragma unroll
            for (int s = 0; s < 8; ++s) acc = __builtin_amdgcn_mfma_f32_16x16x32_bf16(af[s], bfr[s], acc, 0, 0, 0); }
#pragma unroll
        for (int r = 0; r < 4; ++r) { const float lo = __shfl_down(acc[r], 8, 16); if (r16 < 8) slg[(4 * kq + r) * 9 + r16] = acc[r] + lo; }
        LDS_WAIT();
        if (lane < 16) { const int tok = tok0 + lane;
            const float ssum = (SS[SS1_IDX(tok, 0)] + SS[SS1_IDX(tok, 1)]) + (SS[SS1_IDX(tok, 2)] + SS[SS1_IDX(tok, 3)]);
            const float rstd = 1.0f / sqrtf(ssum * (1.0f / D) + EPS);
            float lg[8];
#pragma unroll
            for (int e = 0; e < 8; ++e) lg[e] = fmaf(slg[lane * 9 + e], rstd, br[e]);
            int i0 = 0; float v0 = lg[0];
#pragma unroll
            for (int e = 1; e < 8; ++e) if (lg[e] > v0) { v0 = lg[e]; i0 = e; }
            int i1 = -1; float v1 = -3.0e38f;
#pragma unroll
            for (int e = 0; e < 8; ++e) if (e != i0 && lg[e] > v1) { v1 = lg[e]; i1 = e; }
            const float e1 = __expf(v1 - v0), w0 = 1.0f / (1.0f + e1), w1 = e1 * w0;
            const unsigned pe = (unsigned)i0 | ((unsigned)i1 << 8); TOKE[tok] = pe; TOKW0[tok] = w0; TOKW1[tok] = w1; TOKR[tok] = rstd; se[wid * 16 + lane] = pe; }
        __syncthreads();
        if (tid < 16) { int c = 0; const unsigned e = (unsigned)(tid & 7), sh = (tid >> 3) * 8;
            for (int t = 0; t < 128; ++t) c += (((se[t] >> sh) & 0xffu) == e) ? 1 : 0;
            CNT[tile * 16 + tid] = c; }
        __syncthreads();
    }
}
__device__ __forceinline__ void gather_phase(LAS unsigned char* lds, const bf16_t* X, const unsigned* TOKE, const float* TOKW0, const float* TOKW1, const float* TOKR, const int* CNT,
                                             int* TOKLIST, unsigned* SLOTP, int blk, int nblk) {
    const int tid = threadIdx.x, lane = tid & 63, wid = tid >> 6;
    LAS int* s_tot = (LAS int*)lds;
    LAS int* s_bef = s_tot + 16;
    LAS int* s_start = s_bef + 16;
    LAS unsigned* s_e = (LAS unsigned*)(s_start + 32);
    LAS int* s_slot = (LAS int*)(s_e + 128);
    for (int tile = blk; tile < T / 128; tile += nblk) {
        if (tid < 32) s_tot[tid] = 0;
        __syncthreads();
        { int tot = 0, bef = 0;
#pragma unroll
          for (int k = 0; k < 8; ++k) { const int t = (tid >> 4) + 32 * k; const int c = CNT[t * 16 + (tid & 15)]; tot += c; bef += (t < tile) ? c : 0; }
          atomicAdd((int*)(s_tot + (tid & 15)), tot); atomicAdd((int*)(s_bef + (tid & 15)), bef); }
        if (tid >= 64 && tid < 192) s_e[tid - 64] = TOKE[tile * 128 + tid - 64];
        __syncthreads();
        if (tid == 0) { int s = 0; for (int g = 0; g < 16; ++g) { s_start[g] = s; s += (s_tot[g] + 255) & ~255; } s_start[16] = s; }
        __syncthreads();
        if (tile == 0) {
            for (int g = 0; g < 16; ++g) { const int lo = s_start[g] + s_tot[g], hi = s_start[g + 1]; for (int s = lo + tid; s < hi; s += 512) { TOKLIST[s] = -1; SLOTP[s] = 0u; } }
        }
        if (tid < 128) { const unsigned me = s_e[tid]; const unsigned e0 = me & 0xffu, e1 = (me >> 8) & 0xffu; int r0 = 0, r1 = 0;
            for (int t = 0; t < tid; ++t) { const unsigned o = s_e[t]; r0 += ((o & 0xffu) == e0) ? 1 : 0; r1 += (((o >> 8) & 0xffu) == e1) ? 1 : 0; }
            const int tok = tile * 128 + tid;
            const int sl0 = s_start[e0] + s_bef[e0] + r0, sl1 = s_start[8 + e1] + s_bef[8 + e1] + r1;
            const float rs = TOKR[tok];
            TOKLIST[sl0] = tok; SLOTP[sl0] = pack_h2(rs, rs * TOKW0[tok]); TOKLIST[sl1] = tok; SLOTP[sl1] = pack_h2(rs, rs * TOKW1[tok]); }
        __syncthreads();
    }
}
__device__ __forceinline__ void moe_table(LAS int* tstart, const int* CNT) {
    const int tid = threadIdx.x;
    LAS int* s_tot = tstart + 32;
    if (tid < 16) s_tot[tid] = 0;
    __syncthreads();
    { int tot = 0;
#pragma unroll
      for (int k = 0; k < 8; ++k) tot += CNT[((tid >> 4) + 32 * k) * 16 + (tid & 15)];
      atomicAdd((int*)(s_tot + (tid & 15)), tot); }
    __syncthreads();
    if (tid == 0) { int s = 0; for (int g = 0; g < 16; ++g) { tstart[g] = s; s += (s_tot[g] + 255) >> 8; } tstart[16] = s; }
    __syncthreads();
}
template <bool HALVES> struct OrdMoeT : pg8::OrderHalf {
    const LAS int* tstart; int g_lo; unsigned bexp, btile; const int* toklist;
    __device__ __forceinline__ void setup(const LAS int* ts, int glo, int ng, int nN_, int G_, int c_, unsigned bexp_, unsigned btile_) {
        tstart = ts; g_lo = glo; bexp = bexp_; btile = btile_; init(ts[glo + ng] - ts[glo], nN_, G_, c_); }
    __device__ __forceinline__ bool next(int i, Unit& u) const {
        int pm, pn, half = 0; if (HALVES ? !tileh(i, pm, pn, half) : !tile(i, pm, pn)) return false;
        const int mt = tstart[g_lo] + pm; int g = 0;
#pragma unroll
        for (int k = 1; k < 16; ++k) g += (tstart[k] <= mt) ? 1 : 0;
        u.pm = mt; u.pn = pn; u.rb = mt * 256 + (half == 2 ? 128 : 0); u.half = half; u.aoff = (unsigned)mt * (256u * 2048u) + (half == 2 ? 128u * 2048u : 0u); u.boff = (unsigned)(g & 7) * bexp + (unsigned)pn * btile; return true;
    }
};
__device__ __forceinline__ void final_phase(const bf16_t* __restrict__ X6, float* __restrict__ out, const float* __restrict__ SS, const float* __restrict__ gf, int gwave, int nwaves, int lane) {
    f32x4 g[4];
#pragma unroll
    for (int j = 0; j < 4; ++j) g[j] = *(const f32x4*)(gf + 256 * j + 4 * lane);
    for (int row = 2 * gwave; row < T; row += 2 * nwaves) {
        u32x2 xv[2][4]; float sv[2];
#pragma unroll
        for (int r = 0; r < 2; ++r) {
#pragma unroll
            for (int j = 0; j < 4; ++j) xv[r][j] = *(const u32x2*)(X6 + (size_t)(row + r) * D + 256 * j + 4 * lane);
            sv[r] = (lane < 4) ? SS[SS1_IDX(row + r, lane)] : 0.f; }
#pragma unroll
        for (int r = 0; r < 2; ++r) { const float rs = 1.0f / sqrtf(wave_sum(sv[r]) * (1.0f / D) + EPS);
            float* o = out + (size_t)(row + r) * D + 4 * lane;
#pragma unroll
            for (int j = 0; j < 4; ++j) { const f32x4 v = {bflo(xv[r][j].x), bfhi(xv[r][j].x), bflo(xv[r][j].y), bfhi(xv[r][j].y)};
                __builtin_nontemporal_store(v * rs * g[j], (f32x4*)(o + 256 * j)); } }
    }
}
constexpr size_t MiB = 1u << 20, KiB = 1u << 10;
constexpr size_t WS_BAR = 0, WS_C8G = 32 * KiB, WS_RSTD0 = 64 * KiB, WS_TOKE = 192 * KiB, WS_TOKW0 = 320 * KiB, WS_TOKW1 = 448 * KiB, WS_TOKR = 576 * KiB, WS_CNT = 704 * KiB, WS_TOKLIST = 720 * KiB, WS_SLOTW = 1008 * KiB, WS_SLOTR = 1296 * KiB, WS_WR16 = 1600 * KiB;
constexpr size_t WS_SSA = 2 * MiB, WS_SSB = 4 * MiB, WS_AGGA = 2 * MiB, WS_AGGH = 3 * MiB, WS_CARRY = 4 * MiB;
constexpr size_t WS_W = 6 * MiB;
constexpr size_t W_IN = WS_W, W_GATE = W_IN + 4 * MiB, W_OUT = W_GATE + 1 * MiB, W_FFI = W_OUT + 2 * MiB, W_FFO = W_FFI + 12 * MiB, W_PG0 = W_FFO + 6 * MiB, W_PG1 = W_PG0 + 2 * MiB,
                 W_PP0 = W_PG1 + 2 * MiB, W_PP1 = W_PP0 + MiB / 2, W_QKV = W_PP1 + MiB / 2, W_O = W_QKV + 5 * MiB / 2, W_EI = W_O + 2 * MiB, W_EO = W_EI + 32 * MiB, W_END = W_EO + 16 * MiB;
constexpr size_t SL_A = 92 * MiB, SL_B = 156 * MiB, SL_C = 220 * MiB, SL_D = 284 * MiB, SL_E = 348 * MiB, SL_F = 412 * MiB, SL_G = 476 * MiB, WS_NEED = 512 * MiB;
static_assert(W_END <= SL_A, "weights overlap slots");
static_assert(SL_C + (size_t)XG_ROWS * 2048 <= SL_E + 8 * MiB && SL_E + 8 * MiB + (size_t)XG_ROWS * 2048 <= WS_NEED, "moe buffers");
constexpr size_t WS_XG = SL_C, WS_HEXP = SL_E + 8 * MiB;
constexpr int LDS_BYTES = 163840;
constexpr int LDS_MISC = 131072;
constexpr int NPHASE = 20;

struct Args { const void* in[29]; float* out; unsigned char* ws; int ph_lo, ph_hi; };

struct OrdGates : pg8::OrderBase {
    __device__ __forceinline__ bool next(int i, Unit& u) const { if (!tile(i, u.pm, u.pn)) return false; u.aoff = (unsigned)u.pm * (256u * 2048u) + (unsigned)(u.pn >> 1) * 512u; u.boff = (unsigned)u.pn * (256u * 512u); u.rb = u.pm * 256; u.half = 0; return true; }
};

struct OrdGatesT { int c;
    __device__ __forceinline__ bool next(int i, Unit& u) const { if (i >= 4) return false; const int x = c & 7, yv = c >> 3, b = (yv >> 4) * 2 + (x >> 2), h = x & 3, half = (yv >> 3) & 1, j = yv & 7;
        u.pn = 2 * h + half; u.pm = b * 32 + 8 * i + j; u.rb = u.pm * 256; u.half = 0; u.aoff = (unsigned)u.pm * (256u * 2048u) + (unsigned)h * 512u; u.boff = (unsigned)u.pn * (256u * 512u); return true; }
};
__device__ __forceinline__ bool get_job(const Args& a, int j, TJob& J) {
    unsigned char* ws = a.ws;
    const float* g_mix = (const float*)a.in[3]; const float* g_ffn = (const float*)a.in[4]; const float* g_ple = (const float*)a.in[5];
    J.gain = nullptr; J.map = 0; J.p0 = 0; J.p1 = 0;
    if (j == 0) { J.W = (const float*)a.in[8]; J.K = 1024; J.N = 2048; J.gain = g_mix; J.dst = (bf16_t*)(ws + W_IN); J.dpitch = 1024; return true; }
    if (j == 1) { J.W = (const float*)a.in[16]; J.K = 1024; J.N = 1024; J.dst = (bf16_t*)(ws + W_OUT); J.dpitch = 1024; return true; }
    if (j == 2) { J.W = (const float*)a.in[22]; J.K = 1024; J.N = 6144; J.gain = g_ffn; J.dst = (bf16_t*)(ws + W_FFI); J.dpitch = 1024; J.map = 1; J.p0 = 3072; return true; }
    if (j == 3) { J.W = (const float*)a.in[23]; J.K = 3072; J.N = 1024; J.dst = (bf16_t*)(ws + W_FFO); J.dpitch = 3072; return true; }
    if (j == 4 || j == 5) { const int l = j - 4; J.W = (const float*)a.in[6] + (size_t)l * D * D; J.K = 1024; J.N = 1024; J.gain = g_ple + l * D; J.dst = (bf16_t*)(ws + (l ? W_PG1 : W_PG0)); J.dpitch = 1024; return true; }
    if (j == 6 || j == 7) { const int l = j - 6; J.W = (const float*)a.in[7] + (size_t)l * PLE * D; J.K = 256; J.N = 1024; J.dst = (bf16_t*)(ws + (l ? W_PP1 : W_PP0)); J.dpitch = 256; return true; }
    if (j == 8) { J.W = (const float*)a.in[18]; J.K = 1024; J.N = 256; J.gain = (const float*)a.in[17]; J.dst = (bf16_t*)(ws + W_QKV); J.dpitch = 1024; J.map = 3; J.p0 = 0; J.p1 = 128; return true; }
    if (j == 9) { J.W = (const float*)a.in[19]; J.K = 1024; J.N = 1024; J.gain = g_mix + D; J.dst = (bf16_t*)(ws + W_QKV); J.dpitch = 1024; J.map = 3; J.p0 = 256; J.p1 = 1024; return true; }
    if (j == 10) { J.W = (const float*)a.in[21]; J.K = 1024; J.N = 1024; J.dst = (bf16_t*)(ws + W_O); J.dpitch = 1024; return true; }
    if (j < 19) { const int q = j - 11, gx = q >> 2, h = q & 3;
        J.W = (const float*)a.in[gx ? 13 : 11] + (size_t)h * 65536; J.K = 256; J.N = 256; J.dst = (bf16_t*)(ws + W_GATE); J.dpitch = 256; J.map = 2; J.p0 = 2 * h; J.p1 = gx ? 128 : 0; return true; }
    if (j < 27) { const int e = j - 19; J.W = (const float*)a.in[26] + (size_t)e * D * 2048; J.K = 1024; J.N = 2048; J.gain = g_ffn + D; J.dst = (bf16_t*)(ws + W_EI); J.dpitch = 1024; J.map = 1; J.p0 = 1024; J.p1 = e * 2048; return true; }
    if (j < 35) { const int e = j - 27; J.W = (const float*)a.in[27] + (size_t)e * D * D; J.K = 1024; J.N = 1024; J.dst = (bf16_t*)(ws + W_EO); J.dpitch = 1024; J.p0 = e * 1024; return true; }
    return false;
}

__device__ __forceinline__ void convert_jobs(const Args& args, int jlo, int jhi, int w, int nw, LAS float* scr, int lane) {
    int off = 0; TJob J;
    for (int j = jlo; j < jhi && get_job(args, j, J); ++j) { const int n = (J.K / 64) * (J.N / 32); const int start = (w + nw - off % nw) % nw;
        for (int it = start; it < n; it += nw) transpose_item(J, scr, it, lane);
        off += n; }
}
constexpr int JOB_EI = 19, JOB_EO = 27, JOB_END = 35;

__global__ void __launch_bounds__(512, 2) fwd(Args args) {
    extern __shared__ __attribute__((aligned(16))) unsigned char lds_raw[];
    LAS unsigned char* lds = (LAS unsigned char*)lds_raw;
#define tid ((int)threadIdx.x)
#define lane (tid & 63)
#define wave (__builtin_amdgcn_readfirstlane(tid >> 6))
    const int G = gridDim.x, bx = blockIdx.x;
#define gtid (bx * 512 + tid)
#define gw (bx * 8 + wave)
    const int gthreads = G * 512, NGW = G * 8;
    unsigned char* ws = args.ws;
    const int lo = args.ph_lo, hi = args.ph_hi;
    cg::grid_group grid = cg::this_grid();
#ifndef PHMASK
#define PHMASK 0xFFFFFu
#endif
#define IN(k) ((((PHMASK) >> (k)) & 1u) && lo <= (k) && (k) < hi)
#if SELF_RESET
    unsigned* const barw = g_xbar;
#else
    unsigned* const barw = (unsigned*)(ws + WS_BAR);
#endif
    XcdBarrier xbar; xbar.bar = barw; xbar.x = 0; xbar.st = (volatile LAS unsigned*)(lds + LDS_MISC + 8192);
    if (hi - lo > 1) { if (tid < 4) ((LAS unsigned*)(lds + LDS_MISC + 8192))[tid] = 0u; __syncthreads(); xbar = xcd_barrier_post(barw, (volatile LAS unsigned*)(lds + LDS_MISC + 8192)); }
#ifndef REPMASK
#define REPMASK 0u
#endif
#define REPL(k) for (int rep_ = 0; rep_ <= (int)(((REPMASK) >> (k)) & 1u); ++rep_)
#define SEAM(k) do { if (IN(k) && IN((k) + 1)) { if (lo < 0) grid.sync(); else xcd_barrier(xbar); } } while (0)
    const float* x = (const float*)args.in[0]; const float* p = (const float*)args.in[1]; const int* pos = (const int*)args.in[2];
#define X0 ((bf16_t*)(ws + SL_A))
#define P16 ((bf16_t*)(ws + SL_G))
#define GATE ((bf16_t*)(ws + SL_D))
#define XB ((bf16_t*)(ws + SL_E))
#define XC ((bf16_t*)(ws + SL_F))
#define PP1 ((bf16_t*)(ws + SL_A))
#define HL ((bf16_t*)(ws + SL_B))
#define PC ((bf16_t*)(ws + SL_E))
#define Y ((bf16_t*)(ws + SL_E))
#define X1 ((bf16_t*)(ws + SL_C))
#define PP0 ((bf16_t*)(ws + SL_B))
#define HFF ((bf16_t*)(ws + SL_D))
#define X3 ((bf16_t*)(ws + SL_B))
#define KV ((bf16_t*)(ws + SL_G))
#define Q ((bf16_t*)(ws + SL_C))
#define ATT ((bf16_t*)(ws + SL_D))
#define HEXP ((bf16_t*)(ws + WS_HEXP))
#define SSA ((float*)(ws + WS_SSA))
#define SSB ((float*)(ws + WS_SSB))
#define RSTD0 ((float*)(ws + WS_RSTD0))
#define AGGA ((float*)(ws + WS_AGGA))
#define AGGH ((float*)(ws + WS_AGGH))
#define CARRY ((float*)(ws + WS_CARRY))
#define TOKE ((unsigned*)(ws + WS_TOKE))
#define TOKW0 ((float*)(ws + WS_TOKW0))
#define TOKW1 ((float*)(ws + WS_TOKW1))
#define TOKR ((float*)(ws + WS_TOKR))
#define C8G ((float*)(ws + WS_C8G))
#define CNT ((int*)(ws + WS_CNT))
#define TOKLIST ((int*)(ws + WS_TOKLIST))
#define SLOTP ((unsigned*)(ws + WS_SLOTW))
#define WR16 ((bf16_t*)(ws + WS_WR16))
    if (IN(0)) REPL(0) { if (rep_) xcd_barrier(xbar);
        LAS float* scr = (LAS float*)(lds + wave * 16384);
        convert_jobs(args, 0, JOB_EI, gw, NGW, scr, lane);
        if (G != 256) convert_jobs(args, JOB_EI, JOB_END, gw, NGW, scr, lane);
        if (gtid < D * 8) { const int kk = gtid >> 3, e = gtid & 7; const float w = ((const float*)args.in[24])[gtid] * ((const float*)args.in[4])[D + kk];
            const unsigned hi = pk2(w, 0.f) & 0xffffu; const float rem = w - __uint_as_float(hi << 16); WR16[(size_t)e * D + kk] = (bf16_t)hi; WR16[(size_t)(8 + e) * D + kk] = (bf16_t)(pk2(rem, 0.f) & 0xffffu); }
        if (gtid < D) { const float l = -((const float*)args.in[15])[gtid]; C8G[gtid] = -8.0f * LOG2E * (fmaxf(l, 0.f) + log1pf(expf(-fabsf(l)))); }
        for (int m = 4 * gw; m < T; m += 4 * NGW) cvt_rows<4>(x + (size_t)m * D, X0 + (size_t)m * D, RSTD0 + m, lane);
        for (int m = 4 * gw; m < 2 * T / 4; m += 4 * NGW) cvt_rows<4>(p + (size_t)m * D, P16 + (size_t)m * D, nullptr, lane);
    }
    SEAM(0);
    if (IN(1)) REPL(1) { if (rep_) xcd_barrier(xbar);
        Gemm g{(const char*)X0, (const char*)(ws + W_IN), 2048u, 2048u, 128u * 2048u, 1024, 0}; OrdStd S; S.init(T / 256, 8, G, bx); S.atile = 256u * 2048u; S.btile = 256u * 2048u;
        EpiInProj E{GATE, XB, RSTD0}; gemm_phase(lds, g, S, E);
    }
    SEAM(1);
    if (IN(2)) REPL(2) { if (rep_) xcd_barrier(xbar);
        conv_phase(XB, (const float*)args.in[9], (const float*)args.in[10], XC, gtid, gthreads);
    }
    SEAM(2);
    if (IN(3)) {
        Gemm g{(const char*)XC, (const char*)(ws + W_GATE), 2048u, 512u, 4u * 2048u, 256, 1}; OrdGatesT S; S.c = bx;
        EpiGatesF E{XC, (const float*)args.in[12], (const float*)args.in[14], C8G, GATE, Y, AGGA, AGGH, CARRY, &xbar}; gemm_phase(lds, g, S, E);
        convert_jobs(args, JOB_EI + 5, JOB_EO, gw, NGW, (LAS float*)(lds + wave * 16384), lane);
    }
    SEAM(3);
    if (IN(6)) REPL(6) { if (rep_) xcd_barrier(xbar);
#ifndef NO6A
        { Gemm g{(const char*)Y, (const char*)(ws + W_OUT), 2048u, 2048u, 128u * 2048u, 1024, 0}; OrdStd S; S.init(T / 256, 4, G, bx); S.atile = 256u * 2048u; S.btile = 256u * 2048u;
          EpiRes<false> E{X0, X1, SSA, (LAS float*)(lds + LDS_MISC + 1024)}; gemm_phase(lds, g, S, E); }
#endif
#ifndef NO6B
        { Gemm g{(const char*)P16, (const char*)(ws + W_PP0), 512u, 512u, 128u * 512u, 256, 0}; OrdStd S; S.init(T / 256, 4, G, bx); S.atile = 256u * 512u; S.btile = 256u * 512u;
          EpiBf16 E{PP0, D}; gemm_phase(lds, g, S, E); }
#endif
    }
    SEAM(6);
    if (IN(7)) REPL(7) { if (rep_) xcd_barrier(xbar);
        Gemm g{(const char*)X1, (const char*)(ws + W_FFI), 2048u, 2048u, 128u * 2048u, 1024, 0}; OrdStd S; S.init(T / 256, 24, G, bx); S.atile = 256u * 2048u; S.btile = 256u * 2048u;
        EpiSwiglu E{HFF, DFF, SSA, nullptr}; gemm_phase(lds, g, S, E);
#ifdef PROBE_NOEPI
        xcd_barrier(xbar); { EpiNull E0{(float*)(ws + WS_BAR + 16384)}; gemm_phase(lds, g, S, E0); }
#endif

    }
    SEAM(7);
    if (IN(8)) REPL(8) { if (rep_) xcd_barrier(xbar);
        Gemm g{(const char*)HFF, (const char*)(ws + W_FFO), 6144u, 6144u, 128u * 6144u, 3072, 0}; OrdStd S; S.init(T / 256, 4, G, bx); S.atile = 256u * 6144u; S.btile = 256u * 6144u;
        EpiRes<false> E{X1, X1, SSB, (LAS float*)(lds + LDS_MISC + 1024)}; gemm_phase(lds, g, S, E);
    }
    SEAM(8);
    if (IN(9)) REPL(9) { if (rep_) xcd_barrier(xbar);
        Gemm g{(const char*)X1, (const char*)(ws + W_PG0), 2048u, 2048u, 128u * 2048u, 1024, 0}; OrdStd S; S.init(T / 256, 4, G, bx); S.atile = 256u * 2048u; S.btile = 256u * 2048u;
        EpiPle<false> E{X1, PP0, X3, SSB, SSA, (LAS float*)(lds + LDS_MISC + 1024)}; gemm_phase(lds, g, S, E);
    }
    SEAM(9);
    if (IN(10)) REPL(10) { if (rep_) xcd_barrier(xbar);
        Gemm g{(const char*)X3, (const char*)(ws + W_QKV), 2048u, 2048u, 128u * 2048u, 1024, 0}; OrdStd S; S.init(T / 256, 5, G, bx); S.atile = 256u * 2048u; S.btile = 256u * 2048u;
        EpiQkv E{KV, Q, SSA, pos}; gemm_phase(lds, g, S, E);
        if (G == 256 && bx >= 128) convert_jobs(args, JOB_EI, JOB_EI + 5, (bx - 128) * 8 + wave, 128 * 8, (LAS float*)(lds + wave * 16384), lane);
    }
    SEAM(10);
    if (IN(11)) REPL(11) { if (rep_) xcd_barrier(xbar); attn_phase(lds, Q, KV, (const float*)args.in[20], ATT, bx, G); }
    SEAM(11);
    if (IN(12)) REPL(12) { if (rep_) xcd_barrier(xbar);
        Gemm g{(const char*)ATT, (const char*)(ws + W_O), 2048u, 2048u, 128u * 2048u, 1024, 0}; OrdStd S; S.init(T / 256, 4, G, bx); S.atile = 256u * 2048u; S.btile = 256u * 2048u;
        EpiRes<false> E{X3, X3, SSB, (LAS float*)(lds + LDS_MISC + 1024)}; gemm_phase(lds, g, S, E);
    }
    SEAM(12);
    if (IN(13)) REPL(13) { if (rep_) xcd_barrier(xbar); router_phase(lds, X3, SSB, WR16, (const float*)args.in[25], TOKE, TOKW0, TOKW1, TOKR, CNT, bx, G); }
    SEAM(13);
    if (IN(14)) REPL(14) { if (rep_) xcd_barrier(xbar); gather_phase(lds, X3, TOKE, TOKW0, TOKW1, TOKR, CNT, TOKLIST, SLOTP, bx, G); }
    SEAM(14);
    if (IN(15) || IN(16) || IN(17)) moe_table((LAS int*)(lds + LDS_MISC), CNT);
    if (IN(15)) REPL(15) { if (rep_) xcd_barrier(xbar);
        Gemm g{(const char*)X3, (const char*)(ws + W_EI), 2048u, 2048u, 128u * 2048u, 1024, 0}; OrdMoeT<true> S; S.setup((const LAS int*)(lds + LDS_MISC), 0, 16, 8, G, bx, 2048u * 2048u, 256u * 2048u); S.toklist = TOKLIST;
        EpiSwiglu E{HEXP, D, nullptr, SLOTP}; gemm_phase<EpiSwiglu, OrdMoeT<true>, true, true>(lds, g, S, E);
        if (G == 256) { int nidle = G - pg8::last_round_busy(S.nwg, G, true); if (nidle < 32) nidle = G; const int first = G - nidle;
            if (bx >= first) convert_jobs(args, JOB_EO, JOB_END, (bx - first) * 8 + wave, nidle * 8, (LAS float*)(lds + wave * 16384), lane); }
    }
    SEAM(15);
    if (IN(16)) REPL(16) { if (rep_) xcd_barrier(xbar);
        Gemm g{(const char*)HEXP, (const char*)(ws + W_EO), 2048u, 2048u, 128u * 2048u, 1024, 0}; OrdMoeT<true> S; S.setup((const LAS int*)(lds + LDS_MISC), 0, 8, 4, G, bx, 1024u * 2048u, 256u * 2048u); S.toklist = TOKLIST;
        EpiMoeDown E{TOKLIST, X3, nullptr}; gemm_phase<EpiMoeDown, OrdMoeT<true>, false, true>(lds, g, S, E);
        {
          int nidle = G - pg8::last_round_busy(S.nwg, G, true); if (nidle < 32) nidle = G; const int first = G - nidle;
          if (bx >= first) { Gemm g2{(const char*)(P16 + (size_t)T * PLE), (const char*)(ws + W_PP1), 512u, 512u, 128u * 512u, 256, 0}; OrdStd S2; S2.init(T / 512, 4, nidle, bx - first); S2.atile = 256u * 512u; S2.btile = 256u * 512u;
              EpiBf16 E2{PP1, D}; gemm_phase(lds, g2, S2, E2); } }
    }
    SEAM(16);
    if (IN(17)) REPL(17) { if (rep_) xcd_barrier(xbar);
        Gemm g{(const char*)HEXP, (const char*)(ws + W_EO), 2048u, 2048u, 128u * 2048u, 1024, 0}; OrdMoeT<true> S; S.setup((const LAS int*)(lds + LDS_MISC), 8, 8, 4, G, bx, 1024u * 2048u, 256u * 2048u); S.toklist = TOKLIST;
        EpiMoeDown E{TOKLIST, X3, SSA}; gemm_phase<EpiMoeDown, OrdMoeT<true>, false, true>(lds, g, S, E);
        {
          int nidle = G - pg8::last_round_busy(S.nwg, G, true); if (nidle < 32) nidle = G; const int first = G - nidle;
          if (bx >= first) { Gemm g2{(const char*)(P16 + (size_t)T * PLE + (size_t)(T / 2) * PLE), (const char*)(ws + W_PP1), 512u, 512u, 128u * 512u, 256, 0}; OrdStd S2; S2.init(T / 512, 4, nidle, bx - first); S2.atile = 256u * 512u; S2.btile = 256u * 512u;
              EpiBf16 E2{PP1 + (size_t)(T / 2) * D, D}; gemm_phase(lds, g2, S2, E2); } }
    }
    SEAM(17);
    if (IN(18)) REPL(18) { if (rep_) xcd_barrier(xbar);
        Gemm g{(const char*)X3, (const char*)(ws + W_PG1), 2048u, 2048u, 128u * 2048u, 1024, 0}; OrdStd S; S.init(T / 256, 4, G, bx); S.atile = 256u * 2048u; S.btile = 256u * 2048u;
        EpiPle<false, true> E{X3, PP1, PP1, SSA, SSB, (LAS float*)(lds + LDS_MISC + 1024)}; gemm_phase(lds, g, S, E);
    }
    SEAM(18);
    if (IN(19)) final_phase(PP1, args.out, SSB, (const float*)args.in[28], gw, NGW, lane);
#if SELF_RESET
    if (hi - lo > 1) {
        __syncthreads();
        LAS unsigned* lastf = (LAS unsigned*)(lds + LDS_MISC + 8192) + 2;
        if (tid == 0) *lastf = (xb_add(&barw[XB_EXIT], 1u) == (unsigned)G - 1u) ? 1u : 0u;
        __syncthreads();
        if (*lastf) { for (int i = tid; i < XCD_BAR_WORDS + 64; i += 512) __hip_atomic_store(&barw[i], 0u, RLX_AGENT); }
    }
#endif
#undef IN
#undef tid
#undef lane
#undef wave
#undef gtid
#undef gw
#undef SEAM
}
#ifndef SPLICE
#define SPLICE 0
#endif
#ifndef ONE_LAUNCH
#define ONE_LAUNCH 0
#endif
#if SPLICE
namespace nv {
__global__ void import_k(const bf16_t* __restrict__ src, float* __restrict__ dst, size_t n) {
    const size_t i = (size_t)blockIdx.x * blockDim.x + threadIdx.x; if (i < n) dst[i] = __uint_as_float((unsigned)src[i] << 16);
}
}
using namespace nv;
static inline void ngemm_l(hipStream_t s, const float* A, int lda, const float* B, int ldb, const float* R, int ldr, float* C, int ldc, int M, int N, int K) {
    hipLaunchKernelGGL(ngemm, dim3(N / NBN, M / NBM), dim3(256), 0, s, A, lda, B, ldb, R, ldr, C, ldc, K);
}
static inline int nb(size_t n) { return (int)((n + 255) / 256); }
#endif

extern "C" void kernel_launch(void* const* d_in, const int* in_sizes, int n_in, void* d_out, int out_size, void* d_ws, size_t ws_size, hipStream_t s) {
    static int inited = 0, grid_blocks = 0;
    if (!inited) {
        if (n_in != 29 || ws_size < WS_NEED) { fprintf(stderr, "kernel_launch: unexpected n_in %d / ws_size %zu (need %zu)\n", n_in, ws_size, (size_t)WS_NEED); inited = -1; return; }
        if (hipFuncSetAttribute((const void*)fwd, hipFuncAttributeMaxDynamicSharedMemorySize, LDS_BYTES) != hipSuccess) { fprintf(stderr, "kernel_launch: hipFuncSetAttribute failed\n"); inited = -1; return; }
        int dev = 0, cus = 0, per_cu = 0;
        if (hipGetDevice(&dev) != hipSuccess || hipDeviceGetAttribute(&cus, hipDeviceAttributeMultiprocessorCount, dev) != hipSuccess || cus < 1) { fprintf(stderr, "kernel_launch: device query failed\n"); inited = -1; return; }
        if (hipOccupancyMaxActiveBlocksPerMultiprocessor(&per_cu, (const void*)fwd, 512, LDS_BYTES) != hipSuccess || per_cu < 1) { fprintf(stderr, "kernel_launch: occupancy query reports %d workgroups per CU\n", per_cu); inited = -1; return; }
        grid_blocks = cus;
        if (cus != 256) { fprintf(stderr, "kernel_launch: built for a 256-CU device (got %d CUs)\n", cus); inited = -1; return; }
        inited = 1;
    }
    if (inited < 0) return;
    Args a{};
    for (int i = 0; i < 29; ++i) a.in[i] = d_in[i];
    a.out = (float*)d_out; a.ws = (unsigned char*)d_ws;
    const int grid = grid_blocks;
#if !SELF_RESET
    (void)hipMemsetAsync((char*)d_ws + WS_BAR, 0, 32 * KiB, s);
#endif
#if ONE_LAUNCH
#ifdef PROBE_SPLIT
    { a.ph_lo = 0; a.ph_hi = PROBE_SPLIT + PROBE_REP; void* kargs[] = {&a};
      hipError_t e = hipLaunchCooperativeKernel((const void*)fwd, dim3(grid), dim3(512), kargs, LDS_BYTES, s);
      if (e != hipSuccess) fprintf(stderr, "cooperative launch failed: %s\n", hipGetErrorString(e)); }
#if !SELF_RESET
    (void)hipMemsetAsync((char*)d_ws + WS_BAR, 0, 32 * KiB, s);
#endif
    { a.ph_lo = PROBE_SPLIT; a.ph_hi = NPHASE; void* kargs[] = {&a};
      hipError_t e = hipLaunchCooperativeKernel((const void*)fwd, dim3(grid), dim3(512), kargs, LDS_BYTES, s);
      if (e != hipSuccess) fprintf(stderr, "cooperative launch failed: %s\n", hipGetErrorString(e)); }
#else
    a.ph_lo = 0; a.ph_hi = NPHASE;
    void* kargs[] = {&a};
    hipError_t e = hipLaunchCooperativeKernel((const void*)fwd, dim3(grid), dim3(512), kargs, LDS_BYTES, s);
    if (e != hipSuccess) fprintf(stderr, "cooperative launch failed: %s\n", hipGetErrorString(e));
#endif
#else
    const int last = SPLICE ? SPLICE : NPHASE - 1;
    for (int ph = 0; ph <= last; ++ph) { a.ph_lo = ph; a.ph_hi = ph + 1; hipLaunchKernelGGL(fwd, dim3(grid), dim3(512), LDS_BYTES, s, a); }
#endif
#if SPLICE
    const float* x = (const float*)d_in[0]; const float* p = (const float*)d_in[1]; const int* pos = (const int*)d_in[2];
    const float* g_mix = (const float*)d_in[3]; const float* g_ffn = (const float*)d_in[4]; const float* g_ple = (const float*)d_in[5];
    const float* w_ple_gate = (const float*)d_in[6]; const float* w_ple_proj = (const float*)d_in[7];
    const float* w_lru_in = (const float*)d_in[8]; const float* conv_w = (const float*)d_in[9]; const float* conv_b = (const float*)d_in[10];
    const float* w_ga = (const float*)d_in[11]; const float* b_ga = (const float*)d_in[12]; const float* w_gx = (const float*)d_in[13]; const float* b_gx = (const float*)d_in[14];
    const float* lam = (const float*)d_in[15]; const float* w_lru_out = (const float*)d_in[16]; const float* g_kv = (const float*)d_in[17]; const float* w_kv = (const float*)d_in[18];
    const float* w_q = (const float*)d_in[19]; const float* sinks = (const float*)d_in[20]; const float* w_o = (const float*)d_in[21];
    const float* w_ff_in = (const float*)d_in[22]; const float* w_ff_out = (const float*)d_in[23]; const float* w_router = (const float*)d_in[24]; const float* b_router = (const float*)d_in[25];
    const float* w_exp_in = (const float*)d_in[26]; const float* w_exp_out = (const float*)d_in[27]; const float* g_final = (const float*)d_in[28];
    float* out = (float*)d_out; char* ws = (char*)d_ws;
    float* hf = (float*)(ws); float* xr = (float*)(ws + 96 * MiB); float* kvb = (float*)(ws + 128 * MiB); float* gts = (float*)(ws + 136 * MiB);
    float* big = (float*)(ws + 284 * MiB); float* xn = (float*)(ws + 476 * MiB);
    const int R = SEQ;
    for (int b = 0; b < BATCH; ++b) {
        const float* xb_in = x + (size_t)b * SEQ * D; const int* posb = pos + (size_t)b * SEQ; const size_t boff = (size_t)b * SEQ * D;
        float* h = big; float* xc = big + (size_t)R * 2048; float* rr = xc + (size_t)R * 1024; float* ig = rr + (size_t)R * 1024; float* y = ig + (size_t)R * 1024;
        if (SPLICE == 5) {
            hipLaunchKernelGGL(import_k, dim3(nb((size_t)R * D)), dim3(256), 0, s, (const bf16_t*)(ws + SL_B) + boff, xn, (size_t)R * D);
            ngemm_l(s, xn, D, w_lru_out, D, xb_in, D, xr, D, R, D, D);
        }
        if (SPLICE == 6 || SPLICE == 8) hipLaunchKernelGGL(import_k, dim3(nb((size_t)R * D)), dim3(256), 0, s, (const bf16_t*)(ws + SL_C) + boff, xr, (size_t)R * D);
        if (SPLICE == 9 || SPLICE == 12 || SPLICE == 17) hipLaunchKernelGGL(import_k, dim3(nb((size_t)R * D)), dim3(256), 0, s, (const bf16_t*)(ws + SL_B) + boff, xr, (size_t)R * D);
        if (SPLICE <= 6) {
            hipLaunchKernelGGL(rmsnorm_k, dim3(R / 4), dim3(256), 0, s, xr, g_ffn, xn, R);
            ngemm_l(s, xn, D, w_ff_in, 2 * DFF, nullptr, 0, big, 2 * DFF, R, 2 * DFF, D);
            hipLaunchKernelGGL(swiglu_k, dim3(nb((size_t)R * DFF)), dim3(256), 0, s, big, hf, R, DFF, (const float*)nullptr, 0);
            ngemm_l(s, hf, DFF, w_ff_out, D, xr, D, xr, D, R, D, DFF);
        }
        float* pg = big; float* pp = big + (size_t)R * 1024;
        if (SPLICE <= 8) {
            hipLaunchKernelGGL(rmsnorm_k, dim3(R / 4), dim3(256), 0, s, xr, g_ple, xn, R);
            ngemm_l(s, xn, D, w_ple_gate, D, nullptr, 0, pg, D, R, D, D);
            ngemm_l(s, p + (size_t)b * SEQ * PLE, PLE, w_ple_proj, D, nullptr, 0, pp, D, R, D, PLE);
            hipLaunchKernelGGL(ple_k, dim3(nb((size_t)R * 1024)), dim3(256), 0, s, xr, pg, pp, R);
        }
        float* q = big; float* at = big + (size_t)R * 1024;
        if (SPLICE <= 9) {
            hipLaunchKernelGGL(rmsnorm_k, dim3(R / 4), dim3(256), 0, s, xr, g_kv, xn, R);
            ngemm_l(s, xn, D, w_kv, 256, nullptr, 0, kvb, 256, R, 256, D);
            hipLaunchKernelGGL(rope_k, dim3(nb((size_t)R * 2 * 8)), dim3(256), 0, s, kvb, 256, 2, posb, R);
            hipLaunchKernelGGL(rmsnorm_k, dim3(R / 4), dim3(256), 0, s, xr, g_mix + D, xn, R);
            ngemm_l(s, xn, D, w_q, D, nullptr, 0, q, D, R, D, D);
            hipLaunchKernelGGL(rope_k, dim3(nb((size_t)R * 16 * 8)), dim3(256), 0, s, q, 1024, 16, posb, R);
            hipLaunchKernelGGL(attn_k, dim3(R * 16 / 4), dim3(256), 0, s, q, kvb, sinks, at, R);
            ngemm_l(s, at, D, w_o, D, xr, D, xr, D, R, D, D);
        }
        if (SPLICE <= 12) {
            hipLaunchKernelGGL(rmsnorm_k, dim3(R / 4), dim3(256), 0, s, xr, g_ffn + D, xn, R);
            hipLaunchKernelGGL(router_k, dim3(R / 4), dim3(256), 0, s, xn, w_router, b_router, gts, R);
            for (int e = 0; e < NE; ++e) {
                ngemm_l(s, xn, D, w_exp_in + (size_t)e * D * 2048, 2048, nullptr, 0, big, 2048, R, 2048, D);
                hipLaunchKernelGGL(swiglu_k, dim3(nb((size_t)R * 1024)), dim3(256), 0, s, big, hf, R, 1024, gts, e);
                ngemm_l(s, hf, D, w_exp_out + (size_t)e * D * D, D, xr, D, xr, D, R, D, D);
            }
        }
        if (SPLICE <= 17) {
            hipLaunchKernelGGL(rmsnorm_k, dim3(R / 4), dim3(256), 0, s, xr, g_ple + D, xn, R);
            ngemm_l(s, xn, D, w_ple_gate + (size_t)D * D, D, nullptr, 0, pg, D, R, D, D);
            ngemm_l(s, p + (size_t)(BATCH + b) * SEQ * PLE, PLE, w_ple_proj + (size_t)PLE * D, D, nullptr, 0, pp, D, R, D, PLE);
            hipLaunchKernelGGL(ple_k, dim3(nb((size_t)R * 1024)), dim3(256), 0, s, xr, pg, pp, R);
            hipLaunchKernelGGL(rmsnorm_k, dim3(R / 4), dim3(256), 0, s, xr, g_final, out + boff, R);
        }
        if (SPLICE == 18) hipLaunchKernelGGL(rmsnorm_k, dim3(R / 4), dim3(256), 0, s, out + boff, g_final, out + boff, R);
        (void)w_lru_in; (void)conv_w; (void)conv_b; (void)w_ga; (void)b_ga; (void)w_gx; (void)b_gx; (void)lam; (void)g_mix; (void)h; (void)y;
    }
#endif
}
```
